# Optimizing an MI355X kernel written in HIP

```python
import jax, jax.numpy as jnp
from jax import lax
import numpy as np

D_MODEL = 1024
BATCH = 16
SEQ = 2048
DEPTH = 4

GRID_W = 64
CTX_LEN = 256
HEAD_DIM = 64
ROPE_BASE = 10000.0
Q_BLOCK = 128
NORM_EPS = 1e-6
LN_EPS = 1e-5
CONV_CH = D_MODEL // 2
CONV_WIDTH = 31
GQA_HEADS = (D_MODEL // 2) // HEAD_DIM
GQA_KV_HEADS = GQA_HEADS // 4
GQA_GROUP = GQA_HEADS // GQA_KV_HEADS
GQA_Q_W = GQA_HEADS * HEAD_DIM
GQA_KV_W = GQA_KV_HEADS * HEAD_DIM
EVEN_IN = 2 * CONV_CH + GQA_Q_W + 2 * GQA_KV_W
EVEN_MIX = CONV_CH + GQA_Q_W
DIFF_HEADS = D_MODEL // (2 * HEAD_DIM)
DIFF_V_DIM = 2 * HEAD_DIM
DIFF_QK_W = DIFF_HEADS * 2 * HEAD_DIM
ODD_IN = 3 * DIFF_QK_W
FFN_DIM = (7 * D_MODEL) // 2
N_EXPERTS = 8
TOP_K = 2
N_EVEN = (DEPTH + 1) // 2
N_ODD = DEPTH // 2

kernel_name = 'hybrid_conv_gqa_diffattn_moe_dit'


def _rms_norm(x, g):
    xf = x.astype(jnp.float32)
    y = xf * lax.rsqrt(jnp.mean(xf * xf, axis=-1, keepdims=True) + NORM_EPS)
    return (y * g.astype(jnp.float32)).astype(x.dtype)


def _layer_norm(x, g, b):
    xf = x.astype(jnp.float32)
    mu = jnp.mean(xf, axis=-1, keepdims=True)
    var = jnp.mean(jnp.square(xf - mu), axis=-1, keepdims=True)
    y = (xf - mu) * lax.rsqrt(var + LN_EPS) * g.astype(jnp.float32) + b.astype(jnp.float32)
    return y.astype(x.dtype)


def _axial_rope_tables(n_lat):
    rows = n_lat // GRID_W
    r = jnp.broadcast_to(jnp.arange(rows, dtype=jnp.float32)[:, None], (rows, GRID_W)).reshape(-1)
    col = jnp.broadcast_to(jnp.arange(GRID_W, dtype=jnp.float32)[None, :], (rows, GRID_W)).reshape(-1)
    quarter = HEAD_DIM // 4
    inv_freq = ROPE_BASE ** (-jnp.arange(quarter, dtype=jnp.float32) / quarter)
    ang = jnp.stack([r[:, None] * inv_freq, col[:, None] * inv_freq], axis=1)
    return jnp.cos(ang), jnp.sin(ang)


def _apply_rope(x, cos, sin):
    shp = x.shape
    quarter = HEAD_DIM // 4
    xf = x.astype(jnp.float32).reshape(shp[:-1] + (2, 2, quarter))
    bshape = (1, shp[1]) + (1,) * (len(shp) - 3) + (2, quarter)
    cb = cos.reshape(bshape)
    sb = sin.reshape(bshape)
    x1 = xf[..., 0, :]
    x2 = xf[..., 1, :]
    out = jnp.stack([x1 * cb - x2 * sb, x2 * cb + x1 * sb], axis=-2)
    return out.reshape(shp).astype(x.dtype)


def _sweep_query_blocks(fn, q):
    bsz, n = q.shape[0], q.shape[1]
    nb = n // Q_BLOCK
    qb = jnp.moveaxis(q.reshape((bsz, nb, Q_BLOCK) + q.shape[2:]), 1, 0)
    out = jnp.moveaxis(lax.map(fn, qb), 0, 1)
    return out.reshape((bsz, n) + out.shape[3:])


def _gqa_block(qb, k, v):
    s = jnp.einsum('bqkgd,bskd->bkgqs', qb, k).astype(jnp.float32) * (HEAD_DIM ** -0.5)
    p = jax.nn.softmax(s, axis=-1).astype(v.dtype)
    return jnp.einsum('bkgqs,bskd->bqkgd', p, v)


def _diff_block(qb, k, v, lam):
    s = jnp.einsum('bqhcd,bshcd->bhcqs', qb, k).astype(jnp.float32) * (HEAD_DIM ** -0.5)
    p = jax.nn.softmax(s, axis=-1)
    a = p[:, :, 0] - lam * p[:, :, 1]
    return jnp.einsum('bhqs,bshe->bqhe', a.astype(v.dtype), v)


def _conv_branch(a, g, conv_w, ln_g, ln_b):
    y = a * jax.nn.sigmoid(g)
    pad = CONV_WIDTH // 2
    y = lax.conv_general_dilated(y, conv_w[:, None, :].astype(y.dtype), (1,), [(pad, pad)],
                                 dimension_numbers=('NWC', 'WIO', 'NWC'), feature_group_count=CONV_CH)
    return jax.nn.silu(_layer_norm(y, ln_g, ln_b))


def _even_mixer(h_lat, h_ctx, w_in, conv_w, ln_g, ln_b, qn_g, kn_g, w_out, cos, sin, need_ctx):
    bsz, n_lat, _ = h_lat.shape
    n_ctx = h_ctx.shape[1]
    cuts = [CONV_CH, 2 * CONV_CH, 2 * CONV_CH + GQA_Q_W, 2 * CONV_CH + GQA_Q_W + GQA_KV_W]
    a_l, g_l, q_l, k_l, v_l = jnp.split(h_lat @ w_in, cuts, axis=-1)
    a_c, g_c, q_c, k_c, v_c = jnp.split(h_ctx @ w_in, cuts, axis=-1)
    q_l = _apply_rope(_rms_norm(q_l.reshape(bsz, n_lat, GQA_HEADS, HEAD_DIM), qn_g), cos, sin)
    k_l = _apply_rope(_rms_norm(k_l.reshape(bsz, n_lat, GQA_KV_HEADS, HEAD_DIM), kn_g), cos, sin)
    v_l = v_l.reshape(bsz, n_lat, GQA_KV_HEADS, HEAD_DIM)
    k_c = _rms_norm(k_c.reshape(bsz, n_ctx, GQA_KV_HEADS, HEAD_DIM), kn_g)
    v_c = v_c.reshape(bsz, n_ctx, GQA_KV_HEADS, HEAD_DIM)
    keys = jnp.concatenate([k_l, k_c], axis=1)
    vals = jnp.concatenate([v_l, v_c], axis=1)
    q_l = q_l.reshape(bsz, n_lat, GQA_KV_HEADS, GQA_GROUP, HEAD_DIM)
    att_l = _sweep_query_blocks(lambda qb: _gqa_block(qb, keys, vals), q_l).reshape(bsz, n_lat, GQA_Q_W)
    conv_l = _conv_branch(a_l, g_l, conv_w, ln_g, ln_b)
    y_l = jnp.concatenate([conv_l, att_l], axis=-1) @ w_out
    y_c = None
    if need_ctx:
        q_c = _rms_norm(q_c.reshape(bsz, n_ctx, GQA_HEADS, HEAD_DIM), qn_g)
        q_c = q_c.reshape(bsz, n_ctx, GQA_KV_HEADS, GQA_GROUP, HEAD_DIM)
        att_c = _gqa_block(q_c, k_c, v_c).reshape(bsz, n_ctx, GQA_Q_W)
        conv_c = _conv_branch(a_c, g_c, conv_w, ln_g, ln_b)
        y_c = jnp.concatenate([conv_c, att_c], axis=-1) @ w_out
    return y_l, y_c


def _odd_mixer(h_lat, h_ctx, w_in, lam_p, subln_g, w_out, cos, sin, lam_init, need_ctx):
    def proj(h):
        b, n, _ = h.shape
        q, k, v = jnp.split(h @ w_in, [DIFF_QK_W, 2 * DIFF_QK_W], axis=-1)
        return (q.reshape(b, n, DIFF_HEADS, 2, HEAD_DIM), k.reshape(b, n, DIFF_HEADS, 2, HEAD_DIM),
                v.reshape(b, n, DIFF_HEADS, DIFF_V_DIM))

    q_l, k_l, v_l = proj(h_lat)
    q_c, k_c, v_c = proj(h_ctx)
    q_l = _apply_rope(q_l, cos, sin)
    k_l = _apply_rope(k_l, cos, sin)
    lp = lam_p.astype(jnp.float32)
    lam = jnp.exp(jnp.sum(lp[0] * lp[1])) - jnp.exp(jnp.sum(lp[2] * lp[3])) + lam_init
    keys = jnp.concatenate([k_l, k_c], axis=1)
    vals = jnp.concatenate([v_l, v_c], axis=1)

    def finish(o):
        o = _rms_norm(o, subln_g) * (1.0 - lam_init)
        return o.reshape(o.shape[0], o.shape[1], DIFF_HEADS * DIFF_V_DIM) @ w_out

    y_l = finish(_sweep_query_blocks(lambda qb: _diff_block(qb, keys, vals, lam), q_l))
    y_c = finish(_diff_block(q_c, k_c, v_c, lam)) if need_ctx else None
    return y_l, y_c


def _swiglu(h, wg, wu, wd):
    return (jax.nn.silu(h @ wg) * (h @ wu)) @ wd


def _moe(h, router_w, wg, wu, wd):
    logits = (h @ router_w).astype(jnp.float32)
    top_v, top_i = lax.top_k(logits, TOP_K)
    top_w = jax.nn.softmax(top_v, axis=-1)
    combine = jnp.sum(jax.nn.one_hot(top_i, N_EXPERTS, dtype=jnp.float32) * top_w[..., None], axis=-2)
    y = jnp.zeros_like(h)
    for e in range(N_EXPERTS):
        y = y + combine[..., e:e + 1].astype(h.dtype) * _swiglu(h, wg[e], wu[e], wd[e])
    return y


def setup_inputs(seed: int = 0) -> dict:
    key = jax.random.key(seed)
    ks = iter(jax.random.split(key, 32))
    f32 = jnp.float32
    D, F = D_MODEL, FFN_DIM

    def nrm(shape, scale):
        return jax.random.normal(next(ks), shape, f32) * scale

    def gain(shape):
        return 1.0 + nrm(shape, 0.02)

    return {
        'x': nrm((BATCH, SEQ, D), 1.0),
        'c': nrm((BATCH, D), 1.0),
        'ctx': nrm((BATCH, CTX_LEN, D), 1.0),
        'c_ctx': nrm((D,), 1.0),
        'ada_w': nrm((DEPTH, D, 6 * D), 0.5 * D ** -0.5),
        'ada_b': nrm((DEPTH, 6 * D), 0.02),
        'norm1_g': gain((DEPTH, D)),
        'norm2_g': gain((DEPTH, D)),
        'ev_w_in': nrm((N_EVEN, D, EVEN_IN), D ** -0.5),
        'ev_conv_w': nrm((N_EVEN, CONV_WIDTH, CONV_CH), CONV_WIDTH ** -0.5),
        'ev_ln_g': gain((N_EVEN, CONV_CH)),
        'ev_ln_b': nrm((N_EVEN, CONV_CH), 0.02),
        'ev_q_norm_g': gain((N_EVEN, HEAD_DIM)),
        'ev_k_norm_g': gain((N_EVEN, HEAD_DIM)),
        'ev_w_out': nrm((N_EVEN, EVEN_MIX, D), EVEN_MIX ** -0.5),
        'ev_ffn_wg': nrm((N_EVEN, D, F), D ** -0.5),
        'ev_ffn_wu': nrm((N_EVEN, D, F), D ** -0.5),
        'ev_ffn_wd': nrm((N_EVEN, F, D), F ** -0.5),
        'od_w_in': nrm((N_ODD, D, ODD_IN), D ** -0.5),
        'od_lam': nrm((N_ODD, 4, HEAD_DIM), 0.1),
        'od_subln_g': gain((N_ODD, DIFF_V_DIM)),
        'od_w_out': nrm((N_ODD, DIFF_HEADS * DIFF_V_DIM, D), (DIFF_HEADS * DIFF_V_DIM) ** -0.5),
        'od_router_w': nrm((N_ODD, D, N_EXPERTS), D ** -0.5),
        'od_moe_wg': nrm((N_ODD, N_EXPERTS, D, F), D ** -0.5),
        'od_moe_wu': nrm((N_ODD, N_EXPERTS, D, F), D ** -0.5),
        'od_moe_wd': nrm((N_ODD, N_EXPERTS, F, D), F ** -0.5),
        'final_norm_g': gain((D,)),
    }


def reference(x, c, ctx, c_ctx, ada_w, ada_b, norm1_g, norm2_g, ev_w_in, ev_conv_w, ev_ln_g, ev_ln_b,
              ev_q_norm_g, ev_k_norm_g, ev_w_out, ev_ffn_wg, ev_ffn_wu, ev_ffn_wd, od_w_in, od_lam,
              od_subln_g, od_w_out, od_router_w, od_moe_wg, od_moe_wu, od_moe_wd, final_norm_g):
    n_lat = x.shape[1]
    cos, sin = _axial_rope_tables(n_lat)
    s_lat = jax.nn.silu(c)
    s_ctx = jax.nn.silu(c_ctx)
    xl, xc = x, ctx
    for l in range(DEPTH):
        need_ctx = l < DEPTH - 1
        i = l // 2
        m_l = jnp.split((s_lat @ ada_w[l] + ada_b[l])[:, None, :], 6, axis=-1)
        m_c = jnp.split((s_ctx @ ada_w[l] + ada_b[l])[None, None, :], 6, axis=-1)
        h_l = _rms_norm(xl, norm1_g[l]) * (1.0 + m_l[1]) + m_l[0]
        h_c = _rms_norm(xc, norm1_g[l]) * (1.0 + m_c[1]) + m_c[0]
        if l % 2 == 0:
            y_l, y_c = _even_mixer(h_l, h_c, ev_w_in[i], ev_conv_w[i], ev_ln_g[i], ev_ln_b[i],
                                   ev_q_norm_g[i], ev_k_norm_g[i], ev_w_out[i], cos, sin, need_ctx)
        else:
            lam_init = 0.8 - 0.6 * float(np.exp(-0.3 * l))
            y_l, y_c = _odd_mixer(h_l, h_c, od_w_in[i], od_lam[i], od_subln_g[i], od_w_out[i],
                                  cos, sin, lam_init, need_ctx)
        xl = xl + m_l[2] * y_l
        if need_ctx:
            xc = xc + m_c[2] * y_c
        h_l = _rms_norm(xl, norm2_g[l]) * (1.0 + m_l[4]) + m_l[3]
        if l % 2 == 0:
            xl = xl + m_l[5] * _swiglu(h_l, ev_ffn_wg[i], ev_ffn_wu[i], ev_ffn_wd[i])
        else:
            xl = xl + m_l[5] * _moe(h_l, od_router_w[i], od_moe_wg[i], od_moe_wu[i], od_moe_wd[i])
        if need_ctx:
            h_c = _rms_norm(xc, norm2_g[l]) * (1.0 + m_c[4]) + m_c[3]
            if l % 2 == 0:
                xc = xc + m_c[5] * _swiglu(h_c, ev_ffn_wg[i], ev_ffn_wu[i], ev_ffn_wd[i])
            else:
                xc = xc + m_c[5] * _moe(h_c, od_router_w[i], od_moe_wg[i], od_moe_wu[i], od_moe_wd[i])
    return _rms_norm(xl, final_norm_g)
```

```cpp
#include <hip/hip_runtime.h>
#include <hip/hip_bf16.h>
#include <cstdio>
#include <cstdint>
#include <cmath>
#define MK_ONE_LAUNCH 0
namespace pg8 {
#define PG8_LAS __attribute__((address_space(3)))
typedef unsigned short bf16_t;
typedef short bf16x8 __attribute__((ext_vector_type(8)));
typedef float f32x4 __attribute__((ext_vector_type(4)));
typedef unsigned u32x4 __attribute__((ext_vector_type(4)));
constexpr int BM = 256, BK = 64, HALF = 128, HTB = HALF * BK * 2  , STAGE_BYTES = 8 * HTB, NXCD = 8, WGM = 8;

__host__ __device__ __forceinline__ int lds_byte(int r, int c) { const int st = (r >> 4) * 2 + (c >> 5), rr = r & 15, cc = c & 31, ob = rr * 64 + cc * 2; return st * 1024 + (ob ^ (((ob >> 9) & 1) << 5)); }
__host__ __device__ __forceinline__ void stage_rc(int b, int& R, int& C) { const int st = b / 1024, sb = b % 1024, swz = sb ^ (((sb >> 9) & 1) << 5); R = (st >> 1) * 16 + swz / 64; C = (st & 1) * 32 + (swz % 64) / 2; }
__host__ __device__ __forceinline__ int perm32(int rho) { const int n = rho >> 4, i = rho & 15; return 8 * (i >> 2) + 4 * n + (i & 3); }

struct Unit { int pm, pn; };
struct Gemm { const bf16_t* A; const bf16_t* Bt; int M, N, K; };

struct StaticOrder {
    int nM, nN, nwg, G, c;
    __host__ __device__ void init(int M, int N, int G_, int c_) { nM = M / BM; nN = N / BM; nwg = nM * nN; G = G_; c = c_; }
    __host__ __device__ bool next(int i, Unit& u) const {
        const long L = (long)i * G + c; if (L >= nwg) return false;
        int wgid = (int)L; { const int q = nwg / NXCD, r = nwg % NXCD, xcd = wgid % NXCD, off = wgid / NXCD; wgid = (xcd < r ? xcd * (q + 1) : r * (q + 1) + (xcd - r) * q) + off; }
        const int nig = WGM * nN, gid = wgid / nig, fm = gid * WGM, gsz = (nM - fm) < WGM ? (nM - fm) : WGM;
        u.pm = fm + ((wgid % nig) % gsz); u.pn = (wgid % nig) / gsz; return true;
    }
    __device__ __forceinline__ void a_ready(const Unit&) const {}
    __device__ __forceinline__ void done(const Unit&) const {}
};

__device__ __forceinline__ unsigned cvt_pk_bf16(float lo, float hi) { unsigned r; asm volatile("v_cvt_pk_bf16_f32 %0, %1, %2" : "=v"(r) : "v"(lo), "v"(hi)); return r; }
template <class Epi, class Sched, bool ALIGN_EPI = false, bool SP2 = false>
__device__ __forceinline__ void gemm_phase(PG8_LAS unsigned char* lds, const Gemm g, const Sched& S, const Epi& E, const int tid) {
    const int wid = __builtin_amdgcn_readfirstlane(tid >> 6), lane = tid & 63, wr = wid >> 2, wc = wid & 3, fr = lane & 15, fq = lane >> 4;
    const int K = g.K, nt = K / BK;
    unsigned voffA[2], voffB[2];
#pragma unroll
    for (int i = 0; i < 2; ++i) { int R, C; stage_rc(tid * 16 + i * 8192, R, C); const int Rb = Epi::PERM ? ((R & ~31) + perm32(R & 31)) : R;
        voffA[i] = (unsigned)(R * K + C) * 2u; voffB[i] = (unsigned)(Rb * K + C) * 2u; }
    const size_t kstep = (size_t)(BK * 2);
    const size_t hstep = (size_t)HALF * K * 2;
    const size_t tstep = 2 * hstep;
    const unsigned ldsw = (unsigned)wid * 1024u;
    const int aoff = lds_byte(wr * 64 + fr, fq * 8), boff = lds_byte(wc * 32 + fr, fq * 8);
#define PG8_SA(b, h) (((b) * 2 + (h)) * HTB)
#define PG8_SB(b, h) ((4 + (b) * 2 + (h)) * HTB)
#define PG8_STAGE(bufoff, gbase, voff) do { _Pragma("unroll") for (int _i = 0; _i < 2; ++_i) \
        __builtin_amdgcn_global_load_lds((const unsigned*)((const char*)(gbase) + (voff)[_i]), (PG8_LAS unsigned*)(lds + (bufoff) + ldsw + _i * 8192), 16, 0, 0); } while (0)
#define PG8_LDA(dst, b, h) do { _Pragma("unroll") for (int m = 0; m < 4; ++m) _Pragma("unroll") for (int k = 0; k < 2; ++k) dst[m][k] = *(const PG8_LAS bf16x8*)(lds + PG8_SA(b, h) + aoff + m * 2048 + k * 1024); } while (0)
#define PG8_LDB(dst, b, h) do { _Pragma("unroll") for (int n = 0; n < 2; ++n) _Pragma("unroll") for (int k = 0; k < 2; ++k) dst[n][k] = *(const PG8_LAS bf16x8*)(lds + PG8_SB(b, h) + boff + n * 2048 + k * 1024); } while (0)
#define PG8_MMA(ai, bj, At, Bt) do { __builtin_amdgcn_s_setprio(1); _Pragma("unroll") for (int m = 0; m < 4; ++m) _Pragma("unroll") for (int n = 0; n < 2; ++n) _Pragma("unroll") for (int k = 0; k < 2; ++k) \
        acc[ai][bj][m][n] = __builtin_amdgcn_mfma_f32_16x16x32_bf16(Bt[n][k], At[m][k], acc[ai][bj][m][n], 0, 0, 0); __builtin_amdgcn_s_setprio(0); } while (0)
#define PG8_WAIT_V(n) asm volatile("s_waitcnt vmcnt(" #n ")" ::: "memory")
#define PG8_WAIT_L(n) asm volatile("s_waitcnt lgkmcnt(" #n ")" ::: "memory")
#define PG8_BAR __builtin_amdgcn_s_barrier()
#define PG8_SCHED __builtin_amdgcn_sched_barrier(0)
    Unit cur, nxt; int ui = 0;
    if (!S.next(0, cur)) return;
    f32x4 acc[2][2][4][2];
#pragma unroll
    for (int a = 0; a < 2; ++a)
#pragma unroll
        for (int b = 0; b < 2; ++b)
#pragma unroll
            for (int m = 0; m < 4; ++m)
#pragma unroll
                for (int n = 0; n < 2; ++n) acc[a][b][m][n] = (f32x4){0.f, 0.f, 0.f, 0.f};
    bf16x8 At[4][2], B0[2][2], B1[2][2];
    const char* cA = (const char*)g.A + (size_t)cur.pm * tstep; const char* cB = (const char*)g.Bt + (size_t)cur.pn * tstep;
    S.a_ready(cur);
    if constexpr (SP2) {
        PG8_STAGE(PG8_SB(0, 0), cB, voffB); PG8_STAGE(PG8_SB(0, 1), cB + hstep, voffB); PG8_STAGE(PG8_SA(0, 0), cA, voffA); PG8_STAGE(PG8_SA(0, 1), cA + hstep, voffA);
        if (wr == 1) PG8_BAR;
        PG8_WAIT_V(2); PG8_BAR;
        PG8_STAGE(PG8_SB(1, 0), cB + kstep, voffB); PG8_STAGE(PG8_SA(1, 0), cA + kstep, voffA); PG8_STAGE(PG8_SB(1, 1), cB + hstep + kstep, voffB);
        PG8_WAIT_V(6); PG8_BAR;
    } else {
        PG8_STAGE(PG8_SB(0, 0), cB, voffB); PG8_STAGE(PG8_SA(0, 0), cA, voffA); PG8_STAGE(PG8_SB(0, 1), cB + hstep, voffB); PG8_STAGE(PG8_SA(0, 1), cA + hstep, voffA);
        if (wr == 1) PG8_BAR;
        PG8_WAIT_V(4); PG8_BAR;
        PG8_STAGE(PG8_SB(1, 0), cB + kstep, voffB); PG8_STAGE(PG8_SA(1, 0), cA + kstep, voffA); PG8_STAGE(PG8_SB(1, 1), cB + hstep + kstep, voffB);
        PG8_WAIT_V(6); PG8_BAR;
    }
    for (;;) {
        const bool has_next = S.next(ui + 1, nxt);
        const char* nA = has_next ? (const char*)g.A + (size_t)nxt.pm * tstep : cA; const char* nB = has_next ? (const char*)g.Bt + (size_t)nxt.pn * tstep : cB;
        for (int t = 0; t < nt; t += 2) {
            const bool last = (t == nt - 2);
            const char* a1 = cA + (size_t)(t + 1) * kstep;
            const char* a2 = last ? nA : cA + (size_t)(t + 2) * kstep; const char* b2 = last ? nB : cB + (size_t)(t + 2) * kstep;
            const char* a3 = a2 + kstep; const char* b3 = b2 + kstep;
            if (last && has_next) S.a_ready(nxt);
            if constexpr (SP2) {
            PG8_LDB(B0, 0, 0); PG8_LDB(B1, 0, 1); PG8_SCHED; PG8_LDA(At, 0, 0); PG8_STAGE(PG8_SA(1, 1), a1 + hstep, voffA);
            PG8_WAIT_V(8); PG8_WAIT_L(0); PG8_BAR; PG8_MMA(0, 0, At, B0); PG8_MMA(0, 1, At, B1); PG8_BAR; PG8_SCHED;
            PG8_LDA(At, 0, 1); PG8_STAGE(PG8_SB(0, 0), b2, voffB); PG8_STAGE(PG8_SB(0, 1), b2 + hstep, voffB); PG8_STAGE(PG8_SA(0, 0), a2, voffA);
            PG8_WAIT_V(8); PG8_WAIT_L(0); PG8_BAR; PG8_MMA(1, 0, At, B0); PG8_MMA(1, 1, At, B1); PG8_BAR; PG8_SCHED;
            PG8_LDB(B0, 1, 0); PG8_LDB(B1, 1, 1); PG8_SCHED; PG8_LDA(At, 1, 0); PG8_STAGE(PG8_SA(0, 1), a2 + hstep, voffA);
            PG8_WAIT_V(8); PG8_WAIT_L(0); PG8_BAR; PG8_MMA(0, 0, At, B0); PG8_MMA(0, 1, At, B1); PG8_BAR; PG8_SCHED;
            PG8_LDA(At, 1, 1); PG8_STAGE(PG8_SB(1, 0), b3, voffB); PG8_STAGE(PG8_SB(1, 1), b3 + hstep, voffB); PG8_STAGE(PG8_SA(1, 0), a3, voffA);
            PG8_WAIT_V(8); PG8_WAIT_L(0); PG8_BAR; PG8_MMA(1, 0, At, B0); PG8_MMA(1, 1, At, B1); PG8_BAR; PG8_SCHED;
            } else {
            PG8_LDB(B0, 0, 0); PG8_SCHED; PG8_LDA(At, 0, 0); PG8_STAGE(PG8_SA(1, 1), a1 + hstep, voffA);
            PG8_WAIT_L(8); PG8_BAR; PG8_WAIT_L(0); PG8_MMA(0, 0, At, B0); PG8_BAR; PG8_SCHED;
            PG8_LDB(B1, 0, 1); PG8_STAGE(PG8_SB(0, 0), b2, voffB);
            PG8_BAR; PG8_WAIT_L(0); PG8_MMA(0, 1, At, B1); PG8_BAR;
            PG8_LDA(At, 0, 1); PG8_STAGE(PG8_SA(0, 0), a2, voffA);
            PG8_BAR; PG8_WAIT_L(0); PG8_MMA(1, 0, At, B0); PG8_BAR; PG8_SCHED;
            PG8_STAGE(PG8_SB(0, 1), b2 + hstep, voffB);
            PG8_WAIT_V(6); PG8_BAR; PG8_MMA(1, 1, At, B1); PG8_BAR;
            PG8_LDB(B0, 1, 0); PG8_SCHED; PG8_LDA(At, 1, 0); PG8_STAGE(PG8_SA(0, 1), a2 + hstep, voffA);
            PG8_WAIT_L(8); PG8_BAR; PG8_WAIT_L(0); PG8_MMA(0, 0, At, B0); PG8_BAR; PG8_SCHED;
            PG8_LDB(B1, 1, 1); PG8_STAGE(PG8_SB(1, 0), b3, voffB);
            PG8_BAR; PG8_WAIT_L(0); PG8_MMA(0, 1, At, B1); PG8_BAR;
            PG8_LDA(At, 1, 1); PG8_STAGE(PG8_SA(1, 0), a3, voffA);
            PG8_BAR; PG8_WAIT_L(0); PG8_MMA(1, 0, At, B0); PG8_BAR; PG8_SCHED;
            PG8_STAGE(PG8_SB(1, 1), b3 + hstep, voffB);
            PG8_WAIT_V(6); PG8_BAR; PG8_MMA(1, 1, At, B1); PG8_BAR;
            }
        }
        if constexpr (ALIGN_EPI) { if (wr == 0) PG8_BAR; }
        if constexpr (!Epi::AFTER_DRAIN) { E(acc, cur, wr, wc, fr, fq); S.done(cur); }
        if (!has_next) break;
#pragma unroll
        for (int a = 0; a < 2; ++a)
#pragma unroll
            for (int b = 0; b < 2; ++b)
#pragma unroll
                for (int m = 0; m < 4; ++m)
#pragma unroll
                    for (int n = 0; n < 2; ++n) acc[a][b][m][n] = (f32x4){0.f, 0.f, 0.f, 0.f};
        cur = nxt; cA = nA; cB = nB; ++ui;
        if constexpr (ALIGN_EPI) { if (wr == 1) PG8_BAR; }
    }
    PG8_WAIT_V(0);
    if constexpr (!ALIGN_EPI) { if (wr == 0) PG8_BAR; }
    PG8_BAR;
    if constexpr (Epi::AFTER_DRAIN) { E.fused(acc, cur, wr, wc, fr, fq, lds, wid, lane); S.done(cur); }
#undef PG8_SA
#undef PG8_SB
#undef PG8_STAGE
#undef PG8_LDA
#undef PG8_LDB
#undef PG8_MMA
#undef PG8_WAIT_V
#undef PG8_WAIT_L
#undef PG8_BAR
#undef PG8_SCHED
}
}
constexpr int D = 1024, NB = 16, SEQ = 2048, CTXL = 256, RB = SEQ + CTXL  , M_ALL = NB * RB  ;
constexpr int FF = 3584, NE = 8;
constexpr int EV_IN = 1792, EV_P = 1280;
constexpr int OD_IN = 3072;
constexpr int OP_P = 2048;
constexpr int MAX_SLOT_TILES = 304, MAX_SLOTS = MAX_SLOT_TILES * 256;
constexpr float LOG2E = 1.4426950408889634f;
constexpr float QSCALE = 0.125f * LOG2E;

__device__ __forceinline__ float fast_sigmoid(float x) { return __builtin_amdgcn_rcpf(1.f + __builtin_amdgcn_exp2f(-x * LOG2E)); }
__device__ __forceinline__ float fast_silu(float x) { return x * fast_sigmoid(x); }

namespace pg8 {
struct EpiStoreBf16 {
    static constexpr bool PERM = true, AFTER_DRAIN = false;
    bf16_t* O; int ldc; int coloff;
    __device__ __forceinline__ void operator()(const f32x4 (&acc)[2][2][4][2], const Unit& u, int wr, int wc, int fr, int fq) const {
        const int row0 = u.pm * BM + wr * 64 + fr, col0 = coloff + u.pn * BM + wc * 32 + 8 * fq;
#pragma unroll
        for (int ai = 0; ai < 2; ++ai)
#pragma unroll
            for (int m = 0; m < 4; ++m) { bf16_t* rowp = O + (size_t)(row0 + ai * HALF + m * 16) * ldc + col0;
#pragma unroll
                for (int bj = 0; bj < 2; ++bj) { const f32x4 v0 = acc[ai][bj][m][0], v1 = acc[ai][bj][m][1];
                    u32x4 w; w.x = cvt_pk_bf16(v0[0], v0[1]); w.y = cvt_pk_bf16(v0[2], v0[3]); w.z = cvt_pk_bf16(v1[0], v1[1]); w.w = cvt_pk_bf16(v1[2], v1[3]);
                    *(u32x4*)(rowp + bj * HALF) = w; } }
    }
};
struct EpiEvenIn {
    static constexpr bool PERM = true, AFTER_DRAIN = false;
    bf16_t* EV;
    __device__ __forceinline__ void operator()(const f32x4 (&acc)[2][2][4][2], const Unit& u, int wr, int wc, int fr, int fq) const {
        const int row0 = u.pm * BM + wr * 64 + fr;
        if (u.pn < 4) {
            const int col0 = u.pn * HALF + wc * 32 + 8 * fq;
#pragma unroll
            for (int ai = 0; ai < 2; ++ai)
#pragma unroll
                for (int m = 0; m < 4; ++m) { bf16_t* rowp = EV + (size_t)(row0 + ai * HALF + m * 16) * EV_P + col0;
                    const f32x4 a0 = acc[ai][0][m][0], a1 = acc[ai][0][m][1], g0 = acc[ai][1][m][0], g1 = acc[ai][1][m][1];
                    u32x4 w; w.x = cvt_pk_bf16(a0[0] * fast_sigmoid(g0[0]), a0[1] * fast_sigmoid(g0[1])); w.y = cvt_pk_bf16(a0[2] * fast_sigmoid(g0[2]), a0[3] * fast_sigmoid(g0[3]));
                    w.z = cvt_pk_bf16(a1[0] * fast_sigmoid(g1[0]), a1[1] * fast_sigmoid(g1[1])); w.w = cvt_pk_bf16(a1[2] * fast_sigmoid(g1[2]), a1[3] * fast_sigmoid(g1[3]));
                    *(u32x4*)rowp = w; }
        } else {
            const int col0 = 512 + (u.pn - 4) * BM + wc * 32 + 8 * fq;
#pragma unroll
            for (int ai = 0; ai < 2; ++ai)
#pragma unroll
                for (int m = 0; m < 4; ++m) { bf16_t* rowp = EV + (size_t)(row0 + ai * HALF + m * 16) * EV_P + col0;
#pragma unroll
                    for (int bj = 0; bj < 2; ++bj) { const f32x4 v0 = acc[ai][bj][m][0], v1 = acc[ai][bj][m][1];
                        u32x4 w; w.x = cvt_pk_bf16(v0[0], v0[1]); w.y = cvt_pk_bf16(v0[2], v0[3]); w.z = cvt_pk_bf16(v1[0], v1[1]); w.w = cvt_pk_bf16(v1[2], v1[3]);
                        *(u32x4*)(rowp + bj * HALF) = w; } }
        }
    }
};
struct EpiSwiGLU {
    static constexpr bool PERM = true, AFTER_DRAIN = false;
    bf16_t* ACT; int npl;
    __device__ __forceinline__ void operator()(const f32x4 (&acc)[2][2][4][2], const Unit& u, int wr, int wc, int fr, int fq) const {
        const int row0 = u.pm * BM + wr * 64 + fr, col0 = (u.pn % npl) * HALF + wc * 32 + 8 * fq;
#pragma unroll
        for (int ai = 0; ai < 2; ++ai)
#pragma unroll
            for (int m = 0; m < 4; ++m) { bf16_t* rowp = ACT + (size_t)(row0 + ai * HALF + m * 16) * FF + col0;
                const f32x4 g0 = acc[ai][0][m][0], g1 = acc[ai][0][m][1], u0 = acc[ai][1][m][0], u1 = acc[ai][1][m][1];
                u32x4 w; w.x = cvt_pk_bf16(fast_silu(g0[0]) * u0[0], fast_silu(g0[1]) * u0[1]); w.y = cvt_pk_bf16(fast_silu(g0[2]) * u0[2], fast_silu(g0[3]) * u0[3]);
                w.z = cvt_pk_bf16(fast_silu(g1[0]) * u1[0], fast_silu(g1[1]) * u1[1]); w.w = cvt_pk_bf16(fast_silu(g1[2]) * u1[2], fast_silu(g1[3]) * u1[3]);
                *(u32x4*)rowp = w; }
    }
};
struct EpiResid {
    static constexpr bool PERM = false, AFTER_DRAIN = false;
    float* out; float* xc; const float* gate;
    __device__ __forceinline__ void operator()(const f32x4 (&acc)[2][2][4][2], const Unit& u, int wr, int wc, int fr, int fq) const {
        const int b = u.pm / 9, j = u.pm - b * 9;
        float* base = (j < 8) ? out + (size_t)(b * SEQ + j * BM) * D : xc + (size_t)(b * CTXL) * D;
        const float* gp = gate + (size_t)((j < 8) ? b : NB) * 6144;
        const int col0 = u.pn * BM + wc * 32 + 4 * fq;
        f32x4 gv[2][2];
#pragma unroll
        for (int bj = 0; bj < 2; ++bj)
#pragma unroll
            for (int n = 0; n < 2; ++n) gv[bj][n] = *(const f32x4*)(gp + col0 + bj * HALF + n * 16);
#pragma unroll
        for (int ai = 0; ai < 2; ++ai)
#pragma unroll
            for (int m = 0; m < 4; ++m) { float* rowp = base + (size_t)(ai * HALF + wr * 64 + m * 16 + fr) * D + col0;
#pragma unroll
                for (int bj = 0; bj < 2; ++bj)
#pragma unroll
                    for (int n = 0; n < 2; ++n) { f32x4* p = (f32x4*)(rowp + bj * HALF + n * 16); *p = *p + gv[bj][n] * acc[ai][bj][m][n]; } }
    }
};
struct EpiResidMoe {
    static constexpr bool PERM = false, AFTER_DRAIN = false;
    float* out; float* xc; const float* gate; const int* slot_tok; const float* slot_w;
    __device__ __forceinline__ void operator()(const f32x4 (&acc)[2][2][4][2], const Unit& u, int wr, int wc, int fr, int fq) const {
        const int col0 = (u.pn & 3) * BM + wc * 32 + 4 * fq;
#pragma unroll
        for (int ai = 0; ai < 2; ++ai)
#pragma unroll
            for (int m = 0; m < 4; ++m) { const int slot = u.pm * BM + ai * HALF + wr * 64 + m * 16 + fr; const int tok = slot_tok[slot];
                if (tok >= 0) { const float w = slot_w[slot]; const int b = tok / RB, t = tok - b * RB;
                    float* rowp = ((t < SEQ) ? out + (size_t)(b * SEQ + t) * D : xc + (size_t)(b * CTXL + t - SEQ) * D) + col0;
                    const float* gp = gate + (size_t)((t < SEQ) ? b : NB) * 6144 + col0;
#pragma unroll
                    for (int bj = 0; bj < 2; ++bj)
#pragma unroll
                        for (int n = 0; n < 2; ++n) { f32x4* p = (f32x4*)(rowp + bj * HALF + n * 16); const f32x4 g = *(const f32x4*)(gp + bj * HALF + n * 16); *p = *p + (g * w) * acc[ai][bj][m][n]; } } }
    }
};
struct MapOrder {
    StaticOrder so; int mode; int tlo; int npl; const PG8_LAS int* tab;
    __device__ __forceinline__ void init(int nM, int nN, int G, int c, int mode_, int tlo_ = 0, int npl_ = 0, const PG8_LAS int* tab_ = nullptr) { so.init(nM * BM, nN * BM, G, c); mode = mode_; tlo = tlo_; npl = npl_; tab = tab_; }
    __device__ __forceinline__ bool next(int i, Unit& u) const {
        if (!so.next(i, u)) return false;
        if (mode == 1) u.pm = (u.pm >> 3) * 9 + (u.pm & 7);
        else if (mode == 2) { u.pm += tlo; const int e = __builtin_amdgcn_readfirstlane(tab[u.pm]); u.pn += e * npl; }
        return true;
    }
    __device__ __forceinline__ void a_ready(const Unit&) const {}
    __device__ __forceinline__ void done(const Unit&) const {}
};
}
namespace attn_body {
using bf16=__hip_bfloat16;
using bf16x8=__attribute__((ext_vector_type(8)))short;
using s16x4=__attribute__((ext_vector_type(4)))short;
using f32x16=__attribute__((ext_vector_type(16)))float;
using u32x4=__attribute__((ext_vector_type(4)))unsigned;
constexpr int D=64;
constexpr int NW=8,QBLK=32,QB=QBLK*NW,KVBLK=64;
constexpr int ATTN_UNIT_ROWS=QB;
__device__ __forceinline__ int crow(int r,int hi){return (r&3)+8*(r>>2)+4*hi;}
#define SBAR() __builtin_amdgcn_sched_barrier(0)
constexpr int NSLOT=3, SLOTB=8192;
constexpr int LDS_K=0, LDS_V=NSLOT*SLOTB, LDS_WS=2*NSLOT*SLOTB, LDS_OST=LDS_WS+NW*64*4, LDS_BYTES=LDS_OST+NW*4096;
constexpr float C2=0.125f*1.4426950408889634f;
__device__ __forceinline__ void glds16(const void*gsrc,unsigned lds_dst){unsigned keep;
  asm volatile("s_mov_b32 %0, m0\n\ts_mov_b32 m0, %2\n\ts_nop 0\n\tglobal_load_lds_dwordx4 %1, off\n\ts_mov_b32 m0, %0":"=&s"(keep):"v"(gsrc),"s"(lds_dst):"memory");}
__device__ __forceinline__ float max3f(float a,float b,float c){float r;asm("v_max3_f32 %0, %1, %2, %3":"=v"(r):"v"(a),"v"(b),"v"(c));return r;}
__device__ __forceinline__ float max2f(float a,float b){float r;asm("v_max_f32_e32 %0, %1, %2":"=v"(r):"v"(a),"v"(b));return r;}
__device__ __forceinline__ float fadd_s(float a,float b){float r;asm("v_add_f32_e32 %0, %1, %2":"=v"(r):"v"(a),"v"(b));return r;}
__device__ __forceinline__ float fsub_s(float a,float b){float r;asm("v_sub_f32_e32 %0, %1, %2":"=v"(r):"v"(a),"v"(b));return r;}
typedef float f32x2_t __attribute__((ext_vector_type(2))); typedef __bf16 bf16x2_t __attribute__((ext_vector_type(2)));
__device__ __forceinline__ unsigned cvtpk_s(float lo,float hi){f32x2_t v={lo,hi};bf16x2_t b=__builtin_convertvector(v,bf16x2_t);return __builtin_bit_cast(unsigned,b);}
#define WAIT_BAR(N) asm volatile("s_waitcnt vmcnt(" #N ") lgkmcnt(0)\n\ts_barrier":::"memory")

__device__ __forceinline__ void qkt(f32x16&p0,f32x16&p1,const char*Kslot,const bf16x8*qr,const f32x16&negm,int r32,int hi){
  const char*kb=Kslot+hi*1024+r32*16;
  #pragma unroll
  for(int d0=0;d0<4;++d0){
    const bf16x8 b0=*reinterpret_cast<const bf16x8*>(kb+d0*2048);
    const bf16x8 b1=*reinterpret_cast<const bf16x8*>(kb+d0*2048+512);
    if(d0==0){p0=__builtin_amdgcn_mfma_f32_32x32x16_bf16(b0,qr[0],negm,0,0,0);p1=__builtin_amdgcn_mfma_f32_32x32x16_bf16(b1,qr[0],negm,0,0,0);}
    else{p0=__builtin_amdgcn_mfma_f32_32x32x16_bf16(b0,qr[d0],p0,0,0,0);p1=__builtin_amdgcn_mfma_f32_32x32x16_bf16(b1,qr[d0],p1,0,0,0);}}
}
typedef __attribute__((address_space(3))) const char* lds_cptr;
typedef short v4i16_t __attribute__((ext_vector_type(4)));
__device__ __forceinline__ void kload8(bf16x8*kf,lds_cptr kp){
  kf[0]=*(const __attribute__((address_space(3))) bf16x8*)(kp);      kf[1]=*(const __attribute__((address_space(3))) bf16x8*)(kp+512);
  kf[2]=*(const __attribute__((address_space(3))) bf16x8*)(kp+2048); kf[3]=*(const __attribute__((address_space(3))) bf16x8*)(kp+2560);
  kf[4]=*(const __attribute__((address_space(3))) bf16x8*)(kp+4096); kf[5]=*(const __attribute__((address_space(3))) bf16x8*)(kp+4608);
  kf[6]=*(const __attribute__((address_space(3))) bf16x8*)(kp+6144); kf[7]=*(const __attribute__((address_space(3))) bf16x8*)(kp+6656);
}
__device__ __forceinline__ void kload2(bf16x8*kf,lds_cptr kp,int j){ kf[2*j]=*(const __attribute__((address_space(3))) bf16x8*)(kp+j*2048); kf[2*j+1]=*(const __attribute__((address_space(3))) bf16x8*)(kp+j*2048+512); }
__device__ __forceinline__ s16x4 vtr(lds_cptr p){ return __builtin_bit_cast(s16x4,__builtin_amdgcn_ds_read_tr16_b64_v4i16((__attribute__((address_space(3))) v4i16_t*)p)); }
__device__ __forceinline__ float rowmax(const f32x16&p0,const f32x16&p1){
  float a=max3f(p0[0],p0[1],p1[0]),b=max3f(p0[2],p0[3],p1[1]);a=max3f(a,p1[2],p1[3]);
  #pragma unroll
  for(int r=4;r<16;r+=4){a=max3f(a,p0[r],p0[r+1]);b=max3f(b,p0[r+2],p0[r+3]);a=max3f(a,p1[r],p1[r+1]);b=max3f(b,p1[r+2],p1[r+3]);}
  const float m=max2f(a,b);
  auto rr=__builtin_amdgcn_permlane32_swap(__float_as_uint(m),__float_as_uint(m),false,false);
  return max2f(__uint_as_float(rr[0]),__uint_as_float(rr[1]));
}
__device__ __forceinline__ void pv(f32x16*o,int vb,bf16x8 pa0,bf16x8 pa1,bf16x8 pa2,bf16x8 pa3){
  #pragma unroll
  for(int d0=0;d0<2;++d0){s16x4 lo[4],hi[4];
    #pragma unroll
    for(int ks=0;ks<4;++ks){
      asm volatile("ds_read_b64_tr_b16 %0,%1 offset:%c2":"=&v"(lo[ks]):"v"(vb),"i"(d0*4096+ks*1024):"memory");
      asm volatile("ds_read_b64_tr_b16 %0,%1 offset:%c2":"=&v"(hi[ks]):"v"(vb),"i"(d0*4096+ks*1024+512):"memory");}
    asm volatile("s_waitcnt lgkmcnt(0)":::"memory");SBAR();
    #define PK(k) (bf16x8){lo[k][0],lo[k][1],lo[k][2],lo[k][3],hi[k][0],hi[k][1],hi[k][2],hi[k][3]}
    o[d0]=__builtin_amdgcn_mfma_f32_32x32x16_bf16(pa0,PK(0),o[d0],0,0,0);
    o[d0]=__builtin_amdgcn_mfma_f32_32x32x16_bf16(pa1,PK(1),o[d0],0,0,0);
    o[d0]=__builtin_amdgcn_mfma_f32_32x32x16_bf16(pa2,PK(2),o[d0],0,0,0);
    o[d0]=__builtin_amdgcn_mfma_f32_32x32x16_bf16(pa3,PK(3),o[d0],0,0,0);
    #undef PK
  }
}

#ifndef ATTN_STORE16
#define ATTN_STORE16(p,v) (*(u32x4*)(p)=(v))
#endif
template<int THRL,int qp,int kp_,int vp_e,int op> __device__ __forceinline__ void attn_unit(const bf16*Qw0,const bf16*Kh,const bf16*Vh,bf16*Ow0,int NT,char*shm,const int tid){
  const int lane=tid&63,r32=lane&31,hi=lane>>5; const int wid=__builtin_amdgcn_readfirstlane(tid>>6);
  const bf16*Qw=Qw0+(long)(wid*QBLK)*qp;
  const unsigned lds0=(unsigned)(uintptr_t)shm;
  float*wsf=(float*)(shm+LDS_WS)+wid*64;
  const bf16*ksrc=Kh+(long)lane*kp_+wid*8;
  const bf16*vsrc=Vh+(long)(16*(wid&3)+(lane>>2))*vp_e+(wid>>2)*32+(lane&3)*8;
  const unsigned kdst=lds0+LDS_K+wid*1024, vdst=lds0+LDS_V+wid*1024;
  #define DMA_K(t,slot) glds16(ksrc+(long)(t)*KVBLK*kp_,(unsigned)__builtin_amdgcn_readfirstlane(kdst+(slot)))
  #define DMA_V(t,slot) glds16(vsrc+(long)(t)*KVBLK*vp_e,(unsigned)__builtin_amdgcn_readfirstlane(vdst+(slot)))
  const int vb0=(int)(lds0+LDS_V)+((lane>>4)&1)*32+(lane&3)*8+(4*hi+((lane&15)>>2))*64;
  const char*Kbase=shm+LDS_K; bf16x8 kf[8];
  const lds_cptr shm3=(lds_cptr)shm; const lds_cptr kp0=shm3+LDS_K+hi*1024+r32*16; const lds_cptr vp0=shm3+LDS_V+((lane>>4)&1)*32+(lane&3)*8+(4*hi+((lane&15)>>2))*64;
  DMA_K(0,0);DMA_V(0,0);DMA_K(1,SLOTB);
  bf16x8 qr[4];
  #pragma unroll
  for(int d0=0;d0<4;++d0)qr[d0]=*reinterpret_cast<const bf16x8*>(&Qw[(long)r32*qp+d0*16+hi*8]);
  float mhat=0.f,l_reg=0.f;f32x16 o[2];o[0]=f32x16{};o[1]=f32x16{};f32x16 negm=f32x16{};asm volatile("":"+v"(negm));
  #define CMASK(P0,P1,t) do{}while(0)
  bool resc=false;
  #define START(P0,P1) do{ const float rm=rowmax(P0,P1); resc=false; \
    { const float dl=rm; mhat=fadd_s(mhat,dl); \
      _Pragma("unroll") for(int r=0;r<16;++r){P0[r]=fsub_s(P0[r],dl);P1[r]=fsub_s(P1[r],dl);} \
      _Pragma("unroll") for(int r=0;r<16;++r)negm[r]=-mhat; asm volatile("":"+v"(negm)); } \
    _Pragma("unroll") for(int r=0;r<16;++r)P0[r]=__builtin_amdgcn_exp2f(P0[r]); }while(0)
  #define RESC() do{ if(resc){ asm volatile("s_waitcnt lgkmcnt(0)":::"memory"); \
      _Pragma("unroll") for(int d_=0;d_<2;++d_) _Pragma("unroll") for(int r=0;r<16;++r)o[d_][r]*=wsf[crow(r,hi)]; } }while(0)
  f32x16 pA0,pA1,pB0,pB1;
  int sl_prev=0,sl_cur=0,sl_next=SLOTB;
  #define ROT() do{sl_prev=sl_cur;sl_cur=sl_next;sl_next=(sl_next==(NSLOT-1)*SLOTB)?0:sl_next+SLOTB;}while(0)
  DMA_K(2,2*SLOTB);
  WAIT_BAR(3);
  qkt(pA0,pA1,Kbase,qr,negm,r32,hi);asm volatile("s_nop 15\n\ts_nop 7":"+v"(pA0),"+v"(pA1));CMASK(pA0,pA1,0);
  START(pA0,pA1);
  _Pragma("unroll") for(int r=0;r<16;++r)pA1[r]=__builtin_amdgcn_exp2f(pA1[r]);
  WAIT_BAR(0);
  DMA_K(3,0);DMA_V(1,SLOTB);
  ROT();
  kload8(kf,kp0+sl_cur);
  WAIT_BAR(2);
  s16x4 vlo[8],vhi[8]; u32x4 pw0,pw1,pw2,pw3;
  #define PKW(P,B) cvtpk_s(P[B],P[B+1])
  #define PAF(k) __builtin_bit_cast(bf16x8,pw##k)
  #define VFR(i) (bf16x8){vlo[i][0],vlo[i][1],vlo[i][2],vlo[i][3],vhi[i][0],vhi[i][1],vhi[i][2],vhi[i][3]}
  #define PIN(x) asm volatile("":"+v"(x))
  #define MX3(a,b,c) __builtin_fmaxf(__builtin_fmaxf((a),(b)),(c))
  #define GAPA(MF,A0,A1,A2,A3,W0,W1,PW) do{ MF; sacc+=A0; sacc+=A1; sacc+=A2; sacc+=A3; PIN(sacc); W0; W1; PIN(PW); SBAR(); }while(0)
  #define EX(v) __builtin_amdgcn_exp2f(v)
  #define GAPB(MF,X,B) do{ MF; X[B]=EX(X[B]); X[B+1]=EX(X[B+1]); X[B+2]=EX(X[B+2]); X[B+3]=EX(X[B+3]); PIN(X); SBAR(); }while(0)
  #define VRD(i) do{ vlo[i]=vtr(vp_+(((i)>>2)*4096+((i)&3)*1024)); vhi[i]=vtr(vp_+(((i)>>2)*4096+((i)&3)*1024+512)); }while(0)
  #define KRD(G,j) do{ if(G){ kload2(kf,kp0+sl_next,j); SBAR(); } }while(0)
  #define STEP(C0,C1,P0,P1,t,GK,GV,GL) do{ SBAR(); \
    const lds_cptr vp_=vp0+sl_prev; \
    VRD(0); SBAR(); float sacc=(P0[0]+P0[1]); \
    GAPA(C0=__builtin_amdgcn_mfma_f32_32x32x16_bf16(kf[0],qr[0],negm,0,0,0), P0[2],P0[3],P0[4],P0[5],     pw0[0]=PKW(P0,0), pw0[1]=PKW(P0,2), pw0); \
    VRD(4); SBAR(); GAPA(C1=__builtin_amdgcn_mfma_f32_32x32x16_bf16(kf[1],qr[0],negm,0,0,0), P0[6],P0[7],P0[8],P0[9],     pw0[2]=PKW(P0,4), pw0[3]=PKW(P0,6), pw0); \
    VRD(1); SBAR(); GAPA(C0=__builtin_amdgcn_mfma_f32_32x32x16_bf16(kf[2],qr[1],C0,0,0,0),   P0[10],P0[11],P0[12],P0[13], pw1[0]=PKW(P0,8), pw1[1]=PKW(P0,10), pw1); \
    VRD(5); SBAR(); GAPA(C1=__builtin_amdgcn_mfma_f32_32x32x16_bf16(kf[3],qr[1],C1,0,0,0),   P0[14],P0[15],P1[0],P1[1],   pw1[2]=PKW(P0,12),pw1[3]=PKW(P0,14), pw1); \
    VRD(2); SBAR(); GAPA(C0=__builtin_amdgcn_mfma_f32_32x32x16_bf16(kf[4],qr[2],C0,0,0,0),   P1[2],P1[3],P1[4],P1[5],     pw2[0]=PKW(P1,0), pw2[1]=PKW(P1,2), pw2); \
    VRD(6); SBAR(); GAPA(C1=__builtin_amdgcn_mfma_f32_32x32x16_bf16(kf[5],qr[2],C1,0,0,0),   P1[6],P1[7],P1[8],P1[9],     pw2[2]=PKW(P1,4), pw2[3]=PKW(P1,6), pw2); \
    VRD(3); SBAR(); GAPA(C0=__builtin_amdgcn_mfma_f32_32x32x16_bf16(kf[6],qr[3],C0,0,0,0),   P1[10],P1[11],P1[12],P1[13], pw3[0]=PKW(P1,8), pw3[1]=PKW(P1,10), pw3); \
    VRD(7); SBAR(); GAPA(C1=__builtin_amdgcn_mfma_f32_32x32x16_bf16(kf[7],qr[3],C1,0,0,0),   P1[14],P1[15],0.f,0.f,       pw3[2]=PKW(P1,12),pw3[3]=PKW(P1,14), pw3); \
    l_reg+=sacc; \
    if(GK){DMA_K((t)+3,sl_cur);} if(GV){DMA_V((t)+1,sl_next);} \
    CMASK(C0,C1,t); \
    { float a=MX3(C0[0],C0[1],C1[0]),b=MX3(C0[2],C0[3],C1[1]); a=MX3(a,C1[2],C1[3]); \
      _Pragma("unroll") for(int r=4;r<16;r+=4){a=MX3(a,C0[r],C0[r+1]);b=MX3(b,C0[r+2],C0[r+3]);a=MX3(a,C1[r],C1[r+1]);b=MX3(b,C1[r+2],C1[r+3]);} \
      float rm=__builtin_fmaxf(a,b); { auto rr=__builtin_amdgcn_permlane32_swap(__float_as_uint(rm),__float_as_uint(rm),false,false); rm=__builtin_fmaxf(__uint_as_float(rr[0]),__uint_as_float(rr[1])); } \
      resc=false; \
      if(__builtin_expect(__any(rm>(float)THRL),0)){ const float dl=__builtin_fmaxf(rm,0.f); mhat+=dl; \
        _Pragma("unroll") for(int r=0;r<16;++r){C0[r]-=dl;C1[r]-=dl;} \
        _Pragma("unroll") for(int r=0;r<16;++r)negm[r]=-mhat; asm volatile("":"+v"(negm)); \
        const float f=__builtin_amdgcn_exp2f(-dl); l_reg*=f; if(hi==0)wsf[r32]=f; resc=true; } } \
    SBAR(); \
    GAPB(o[0]=__builtin_amdgcn_mfma_f32_32x32x16_bf16(PAF(0),VFR(0),o[0],0,0,0), C0,0); \
    GAPB(o[1]=__builtin_amdgcn_mfma_f32_32x32x16_bf16(PAF(0),VFR(4),o[1],0,0,0), C0,4); \
    KRD(GL,0); GAPB(o[0]=__builtin_amdgcn_mfma_f32_32x32x16_bf16(PAF(1),VFR(1),o[0],0,0,0), C0,8); \
    KRD(GL,1); GAPB(o[1]=__builtin_amdgcn_mfma_f32_32x32x16_bf16(PAF(1),VFR(5),o[1],0,0,0), C0,12); \
    KRD(GL,2); GAPB(o[0]=__builtin_amdgcn_mfma_f32_32x32x16_bf16(PAF(2),VFR(2),o[0],0,0,0), C1,0); \
    KRD(GL,3); GAPB(o[1]=__builtin_amdgcn_mfma_f32_32x32x16_bf16(PAF(2),VFR(6),o[1],0,0,0), C1,4); \
    GAPB(o[0]=__builtin_amdgcn_mfma_f32_32x32x16_bf16(PAF(3),VFR(3),o[0],0,0,0), C1,8); \
    GAPB(o[1]=__builtin_amdgcn_mfma_f32_32x32x16_bf16(PAF(3),VFR(7),o[1],0,0,0), C1,12); \
    }while(0)
  int t=1;
  for(;t+5<NT;t+=2){
    STEP(pB0,pB1,pA0,pA1,t,true,true,true);     WAIT_BAR(2); RESC(); ROT();
    STEP(pA0,pA1,pB0,pB1,t+1,true,true,true);   WAIT_BAR(2); RESC(); ROT();
  }
  #define ENDW(tt) do{ if((tt)+3<NT){WAIT_BAR(2);} else if((tt)+2<NT){WAIT_BAR(1);} else {WAIT_BAR(0);} }while(0)
  for(;t+1<NT;t+=2){
    STEP(pB0,pB1,pA0,pA1,t,(t+3<NT),(t+1<NT),(t+1<NT));       ENDW(t);   RESC(); ROT();
    STEP(pA0,pA1,pB0,pB1,t+1,(t+4<NT),(t+2<NT),(t+2<NT));     ENDW(t+1); RESC(); ROT();
  }
  STEP(pB0,pB1,pA0,pA1,NT-1,false,false,false); RESC();
  { float sacc=pB0[0]+pB0[1]; _Pragma("unroll") for(int r=2;r<16;++r)sacc+=pB0[r]; _Pragma("unroll") for(int r=0;r<16;++r)sacc+=pB1[r]; l_reg+=sacc;
    pw0=(u32x4){PKW(pB0,0),PKW(pB0,2),PKW(pB0,4),PKW(pB0,6)};pw1=(u32x4){PKW(pB0,8),PKW(pB0,10),PKW(pB0,12),PKW(pB0,14)};pw2=(u32x4){PKW(pB1,0),PKW(pB1,2),PKW(pB1,4),PKW(pB1,6)};pw3=(u32x4){PKW(pB1,8),PKW(pB1,10),PKW(pB1,12),PKW(pB1,14)};
    SBAR(); pv(o,vb0+sl_cur,PAF(0),PAF(1),PAF(2),PAF(3)); }
  #undef PKW
  #undef PAF
  #undef VFR
  #undef PIN
  #undef MX3
  #undef GAPA
  #undef GAPB
  #undef EX
  #undef VRD
  #undef KRD
  #undef STEP
  #undef ENDW
  {auto rr=__builtin_amdgcn_permlane32_swap(__float_as_uint(l_reg),__float_as_uint(l_reg),false,false);l_reg=__uint_as_float(rr[0])+__uint_as_float(rr[1]);}
  if(hi==0)wsf[32+r32]=l_reg;asm volatile("s_waitcnt lgkmcnt(0)":::"memory");
  float rli[16];
  #pragma unroll
  for(int r=0;r<16;++r)rli[r]=__builtin_amdgcn_rcpf(wsf[32+crow(r,hi)]);
  bf16*Ow=Ow0+(long)(wid*QBLK)*op;
  { bf16*stg=(bf16*)(shm+LDS_OST)+wid*2048;
    #pragma unroll
    for(int r=0;r<16;++r){const int orow=crow(r,hi);
      #pragma unroll
      for(int d0=0;d0<2;++d0)stg[orow*64+d0*32+r32]=__float2bfloat16(o[d0][r]*rli[r]);}
    asm volatile("s_waitcnt lgkmcnt(0)":::"memory");
    #pragma unroll
    for(int i=0;i<4;++i){const int row=i*8+(lane>>3),ch=lane&7; const u32x4 v=*(const u32x4*)(stg+row*64+ch*8); ATTN_STORE16(Ow+(long)row*op+ch*8,v);} }
  asm volatile("s_waitcnt lgkmcnt(0)\n\ts_barrier":::"memory");
  #undef DMA_K
  #undef DMA_V
  #undef CMASK
  #undef START
  #undef RESC
  #undef ROT
}
constexpr int ATTN_LDS_BYTES=LDS_BYTES;
#undef SBAR
#undef WAIT_BAR
}
#define GAS __attribute__((address_space(1)))
#define LAS __attribute__((address_space(3)))
typedef unsigned short bf16;
typedef unsigned v4u __attribute__((ext_vector_type(4)));
typedef float f32x4 __attribute__((ext_vector_type(4)));
typedef short bf16x8 __attribute__((ext_vector_type(8)));
typedef GAS unsigned gu32;
typedef GAS unsigned long long gu64;
#define RLX_AGENT __ATOMIC_RELAXED, __HIP_MEMORY_SCOPE_AGENT
#define LDS_WAIT() asm volatile("s_waitcnt lgkmcnt(0)" ::: "memory")
#define VM_WAIT() asm volatile("s_waitcnt vmcnt(0)" ::: "memory")
__device__ __forceinline__ unsigned long long rt() { return __builtin_amdgcn_s_memrealtime(); }
__device__ __forceinline__ unsigned f2bf(float f) { unsigned u = __builtin_bit_cast(unsigned, f); return (u + 0x7fffu + ((u >> 16) & 1u)) >> 16; }
__device__ __forceinline__ unsigned pk2(float lo, float hi) { return f2bf(lo) | (f2bf(hi) << 16); }

#define XB_TMO      128
#define XB_XCNT(j)  (256  + 64 * (j))
#define XB_XSUB(j)  (1280 + 64 * (j))
#define XB_XGEN(j)  (2304 + 64 * (j))
#define XB_TOP      3328
#define XB_TOPGEN   3392
#define XCD_BAR_WORDS 3456
#define XB_SPIN_CAP (1u << 18)

__device__ __forceinline__ unsigned xb_ld(unsigned* p)              { return __hip_atomic_load(p, __ATOMIC_RELAXED, __HIP_MEMORY_SCOPE_AGENT); }
__device__ __forceinline__ unsigned xb_add(unsigned* p, unsigned v) { return __hip_atomic_fetch_add(p, v, __ATOMIC_RELAXED, __HIP_MEMORY_SCOPE_AGENT); }
__device__ __forceinline__ unsigned xb_xcc_id() { return (unsigned)__builtin_amdgcn_s_getreg((3 << 11) | 20) & 0xFu; }
#define XB_SPIN(cond, bar) do { unsigned _sp = 0; while (cond) { __builtin_amdgcn_s_sleep(1); \
    if ((++_sp & 255u) == 0u) { if (xb_ld(&(bar)[XB_TMO])) break; if (_sp > XB_SPIN_CAP) { atomicAdd(&(bar)[XB_TMO], 1u); break; } } } } while (0)

struct XcdBarrier {
    unsigned* bar; unsigned x;
    volatile LAS unsigned* st;
};

__device__ __forceinline__ XcdBarrier xcd_barrier_post(unsigned* bar, volatile LAS unsigned* st, const int tid_) {
    XcdBarrier b; b.bar = bar; b.x = xb_xcc_id(); b.st = st;
    if (tid_ == 0) (void)xb_add(&bar[XB_XCNT(b.x)], 1u);
    return b;
}
__device__ __forceinline__ void xcd_barrier_complete(unsigned* bar, unsigned x, unsigned& nloc, unsigned& nx) {
    const unsigned G = gridDim.x * gridDim.y * gridDim.z;
    unsigned sum, cnt, mine, sp = 0u;
    for (;;) {
        sum = 0u; cnt = 0u; mine = 0u;
#pragma unroll
        for (unsigned j = 0; j < 16; ++j) { const unsigned c = xb_ld(&bar[XB_XCNT(j)]); sum += c; cnt += (c > 0u) ? 1u : 0u; mine = (j == x) ? c : mine; }
        if (sum == G) break;
        __builtin_amdgcn_s_sleep(1);
        if ((++sp & 255u) == 0u) { if (xb_ld(&bar[XB_TMO])) break; if (sp > XB_SPIN_CAP) { atomicAdd(&bar[XB_TMO], 1u); break; } }
    }
    nloc = mine > 0u ? mine : 1u; nx = cnt > 0u ? cnt : 1u;
}

__device__ __forceinline__ void xcd_barrier(const XcdBarrier& b, const int tid_) {
    asm volatile("s_waitcnt vmcnt(0)" ::: "memory");
    __syncthreads();
    if (tid_ == 0) {
        unsigned* bar = b.bar;
        __builtin_amdgcn_s_waitcnt(0);
        unsigned nloc = b.st[0], nx = b.st[1];
        if (nloc == 0u) { xcd_barrier_complete(bar, b.x, nloc, nx); b.st[0] = nloc; b.st[1] = nx; }
        const unsigned old = xb_add(&bar[XB_XSUB(b.x)], 1u);
        const unsigned gen = old / nloc;
        if (old + 1u == (gen + 1u) * nloc) {
            __builtin_amdgcn_fence(__ATOMIC_RELEASE, "agent");
            asm volatile("s_waitcnt vmcnt(0)" ::: "memory");
            const unsigned og = xb_add(&bar[XB_TOP], 1u);
            const unsigned tg = og / nx;
            if (og + 1u == (tg + 1u) * nx) xb_add(&bar[XB_TOPGEN], 1u);
            else XB_SPIN(xb_ld(&bar[XB_TOPGEN]) == tg, bar);
            __builtin_amdgcn_fence(__ATOMIC_ACQUIRE, "agent");
            xb_add(&bar[XB_XGEN(b.x)], 1u);
            asm volatile("s_waitcnt vmcnt(0)" ::: "memory");
        } else {
            XB_SPIN(xb_ld(&bar[XB_XGEN(b.x)]) == gen, bar);
            __builtin_amdgcn_fence(__ATOMIC_ACQUIRE, "agent");
            asm volatile("s_waitcnt vmcnt(0)" ::: "memory");
        }
    }
    __syncthreads();
}
constexpr size_t MiB = 1u << 20;
constexpr size_t WS_CTL = 0, CTL_ZERO_BYTES = 1 * MiB;
constexpr size_t WS_MOD = 1 * MiB;
constexpr size_t WS_ROPE = 3 * MiB;
constexpr size_t WS_ROUTE_E = 3 * MiB + 65536;
constexpr size_t WS_ROUTE_W = 3 * MiB + 262144;
constexpr size_t WS_SLOT_TOK = 4 * MiB;
constexpr size_t WS_SLOT_W = 4 * MiB + 524288;
constexpr size_t WS_XC = 8 * MiB;
constexpr size_t WS_H = 24 * MiB;
constexpr size_t WS_WT = 96 * MiB;
constexpr size_t WT_IN = 0, WT_OUT = 6 * MiB, WT_GU = 8 * MiB, WT_DN = 120 * MiB;
constexpr size_t WS_HP = 286 * MiB;
constexpr size_t WS_R1 = 438 * MiB;
constexpr size_t R1_OPART = 216 * MiB;
constexpr size_t WS_END = 970 * MiB;

constexpr int CW_TMO = 0, CW_CODE = 1;
constexpr int CW_BAR = 4096;
constexpr int CW_MOE = 16384;

constexpr int RING_OFF = 0, RING_BYTES = 131072;
constexpr int LDSCTL_OFF = RING_BYTES, MISC_OFF = LDSCTL_OFF + 320;
constexpr int TAB_OFF = LDSCTL_OFF + 1024;
constexpr int LDS_BYTES = 147456;
constexpr int NWAVES = 8;

struct Args { const float* in[27]; float* out; unsigned char* ws; int ph_lo, ph_hi; };
struct Frame { LAS unsigned char* lds; gu32* ctl; int tid, lane, wave, vcu, G; };
constexpr int ARGS_OFF = LDSCTL_OFF + 512;
#define ARG_LO(k) ((unsigned)__builtin_amdgcn_readfirstlane((int)((const LAS unsigned*)(F.lds + ARGS_OFF))[2 * (k)]))
#define ARG_HI(k) ((unsigned)__builtin_amdgcn_readfirstlane((int)((const LAS unsigned*)(F.lds + ARGS_OFF))[2 * (k) + 1]))
#define ARG_U64(k) (((unsigned long long)ARG_HI(k) << 32) | (unsigned long long)ARG_LO(k))
#define ARG_IN(k) ((const float*)(const GAS float*)ARG_U64(k))
#define ARG_OUT ((float*)(GAS float*)ARG_U64(27))
#define ARG_WS ((unsigned char*)(GAS unsigned char*)ARG_U64(28))

__device__ __forceinline__ float wave_sum(float v) {
#pragma unroll
    for (int o = 1; o < 64; o <<= 1) v += __shfl_xor(v, o);
    return v;
}
__device__ __forceinline__ float* resid_row(float* out, float* xc, int r) { const int b = r / RB, t = r - b * RB; return t < SEQ ? out + (size_t)(b * SEQ + t) * D : xc + (size_t)(b * CTXL + t - SEQ) * D; }

__device__ __forceinline__ void p0_phase(const Frame& F) {
    const size_t gt = (size_t)F.vcu * 512 + F.tid, NT_ = (size_t)F.G * 512;
    { const f32x4* s = (const f32x4*)ARG_IN(0); f32x4* d = (f32x4*)ARG_OUT; for (size_t i = gt; i < (size_t)NB * SEQ * D / 4; i += NT_) d[i] = s[i]; }
    { const f32x4* s = (const f32x4*)ARG_IN(2); f32x4* d = (f32x4*)(ARG_WS + WS_XC); for (size_t i = gt; i < (size_t)NB * CTXL * D / 4; i += NT_) d[i] = s[i]; }
    if (F.vcu == 0) { for (int i = F.tid; i < 1024; i += 512) { const int v = i >> 4, k = i & 15; const float inv = powf(10000.f, -(float)k / 16.f), ang = (float)v * inv;
        float* rt_ = (float*)(ARG_WS + WS_ROPE); rt_[i] = cosf(ang); rt_[1024 + i] = sinf(ang); } }
    LAS float* S = (LAS float*)(F.lds);
    LAS float* R = (LAS float*)(F.lds + 17 * 1024 * 4);
    { const float* c_ = ARG_IN(1); const float* cc_ = ARG_IN(3);
    for (int i = F.tid; i < 17 * 1024; i += 512) { const float v = (i < 16 * 1024) ? c_[i] : cc_[i - 16 * 1024]; S[i] = v / (1.f + __expf(-v)); } }
    __syncthreads();
    const float* adaw = ARG_IN(4); const float* adab = ARG_IN(5); float* MODw = (float*)(ARG_WS + WS_MOD);
    const int cl = F.tid & 127, kc = F.tid >> 7;
    for (int item = F.vcu; item < 4 * 48; item += F.G) {
        const int l = item / 48, n0 = (item % 48) * 128;
        const float* W = adaw + ((size_t)l * D + kc * 256) * 6144 + n0 + cl;
        float acc[17];
#pragma unroll
        for (int bb = 0; bb < 17; ++bb) acc[bb] = 0.f;
        for (int k = 0; k < 256; k += 4) {
            const float w0 = W[(size_t)(k + 0) * 6144], w1 = W[(size_t)(k + 1) * 6144], w2 = W[(size_t)(k + 2) * 6144], w3 = W[(size_t)(k + 3) * 6144];
#pragma unroll
            for (int bb = 0; bb < 17; ++bb) { const f32x4 s4 = *(const LAS f32x4*)(S + bb * 1024 + kc * 256 + k); acc[bb] += s4[0] * w0 + s4[1] * w1 + s4[2] * w2 + s4[3] * w3; }
        }
#pragma unroll
        for (int bb = 0; bb < 17; ++bb) R[(kc * 17 + bb) * 128 + cl] = acc[bb];
        __syncthreads();
        if (kc == 0) { float* MOD = MODw;
#pragma unroll
            for (int bb = 0; bb < 17; ++bb) MOD[(size_t)(l * 17 + bb) * 6144 + n0 + cl] = adab[l * 6144 + n0 + cl] + ((R[bb * 128 + cl] + R[(17 + bb) * 128 + cl]) + (R[(34 + bb) * 128 + cl] + R[(51 + bb) * 128 + cl])); }
        __syncthreads();
    }
}

__device__ __forceinline__ void transpose_item(const float* W, int K, int N, bf16* WT, int k0, int n0, int drow, LAS float* scr, int lane) {
#pragma unroll 8
    for (int i = 0; i < 32; ++i) { const int kk = 2 * i + (lane >> 5); scr[kk * 33 + (lane & 31)] = W[(size_t)(k0 + kk) * N + n0 + (lane & 31)]; }
    LDS_WAIT(); asm volatile("" ::: "memory");
    const int c = lane & 7;
#pragma unroll
    for (int j = 0; j < 4; ++j) { const int n = (lane >> 3) + 8 * j; const LAS float* s = scr + (8 * c) * 33 + n;
        v4u o; o.x = pk2(s[0 * 33], s[1 * 33]); o.y = pk2(s[2 * 33], s[3 * 33]); o.z = pk2(s[4 * 33], s[5 * 33]); o.w = pk2(s[6 * 33], s[7 * 33]);
        *(GAS v4u*)(WT + (size_t)(drow + n) * K + k0 + 8 * c) = o; }
    LDS_WAIT(); asm volatile("" ::: "memory");
}
__device__ __forceinline__ int wt_drow(int mode, int e, int N, int n0) {
    if (mode == 0) return e * N + n0;
    if (mode == 1) return n0 < 512 ? (n0 >> 7) * 256 + (n0 & 127) : (n0 < 1024 ? ((n0 - 512) >> 7) * 256 + 128 + (n0 & 127) : n0);
    return e * 2 * N + (n0 >> 7) * 256 + (n0 & 127) + (mode == 3 ? 128 : 0);
}
__device__ __forceinline__ int wconv_job(const Frame& F, int& it, int step, const float* W, int nexp, int K, int N, bf16* WT, int mode) {
    const int per = (K / 64) * (N / 32), tot = nexp * per, nblk = N / 32;
    LAS float* scr = (LAS float*)(F.lds + RING_OFF + F.wave * 16384);
    for (; it < tot; it += step) { const int e = it / per, r = it - e * per, kb = r / nblk, nb = r - kb * nblk;
        transpose_item(W + (size_t)e * K * N, K, N, WT, 64 * kb, 32 * nb, wt_drow(mode, e, N, 32 * nb), scr, F.lane); }
    it -= tot; return tot;
}
__device__ __forceinline__ void wconv_phase(const Frame& F, int l) {
    const int i = l >> 1, step = F.G * NWAVES; int it = F.vcu * NWAVES + F.wave;
    bf16* WT = (bf16*)(ARG_WS + WS_WT);
    if ((l & 1) == 0) {
        wconv_job(F, it, step, ARG_IN(8) + (size_t)i * D * EV_IN, 1, D, EV_IN, WT + WT_IN / 2, 1);
        wconv_job(F, it, step, ARG_IN(14) + (size_t)i * D * D, 1, D, D, WT + WT_OUT / 2, 0);
        wconv_job(F, it, step, ARG_IN(15) + (size_t)i * D * FF, 1, D, FF, WT + WT_GU / 2, 2);
        wconv_job(F, it, step, ARG_IN(16) + (size_t)i * D * FF, 1, D, FF, WT + WT_GU / 2, 3);
        wconv_job(F, it, step, ARG_IN(17) + (size_t)i * FF * D, 1, FF, D, WT + WT_DN / 2, 0);
    } else {
        wconv_job(F, it, step, ARG_IN(18) + (size_t)i * D * OD_IN, 1, D, OD_IN, WT + WT_IN / 2, 0);
        wconv_job(F, it, step, ARG_IN(21) + (size_t)i * D * D, 1, D, D, WT + WT_OUT / 2, 0);
        wconv_job(F, it, step, ARG_IN(23) + (size_t)i * NE * D * FF, NE, D, FF, WT + WT_GU / 2, 2);
        wconv_job(F, it, step, ARG_IN(24) + (size_t)i * NE * D * FF, NE, D, FF, WT + WT_GU / 2, 3);
        wconv_job(F, it, step, ARG_IN(25) + (size_t)i * NE * FF * D, NE, FF, D, WT + WT_DN / 2, 0);
    }
}

template <bool ROUTER>
__device__ __forceinline__ void norm_phase(const Frame& F, int l, int which, bool lat_only) {
    const float* MOD = (const float*)(ARG_WS + WS_MOD) + (size_t)l * 17 * 6144;
    const float* G = (which ? ARG_IN(7) : ARG_IN(6)) + l * D;
    unsigned char* ws_ = ARG_WS; float* xc = (float*)(ws_ + WS_XC); bf16* H = (bf16*)(ws_ + WS_H); float* outp = ARG_OUT;
    int* routeE = (int*)(ws_ + WS_ROUTE_E); float* routeW = (float*)(ws_ + WS_ROUTE_W);
    LAS float* RW = (LAS float*)(F.lds);
    LAS unsigned* LC = (LAS unsigned*)(F.lds + TAB_OFF);
    if (ROUTER) {
        const float* rw = ARG_IN(22) + (size_t)(l >> 1) * D * NE;
        for (int i = F.tid; i < D * NE; i += 512) RW[i] = rw[i];
        if (F.tid < 16) LC[F.tid] = 0u;
        int* st = (int*)(ws_ + WS_SLOT_TOK); for (int i = F.vcu * 512 + F.tid; i < MAX_SLOTS; i += F.G * 512) st[i] = -1;
        __syncthreads();
    }
    const int gw = F.vcu * NWAVES + F.wave, NGW = F.G * NWAVES;
    for (int r = gw; r < M_ALL; r += NGW) {
        const int b = r / RB, t = r - b * RB; if (lat_only && t >= SEQ) continue;
        const float* xr = (t < SEQ) ? outp + (size_t)(b * SEQ + t) * D : xc + (size_t)(b * CTXL + t - SEQ) * D;
        const float* mp = MOD + (size_t)((t < SEQ) ? b : NB) * 6144 + (which ? 3 : 0) * D;
        f32x4 v[4]; float s = 0.f;
#pragma unroll
        for (int j = 0; j < 4; ++j) { v[j] = *(const f32x4*)(xr + 4 * F.lane + 256 * j); s += (v[j].x * v[j].x + v[j].y * v[j].y) + (v[j].z * v[j].z + v[j].w * v[j].w); }
        const float rs = 1.f / sqrtf(wave_sum(s) * (1.f / D) + 1e-6f);
#pragma unroll
        for (int j = 0; j < 4; ++j) { const int c = 4 * F.lane + 256 * j; const f32x4 g = *(const f32x4*)(G + c), sh = *(const f32x4*)(mp + c), sc = *(const f32x4*)(mp + D + c);
            v[j] = (v[j] * rs) * g * (sc + 1.f) + sh;
            *(unsigned long long*)(H + (size_t)r * D + c) = (unsigned long long)pk2(v[j].x, v[j].y) | ((unsigned long long)pk2(v[j].z, v[j].w) << 32); }
        if (ROUTER) {
            float lg[8];
#pragma unroll
            for (int e = 0; e < 8; ++e) lg[e] = 0.f;
#pragma unroll
            for (int j = 0; j < 4; ++j)
#pragma unroll
                for (int q = 0; q < 4; ++q) { const int c = 4 * F.lane + 256 * j + q; const f32x4 w0 = *(const LAS f32x4*)(RW + c * 8), w1 = *(const LAS f32x4*)(RW + c * 8 + 4); const float hv = v[j][q];
                    lg[0] += hv * w0[0]; lg[1] += hv * w0[1]; lg[2] += hv * w0[2]; lg[3] += hv * w0[3]; lg[4] += hv * w1[0]; lg[5] += hv * w1[1]; lg[6] += hv * w1[2]; lg[7] += hv * w1[3]; }
#pragma unroll
            for (int e = 0; e < 8; ++e) lg[e] = wave_sum(lg[e]);
            int e0 = 0; float v0 = lg[0];
#pragma unroll
            for (int e = 1; e < 8; ++e) if (lg[e] > v0) { v0 = lg[e]; e0 = e; }
            int e1 = -1; float v1 = -INFINITY;
#pragma unroll
            for (int e = 0; e < 8; ++e) if (e != e0 && lg[e] > v1) { v1 = lg[e]; e1 = e; }
            if (F.lane == 0) { const float w0 = 1.f / (1.f + __expf(v1 - v0));
                routeE[r] = e0 | (e1 << 8); routeW[2 * r] = w0; routeW[2 * r + 1] = 1.f - w0;
                __hip_atomic_fetch_add(&LC[e0], 1u, __ATOMIC_RELAXED, __HIP_MEMORY_SCOPE_WORKGROUP); __hip_atomic_fetch_add(&LC[8 + e1], 1u, __ATOMIC_RELAXED, __HIP_MEMORY_SCOPE_WORKGROUP); }
        }
    }
    if (ROUTER) { __syncthreads(); if (F.tid < 16) { const unsigned c = LC[F.tid]; if (c) __hip_atomic_fetch_add(F.ctl + CW_MOE + 1024 * (l >> 1) + F.tid, c, RLX_AGENT); } __syncthreads(); }
}

template <bool EVEN>
__device__ __forceinline__ void qkpost_phase(const Frame& F, int l) {
    constexpr int NH = EVEN ? 10 : 32, NQ = EVEN ? 8 : 16, P = EVEN ? EV_P : OD_IN;
    bf16* base = (bf16*)(ARG_WS + WS_R1);
    const float* cosT = (const float*)(ARG_WS + WS_ROPE); const float* sinT = cosT + 1024;
    const float* qg = ARG_IN(12) + (l >> 1) * 64; const float* kg = ARG_IN(13) + (l >> 1) * 64;
    const int k = F.lane & 7, sub = F.lane >> 3;
    const long total = (long)M_ALL * NH, step = (long)F.G * NWAVES * 8;
    for (long it = ((long)(F.vcu * NWAVES + F.wave)) * 8 + sub; it < total; it += step) {
        const int r = (int)(it / NH), h = (int)(it - (long)r * NH); const int b = r / RB, t = r - b * RB; const bool isq = h < NQ;
        if (!EVEN && t >= SEQ && !isq) continue;
        bf16* p = base + (size_t)r * P + (EVEN ? (isq ? 512 + 64 * h : 1024 + 64 * (h - 8)) : (isq ? 64 * h : 1024 + 64 * (h - 16))) + 8 * k;
        const v4u raw = *(const v4u*)p; float x[8];
#pragma unroll
        for (int e = 0; e < 4; ++e) { x[2 * e] = __uint_as_float(raw[e] << 16); x[2 * e + 1] = __uint_as_float(raw[e] & 0xffff0000u); }
        if (EVEN) { float ss = 0.f;
#pragma unroll
            for (int e = 0; e < 8; ++e) ss += x[e] * x[e];
            ss += __shfl_xor(ss, 1); ss += __shfl_xor(ss, 2); ss += __shfl_xor(ss, 4);
            const float rs = 1.f / sqrtf(ss * (1.f / 64.f) + 1e-6f); const float* g = (isq ? qg : kg) + 8 * k;
#pragma unroll
            for (int e = 0; e < 8; ++e) x[e] = x[e] * rs * g[e]; }
        float y[8];
#pragma unroll
        for (int e = 0; e < 8; ++e) y[e] = __shfl_xor(x[e], 2);
        if (t < SEQ) { const int pv_ = (k >> 2) ? (t & 63) : (t >> 6); const float* cp = cosT + pv_ * 16 + (k & 1) * 8; const float* sp = sinT + pv_ * 16 + (k & 1) * 8; const float sg = (k & 2) ? 1.f : -1.f;
#pragma unroll
            for (int e = 0; e < 8; ++e) x[e] = x[e] * cp[e] + sg * y[e] * sp[e]; }
        if (isq) {
#pragma unroll
            for (int e = 0; e < 8; ++e) x[e] *= QSCALE; }
        v4u o; o.x = pk2(x[0], x[1]); o.y = pk2(x[2], x[3]); o.z = pk2(x[4], x[5]); o.w = pk2(x[6], x[7]);
        *(v4u*)p = o;
    }
}

__device__ __forceinline__ void conv_phase(const Frame& F, int l) {
    const int i = l >> 1;
    LAS unsigned char* TILE = F.lds;
    LAS float* CW = (LAS float*)(F.lds + 63488);
    const bf16* EV = (const bf16*)(ARG_WS + WS_R1); bf16* MIX = (bf16*)(ARG_WS + WS_H);
    { const float* cw = ARG_IN(9) + (size_t)i * 31 * 512; for (int k = F.tid; k < 31 * 512; k += 512) CW[k] = cw[k]; }
    float lg[8], lb[8]; const float* lng_ = ARG_IN(10); const float* lnb_ = ARG_IN(11);
#pragma unroll
    for (int c = 0; c < 8; ++c) { lg[c] = lng_[i * 512 + 8 * F.lane + c]; lb[c] = lnb_[i * 512 + 8 * F.lane + c]; }
    const int NU = NB * 72;
    for (int u = F.vcu; u < NU; u += F.G) {
        const int b = u / 72, v = u - b * 72; const bool lat = v < 64; const int t0 = lat ? 32 * v : 32 * (v - 64), L = lat ? SEQ : CTXL, rbase = b * RB + (lat ? 0 : SEQ);
        __syncthreads();
        for (int rr = F.wave; rr < 62; rr += NWAVES) { const int t = t0 - 15 + rr; v4u val = (v4u){0u, 0u, 0u, 0u};
            if (t >= 0 && t < L) val = *(const v4u*)(EV + (size_t)(rbase + t) * EV_P + 8 * F.lane);
            *(LAS v4u*)(TILE + rr * 1024 + 16 * F.lane) = val; }
        __syncthreads();
        float acc[4][8];
#pragma unroll
        for (int q = 0; q < 4; ++q)
#pragma unroll
            for (int c = 0; c < 8; ++c) acc[q][c] = 0.f;
#pragma unroll 2
        for (int j = 0; j < 31; ++j) {
            const f32x4 w0 = *(const LAS f32x4*)(CW + j * 512 + 8 * F.lane), w1 = *(const LAS f32x4*)(CW + j * 512 + 8 * F.lane + 4);
#pragma unroll
            for (int q = 0; q < 4; ++q) { const v4u raw = *(const LAS v4u*)(TILE + (4 * F.wave + q + j) * 1024 + 16 * F.lane);
                acc[q][0] += __uint_as_float(raw[0] << 16) * w0[0]; acc[q][1] += __uint_as_float(raw[0] & 0xffff0000u) * w0[1];
                acc[q][2] += __uint_as_float(raw[1] << 16) * w0[2]; acc[q][3] += __uint_as_float(raw[1] & 0xffff0000u) * w0[3];
                acc[q][4] += __uint_as_float(raw[2] << 16) * w1[0]; acc[q][5] += __uint_as_float(raw[2] & 0xffff0000u) * w1[1];
                acc[q][6] += __uint_as_float(raw[3] << 16) * w1[2]; acc[q][7] += __uint_as_float(raw[3] & 0xffff0000u) * w1[3]; }
        }
#pragma unroll
        for (int q = 0; q < 4; ++q) {
            float s = 0.f;
#pragma unroll
            for (int c = 0; c < 8; ++c) s += acc[q][c];
            const float mean = wave_sum(s) * (1.f / 512.f); float s2 = 0.f;
#pragma unroll
            for (int c = 0; c < 8; ++c) { acc[q][c] -= mean; s2 += acc[q][c] * acc[q][c]; }
            const float rstd = 1.f / sqrtf(wave_sum(s2) * (1.f / 512.f) + 1e-5f);
            float o[8];
#pragma unroll
            for (int c = 0; c < 8; ++c) o[c] = fast_silu(acc[q][c] * rstd * lg[c] + lb[c]);
            v4u w; w.x = pk2(o[0], o[1]); w.y = pk2(o[2], o[3]); w.z = pk2(o[4], o[5]); w.w = pk2(o[6], o[7]);
            *(v4u*)(MIX + (size_t)(rbase + t0 + 4 * F.wave + q) * D + 8 * F.lane) = w;
        }
    }
    __syncthreads();
}

__device__ __forceinline__ void attn_even_phase(const Frame& F, unsigned char* lds_generic) {
    using abf = attn_body::bf16;
    const abf* EV = (const abf*)(ARG_WS + WS_R1); abf* MIX = (abf*)(ARG_WS + WS_H);
    const int NLAT = NB * 8 * 8, per = (NLAT + F.G - 1) / F.G;
    for (int id = F.vcu * per; id < (F.vcu + 1) * per && id < NLAT; ++id) {
        const int qb = id & 7, h = ((id >> 5) & 1) * 4 + ((id >> 3) & 3), b = id >> 6;
        const size_t r0 = (size_t)b * RB;
        attn_body::attn_unit<8, EV_P, EV_P, EV_P, D>(EV + (r0 + qb * 256) * EV_P + 512 + 64 * h, EV + r0 * EV_P + 1024 + 64 * (h >> 2), EV + r0 * EV_P + 1152 + 64 * (h >> 2),
                                MIX + (r0 + qb * 256) * D + 512 + 64 * h, 36, (char*)lds_generic, F.tid);
    }
    const int NCTX = NB * 8, perc = (NCTX + F.G - 1) / F.G;
    for (int id = F.vcu * perc; id < (F.vcu + 1) * perc && id < NCTX; ++id) {
        const int h = id & 7, b = id >> 3; const size_t r0 = (size_t)b * RB + SEQ;
        attn_body::attn_unit<8, EV_P, EV_P, EV_P, D>(EV + r0 * EV_P + 512 + 64 * h, EV + r0 * EV_P + 1024 + 64 * (h >> 2), EV + r0 * EV_P + 1152 + 64 * (h >> 2),
                                MIX + r0 * D + 512 + 64 * h, 4, (char*)lds_generic, F.tid);
    }
}
__device__ __forceinline__ void attn_odd_phase(const Frame& F, unsigned char* lds_generic, bool need_ctx) {
    using abf = attn_body::bf16;
    const abf* QKV = (const abf*)(ARG_WS + WS_R1); abf* OP = (abf*)(ARG_WS + WS_R1 + R1_OPART);
    const int NLAT = NB * 32 * 8, per = (NLAT + F.G - 1) / F.G;
    for (int id = F.vcu * per; id < (F.vcu + 1) * per && id < NLAT; ++id) {
        const int qb = id & 7, cv = (id >> 3) & 3, h = (id >> 5) & 7, b = id >> 8; const int c = cv >> 1, vh = cv & 1;
        const size_t r0 = (size_t)b * RB;
        attn_body::attn_unit<8, OD_IN, OD_IN, OD_IN, OP_P>(QKV + (r0 + qb * 256) * OD_IN + (h * 2 + c) * 64, QKV + r0 * OD_IN + 1024 + (h * 2 + c) * 64, QKV + r0 * OD_IN + 2048 + h * 128 + vh * 64,
                                OP + (r0 + qb * 256) * OP_P + h * 256 + c * 128 + vh * 64, 36, (char*)lds_generic, F.tid);
    }
    if (need_ctx) {
        const int NCTX = NB * 32, perc = (NCTX + F.G - 1) / F.G;
        for (int id = F.vcu * perc; id < (F.vcu + 1) * perc && id < NCTX; ++id) {
            const int cv = id & 3, h = (id >> 2) & 7, b = id >> 5; const int c = cv >> 1, vh = cv & 1; const size_t r0 = (size_t)b * RB + SEQ;
            attn_body::attn_unit<8, OD_IN, OD_IN, OD_IN, OP_P>(QKV + r0 * OD_IN + (h * 2 + c) * 64, QKV + r0 * OD_IN + 1024 + (h * 2 + c) * 64, QKV + r0 * OD_IN + 2048 + h * 128 + vh * 64,
                                    OP + r0 * OP_P + h * 256 + c * 128 + vh * 64, 4, (char*)lds_generic, F.tid);
        }
    }
}
__device__ __forceinline__ void diffcomb_phase(const Frame& F, int l, bool need_ctx) {
    const bf16* OP = (const bf16*)(ARG_WS + WS_R1 + R1_OPART); bf16* MIX = (bf16*)(ARG_WS + WS_H);
    const float* lp = ARG_IN(19) + (l >> 1) * 256; const float lam_init = 0.8f - 0.6f * expf(-0.3f * (float)l);
    const float lam = expf(wave_sum(lp[F.lane] * lp[64 + F.lane])) - expf(wave_sum(lp[128 + F.lane] * lp[192 + F.lane])) + lam_init;
    const int k = F.lane & 15, sub = F.lane >> 4; const float* sg = ARG_IN(20) + (l >> 1) * 128 + 8 * k; const float osc = 1.f - lam_init;
    float g[8];
#pragma unroll
    for (int e = 0; e < 8; ++e) g[e] = sg[e] * osc;
    const long total = (long)M_ALL * 8, step = (long)F.G * NWAVES * 4;
    for (long it = ((long)(F.vcu * NWAVES + F.wave)) * 4 + sub; it < total; it += step) {
        const int r = (int)(it >> 3), h = (int)(it & 7); const int t = r % RB; if (!need_ctx && t >= SEQ) continue;
        const bf16* p = OP + (size_t)r * OP_P + h * 256 + 8 * k; const v4u a = *(const v4u*)p, c = *(const v4u*)(p + 128); float x[8]; float ss = 0.f;
#pragma unroll
        for (int e = 0; e < 4; ++e) { x[2 * e] = __uint_as_float(a[e] << 16) - lam * __uint_as_float(c[e] << 16); x[2 * e + 1] = __uint_as_float(a[e] & 0xffff0000u) - lam * __uint_as_float(c[e] & 0xffff0000u); }
#pragma unroll
        for (int e = 0; e < 8; ++e) ss += x[e] * x[e];
        ss += __shfl_xor(ss, 1); ss += __shfl_xor(ss, 2); ss += __shfl_xor(ss, 4); ss += __shfl_xor(ss, 8);
        const float rs = 1.f / sqrtf(ss * (1.f / 128.f) + 1e-6f);
        v4u o; o.x = pk2(x[0] * rs * g[0], x[1] * rs * g[1]); o.y = pk2(x[2] * rs * g[2], x[3] * rs * g[3]); o.z = pk2(x[4] * rs * g[4], x[5] * rs * g[5]); o.w = pk2(x[6] * rs * g[6], x[7] * rs * g[7]);
        *(v4u*)(MIX + (size_t)r * D + h * 128 + 8 * k) = o;
    }
}

__device__ __forceinline__ void moe_tables(const Frame& F, int i) {
    LAS int* TAB = (LAS int*)(F.lds + TAB_OFF);
    __syncthreads();
    if (F.tid == 0) { int ts = 0;
        for (int g = 0; g < 16; ++g) { const unsigned c = __hip_atomic_load(F.ctl + CW_MOE + 1024 * i + g, RLX_AGENT); const int nt = (int)((c + 255u) >> 8); TAB[320 + g] = ts;
            for (int q = 0; q < nt && ts + q < MAX_SLOT_TILES; ++q) TAB[ts + q] = g & 7; ts += nt; if (g == 7) TAB[337] = ts; }
        TAB[336] = ts < MAX_SLOT_TILES ? ts : MAX_SLOT_TILES; }
    __syncthreads();
}
__device__ __forceinline__ void moe_assign_phase(const Frame& F, int l, bool lat_only) {
    const int i = l >> 1; moe_tables(F, i);
    LAS int* TAB = (LAS int*)(F.lds + TAB_OFF);
    LAS unsigned* LCNT = (LAS unsigned*)(F.lds);
    LAS int* SL = (LAS int*)(F.lds + 256);
    const int* RE = (const int*)(ARG_WS + WS_ROUTE_E); const float* RWt = (const float*)(ARG_WS + WS_ROUTE_W);
    int* ST = (int*)(ARG_WS + WS_SLOT_TOK); float* SW = (float*)(ARG_WS + WS_SLOT_W);
    const int chunk = (M_ALL + F.G - 1) / F.G, r0 = F.vcu * chunk, nr = (r0 + chunk <= M_ALL) ? chunk : (M_ALL > r0 ? M_ALL - r0 : 0);
    for (int base = 0; base < nr; base += 512) {
        if (F.tid < 32) LCNT[F.tid] = 0u;
        __syncthreads();
        const int r = r0 + base + F.tid; const bool valid = (base + F.tid < nr) && !(lat_only && (r % RB) >= SEQ);
        int e0 = 0, e1 = 0; unsigned lr0 = 0, lr1 = 0;
        if (valid) { const int ee = RE[r]; e0 = ee & 255; e1 = ee >> 8; lr0 = __hip_atomic_fetch_add(&LCNT[e0], 1u, __ATOMIC_RELAXED, __HIP_MEMORY_SCOPE_WORKGROUP); lr1 = __hip_atomic_fetch_add(&LCNT[8 + e1], 1u, __ATOMIC_RELAXED, __HIP_MEMORY_SCOPE_WORKGROUP); }
        __syncthreads();
        if (F.tid < 16) { const unsigned c = LCNT[F.tid]; LCNT[16 + F.tid] = c ? __hip_atomic_fetch_add(F.ctl + CW_MOE + 1024 * i + 64 + F.tid, c, RLX_AGENT) : 0u; }
        __syncthreads();
        int s0 = -1, s1 = -1;
        if (valid) { s0 = TAB[320 + e0] * 256 + (int)(LCNT[16 + e0] + lr0); s1 = TAB[320 + 8 + e1] * 256 + (int)(LCNT[24 + e1] + lr1);
            if (s0 < MAX_SLOTS) { ST[s0] = r; SW[s0] = RWt[2 * r]; } else s0 = -1;
            if (s1 < MAX_SLOTS) { ST[s1] = r; SW[s1] = RWt[2 * r + 1]; } else s1 = -1; }
        if (base + F.tid < nr) { SL[2 * F.tid] = s0; SL[2 * F.tid + 1] = s1; }
        __syncthreads();
        const int ncp = 2 * ((nr - base) < 512 ? (nr - base) : 512);
        const bf16* H = (const bf16*)(ARG_WS + WS_H); bf16* HP = (bf16*)(ARG_WS + WS_HP);
        for (int cp = F.wave; cp < ncp; cp += NWAVES) { const int s = SL[cp]; if (s < 0) continue; const int rr = r0 + base + (cp >> 1);
            const v4u* src = (const v4u*)(H + (size_t)rr * D) + F.lane; v4u* dst = (v4u*)(HP + (size_t)s * D) + F.lane; const v4u x0 = src[0], x1 = src[64]; dst[0] = x0; dst[64] = x1; }
        __syncthreads();
    }
}

__device__ __forceinline__ void final_phase(const Frame& F) {
    const float* G = ARG_IN(26); float* outp = ARG_OUT; const int gw = F.vcu * NWAVES + F.wave, NGW = F.G * NWAVES;
    for (int r = gw; r < NB * SEQ; r += NGW) { float* xr = outp + (size_t)r * D; f32x4 v[4]; float s = 0.f;
#pragma unroll
        for (int j = 0; j < 4; ++j) { v[j] = *(const f32x4*)(xr + 4 * F.lane + 256 * j); s += (v[j].x * v[j].x + v[j].y * v[j].y) + (v[j].z * v[j].z + v[j].w * v[j].w); }
        const float rs = 1.f / sqrtf(wave_sum(s) * (1.f / D) + 1e-6f);
#pragma unroll
        for (int j = 0; j < 4; ++j) { const int c = 4 * F.lane + 256 * j; *(f32x4*)(xr + c) = (v[j] * rs) * *(const f32x4*)(G + c); } }
}

constexpr int PH_PAIR = 21, NPH = 2 + 2 * PH_PAIR;
#ifndef MK_ONE_LAUNCH
#define MK_ONE_LAUNCH 0
#endif
#define IN(k) (lo <= (k) && (k) < hi)
#define FRESH(tag) do { int z_; asm volatile("s_mov_b32 %0, 0 ; MARK " tag : "=s"(z_) :: "memory"); F.lane = (int)__builtin_amdgcn_mbcnt_hi(~0u, __builtin_amdgcn_mbcnt_lo(~0u, (unsigned)z_)); F.tid = F.wave * 64 + F.lane; } while (0)
#define SEAM(k) do { if (IN(k) && IN((k) + 1)) xcd_barrier(bar, F.tid); } while (0)
#define WSP(off) (ARG_WS + (off))
#define H_ ((bf16_t*)WSP(WS_H))
#define WT_ ((bf16_t*)WSP(WS_WT))
#define R1_ ((bf16_t*)WSP(WS_R1))
#define XC_ ((float*)WSP(WS_XC))
#define MODL(l) ((const float*)WSP(WS_MOD) + (size_t)(l) * 17 * 6144)
template <int I>
__device__ __forceinline__ void layer_pair(Frame& F, const XcdBarrier& bar, const int lo, const int hi, unsigned char* lds, int bx) {
    using namespace pg8;
    const PG8_LAS int* TAB = (const PG8_LAS int*)(F.lds + TAB_OFF);
    constexpr int il = I; constexpr int pb = 1 + PH_PAIR * il;
        { const int l = 2 * il;
        FRESH("0"); if (IN(pb + 0)) wconv_phase(F, l);
        SEAM(pb + 0);
        FRESH("1"); if (IN(pb + 1)) norm_phase<false>(F, l, 0, false);
        SEAM(pb + 1);
        FRESH("2"); if (IN(pb + 2)) { Gemm g{H_, WT_ + WT_IN / 2, M_ALL, EV_IN, D}; MapOrder S; S.init(M_ALL / 256, EV_IN / 256, F.G, bx, 0); EpiEvenIn E{R1_};
            gemm_phase<EpiEvenIn, MapOrder, true, true>(F.lds + RING_OFF, g, S, E, F.tid); }
        SEAM(pb + 2);
        FRESH("3"); if (IN(pb + 3)) qkpost_phase<true>(F, l);
        SEAM(pb + 3);
        FRESH("4"); if (IN(pb + 4)) { conv_phase(F, l); attn_even_phase(F, lds); }
        SEAM(pb + 4);
        FRESH("5"); if (IN(pb + 5)) { Gemm g{H_, WT_ + WT_OUT / 2, M_ALL, D, D}; MapOrder S; S.init(M_ALL / 256, D / 256, F.G, bx, 0); EpiResid E{ARG_OUT, XC_, MODL(l) + 2 * D};
            gemm_phase<EpiResid, MapOrder, true, true>(F.lds + RING_OFF, g, S, E, F.tid); }
        SEAM(pb + 5);
        FRESH("6"); if (IN(pb + 6)) norm_phase<false>(F, l, 1, false);
        SEAM(pb + 6);
        FRESH("7"); if (IN(pb + 7)) { Gemm g{H_, WT_ + WT_GU / 2, M_ALL, 2 * FF, D}; MapOrder S; S.init(M_ALL / 256, 2 * FF / 256, F.G, bx, 0); EpiSwiGLU E{R1_, 2 * FF / 256};
            gemm_phase<EpiSwiGLU, MapOrder, true, true>(F.lds + RING_OFF, g, S, E, F.tid); }
        SEAM(pb + 7);
        FRESH("8"); if (IN(pb + 8)) { Gemm g{R1_, WT_ + WT_DN / 2, M_ALL, D, FF}; MapOrder S; S.init(M_ALL / 256, D / 256, F.G, bx, 0); EpiResid E{ARG_OUT, XC_, MODL(l) + 5 * D};
            gemm_phase<EpiResid, MapOrder, true, true>(F.lds + RING_OFF, g, S, E, F.tid); }
        SEAM(pb + 8);
        }
        { const int l = 2 * il + 1; const bool need_ctx = (l < 3);
        FRESH("9"); if (IN(pb + 9)) wconv_phase(F, l);
        SEAM(pb + 9);
        FRESH("10"); if (IN(pb + 10)) norm_phase<false>(F, l, 0, false);
        SEAM(pb + 10);
        FRESH("11"); if (IN(pb + 11)) { Gemm g{H_, WT_ + WT_IN / 2, M_ALL, OD_IN, D}; MapOrder S; S.init(M_ALL / 256, OD_IN / 256, F.G, bx, 0); EpiStoreBf16 E{R1_, OD_IN, 0};
            gemm_phase<EpiStoreBf16, MapOrder, true, true>(F.lds + RING_OFF, g, S, E, F.tid); }
        SEAM(pb + 11);
        FRESH("12"); if (IN(pb + 12)) qkpost_phase<false>(F, l);
        SEAM(pb + 12);
        FRESH("13"); if (IN(pb + 13)) attn_odd_phase(F, lds, need_ctx);
        SEAM(pb + 13);
        FRESH("14"); if (IN(pb + 14)) diffcomb_phase(F, l, need_ctx);
        SEAM(pb + 14);
        FRESH("15"); if (IN(pb + 15)) { Gemm g{H_, WT_ + WT_OUT / 2, M_ALL, D, D}; MapOrder S; S.init(need_ctx ? M_ALL / 256 : NB * 8, D / 256, F.G, bx, need_ctx ? 0 : 1); EpiResid E{ARG_OUT, XC_, MODL(l) + 2 * D};
            gemm_phase<EpiResid, MapOrder, true, true>(F.lds + RING_OFF, g, S, E, F.tid); }
        SEAM(pb + 15);
        FRESH("16"); if (IN(pb + 16)) norm_phase<true>(F, l, 1, !need_ctx);
        SEAM(pb + 16);
        FRESH("17"); if (IN(pb + 17)) moe_assign_phase(F, l, !need_ctx);
        SEAM(pb + 17);
        FRESH("18"); if (IN(pb + 18)) { moe_tables(F, il); Gemm g{(const bf16_t*)WSP(WS_HP), WT_ + WT_GU / 2, MAX_SLOTS, NE * 2 * FF, D}; MapOrder S; S.init(__builtin_amdgcn_readfirstlane(TAB[336]), 2 * FF / 256, F.G, bx, 2, 0, 2 * FF / 256, TAB); EpiSwiGLU E{R1_, 2 * FF / 256};
            gemm_phase<EpiSwiGLU, MapOrder, true, true>(F.lds + RING_OFF, g, S, E, F.tid); }
        SEAM(pb + 18);
        FRESH("19"); if (IN(pb + 19)) { moe_tables(F, il); Gemm g{R1_, WT_ + WT_DN / 2, MAX_SLOTS, NE * D, FF}; MapOrder S; S.init(__builtin_amdgcn_readfirstlane(TAB[337]), D / 256, F.G, bx, 2, 0, D / 256, TAB);
            EpiResidMoe E{ARG_OUT, XC_, MODL(l) + 5 * D, (const int*)WSP(WS_SLOT_TOK), (const float*)WSP(WS_SLOT_W)};
            gemm_phase<EpiResidMoe, MapOrder, true, true>(F.lds + RING_OFF, g, S, E, F.tid); }
        SEAM(pb + 19);
        FRESH("20"); if (IN(pb + 20)) { moe_tables(F, il); Gemm g{R1_, WT_ + WT_DN / 2, MAX_SLOTS, NE * D, FF}; MapOrder S; S.init(__builtin_amdgcn_readfirstlane(TAB[336] - TAB[337]), D / 256, F.G, bx, 2, __builtin_amdgcn_readfirstlane(TAB[337]), D / 256, TAB);
            EpiResidMoe E{ARG_OUT, XC_, MODL(l) + 5 * D, (const int*)WSP(WS_SLOT_TOK), (const float*)WSP(WS_SLOT_W)};
            gemm_phase<EpiResidMoe, MapOrder, true, true>(F.lds + RING_OFF, g, S, E, F.tid); }
        SEAM(pb + 20);
        }
}
__global__ void __launch_bounds__(NWAVES * 64, 2) fwd(Args args) {
    extern __shared__ __attribute__((aligned(16))) unsigned char lds[];
    Frame F;
    F.lds = (LAS unsigned char*)lds;
    F.tid = threadIdx.x; F.lane = F.tid & 63; F.wave = __builtin_amdgcn_readfirstlane(F.tid >> 6); asm volatile("" : "+s"(F.wave));
    F.G = gridDim.x; { const int bx = blockIdx.x; F.vcu = (F.G % 8 == 0) ? (bx % 8) * (F.G / 8) + bx / 8 : bx; }
    F.ctl = (gu32*)(args.ws + WS_CTL);
    for (int u = F.tid; u < (LDS_BYTES - LDSCTL_OFF) / 4; u += NWAVES * 64) ((LAS unsigned*)(F.lds + LDSCTL_OFF))[u] = 0u;
    __syncthreads();
    if (F.tid < 58) { const unsigned* ka = (const unsigned*)__builtin_amdgcn_kernarg_segment_ptr(); ((LAS unsigned*)(F.lds + ARGS_OFF))[F.tid] = ka[F.tid]; }
    __syncthreads();
    const int lo = args.ph_lo, hi = args.ph_hi; int bx = (int)blockIdx.x;
    XcdBarrier bar; bar.bar = (unsigned*)(F.ctl + CW_BAR); bar.x = 0; bar.st = nullptr;
    if (hi - lo > 1) bar = xcd_barrier_post((unsigned*)(F.ctl + CW_BAR), (volatile LAS unsigned*)(F.lds + MISC_OFF) + 8, F.tid);

    FRESH("P0"); if (IN(0)) p0_phase(F);
    SEAM(0);
    layer_pair<0>(F, bar, lo, hi, lds, bx);
    layer_pair<1>(F, bar, lo, hi, lds, bx);
    FRESH("FINAL"); if (IN(NPH - 1)) final_phase(F);
#undef IN
#undef SEAM
}

extern "C" void kernel_launch(void* const* d_in, const int* in_sizes, int n_in, void* d_out, int out_size, void* d_ws, size_t ws_size, hipStream_t stream) {
    static int grid = 0;
    if (grid == 0) {
        if (n_in != 27 || out_size != NB * SEQ * D || ws_size < WS_END) { fprintf(stderr, "kernel_launch: unexpected shapes: n_in %d out %d ws %zu (need %zu)\n", n_in, out_size, ws_size, (size_t)WS_END); grid = -1; return; }
        int dev = 0, cus = 0, per_cu = 0;
        if (hipGetDevice(&dev) != hipSuccess || hipDeviceGetAttribute(&cus, hipDeviceAttributeMultiprocessorCount, dev) != hipSuccess) { grid = -1; return; }
        if (hipFuncSetAttribute((const void*)fwd, hipFuncAttributeMaxDynamicSharedMemorySize, LDS_BYTES) != hipSuccess) { fprintf(stderr, "kernel_launch: hipFuncSetAttribute failed\n"); grid = -1; return; }
        if (hipOccupancyMaxActiveBlocksPerMultiprocessor(&per_cu, (const void*)fwd, NWAVES * 64, LDS_BYTES) != hipSuccess || per_cu < 1) fprintf(stderr, "kernel_launch: occupancy query reports %d blocks per CU\n", per_cu);
        (void)hipGetLastError();
        grid = cus;
    }
    if (grid < 0) return;
    (void)hipMemsetAsync((char*)d_ws + WS_CTL, 0, CTL_ZERO_BYTES, stream);
    Args a{};
    for (int i = 0; i < 27; ++i) a.in[i] = (const float*)d_in[i];
    a.out = (float*)d_out; a.ws = (unsigned char*)d_ws;
#if MK_ONE_LAUNCH
    a.ph_lo = 0; a.ph_hi = NPH;
    hipLaunchKernelGGL(fwd, dim3(grid), dim3(NWAVES * 64), LDS_BYTES, stream, a);
#else
    for (int p = 0; p < NPH; ++p) { a.ph_lo = p; a.ph_hi = p + 1; hipLaunchKernelGGL(fwd, dim3(grid), dim3(NWAVES * 64), LDS_BYTES, stream, a); }
#endif
    const hipError_t le = hipPeekAtLastError();
    if (le != hipSuccess) fprintf(stderr, "kernel_launch: launch failed: %s\n", hipGetErrorName(le));
}
```

```cpp
#include <hip/hip_runtime.h>
#include <hip/hip_bf16.h>
#include <cstdio>
#include <cstdint>
#include <cmath>
#include <type_traits>
#define MK_ONE_LAUNCH 1
#define PROBE_DUP 0
#define FFN_FP8 14
#define FFN_FP8_DN 15
#define PROBE_UDUP -1
#define W8IN_MASK 3
#define W8OUT_MASK 0
#define W8EV_MASK 0
namespace pg8 {
#define PG8_LAS __attribute__((address_space(3)))
typedef unsigned short bf16_t;
typedef short bf16x8 __attribute__((ext_vector_type(8)));
typedef float f32x4 __attribute__((ext_vector_type(4)));
typedef unsigned u32x4 __attribute__((ext_vector_type(4)));
constexpr int BM = 256, BK = 64, HALF = 128, HTB = HALF * BK * 2  , STAGE_BYTES = 8 * HTB, NXCD = 8, WGM = 8;

__host__ __device__ __forceinline__ int lds_byte(int r, int c) { const int st = (r >> 4) * 2 + (c >> 5), rr = r & 15, cc = c & 31, ob = rr * 64 + cc * 2; return st * 1024 + (ob ^ (((ob >> 9) & 1) << 5)); }
__host__ __device__ __forceinline__ void stage_rc(int b, int& R, int& C) { const int st = b / 1024, sb = b % 1024, swz = sb ^ (((sb >> 9) & 1) << 5); R = (st >> 1) * 16 + swz / 64; C = (st & 1) * 32 + (swz % 64) / 2; }
__host__ __device__ __forceinline__ int perm32(int rho) { const int n = rho >> 4, i = rho & 15; return 8 * (i >> 2) + 4 * n + (i & 3); }

#if PROBE_UDUP >= 0
struct Unit { int pm, pn, dup; };
#else
struct Unit { int pm, pn; };
#endif
struct Gemm { const bf16_t* A; const bf16_t* Bt; int M, N, K; };
typedef int v4i_t __attribute__((ext_vector_type(4))); typedef int v8i_t __attribute__((ext_vector_type(8)));

struct StaticOrder {
#if PROBE_UDUP >= 0
    int nM, nN, nwg, G, c, tot;
    __host__ __device__ void init(int M, int N, int G_, int c_) { nM = M / BM; nN = N / BM; nwg = nM * nN; G = G_; c = c_; tot = nwg; }
    __host__ __device__ bool next(int i, Unit& u) const { const long L = (long)i * G + c; if (L >= tot) return false; decode((int)(L % nwg), u); u.dup = (L >= nwg); return true; }
#else
    int nM, nN, nwg, G, c;
    __host__ __device__ void init(int M, int N, int G_, int c_) { nM = M / BM; nN = N / BM; nwg = nM * nN; G = G_; c = c_; }
    __host__ __device__ bool next(int i, Unit& u) const { const long L = (long)i * G + c; if (L >= nwg) return false; decode((int)L, u); return true; }
#endif
    __host__ __device__ void decode(int L, Unit& u) const {
        int wgid = L; { const int q = nwg / NXCD, r = nwg % NXCD, xcd = wgid % NXCD, off = wgid / NXCD; wgid = (xcd < r ? xcd * (q + 1) : r * (q + 1) + (xcd - r) * q) + off; }
        const int nig = WGM * nN, gid = wgid / nig, fm = gid * WGM, gsz = (nM - fm) < WGM ? (nM - fm) : WGM;
        u.pm = fm + ((wgid % nig) % gsz); u.pn = (wgid % nig) / gsz;
    }
    __device__ __forceinline__ void a_ready(const Unit&) const {}
    __device__ __forceinline__ void done(const Unit&) const {}
};

__device__ __forceinline__ unsigned cvt_pk_bf16(float lo, float hi) { unsigned r; asm volatile("v_cvt_pk_bf16_f32 %0, %1, %2" : "=v"(r) : "v"(lo), "v"(hi)); return r; }
template <class...> struct mk_void { typedef void type; };
template <class E, class = void> struct epi_split { static constexpr int nst = -1; };
template <class E> struct epi_split<E, typename mk_void<decltype(E::NST_HALF)>::type> { static constexpr int nst = E::NST_HALF; };
template <bool F8> struct FragT { struct type { bf16x8 k[2]; }; };
template <> struct FragT<true> { typedef v8i_t type; };
template <class Epi, class Sched, bool ALIGN_EPI = false, bool SP2 = false, bool F8 = false>
__device__ __forceinline__ void gemm_phase(PG8_LAS unsigned char* lds, const Gemm g, const Sched& S, const Epi& E, const int tid) {
    const int wid = __builtin_amdgcn_readfirstlane(tid >> 6), lane = tid & 63, wr = wid >> 2, wc = wid & 3, fr = lane & 15, fq = lane >> 4;
    const int K = g.K, nt = K / BK;
    unsigned voffA, voffB;
    { int R, C; stage_rc(tid * 16, R, C); const int Rb = Epi::PERM ? ((R & ~31) + perm32(R & 31)) : R; voffA = (unsigned)(R * K + C) * 2u; voffB = (unsigned)(Rb * K + C) * 2u; }
    const unsigned p1step = 64u * (unsigned)K * 2u;
    const unsigned kstep = (unsigned)(BK * 2);
    const unsigned hstep = (unsigned)HALF * K * 2;
    const unsigned tstep = 2 * hstep;
    const unsigned ldsw = (unsigned)wid * 1024u;
    int aoff = lds_byte(wr * 64 + fr, fq * 8), boff = lds_byte(wc * 32 + fr, fq * 8) + 4 * HTB;
    asm volatile("" : "+v"(aoff), "+v"(boff));
#define PG8_SA(b, h) (((b) * 2 + (h)) * HTB)
#define PG8_SB(b, h) ((4 + (b) * 2 + (h)) * HTB)
#define PG8_SBR(b, h) (((b) * 2 + (h)) * HTB)
#define PG8_STAGE(bufoff, goff, voff) do { _Pragma("unroll") for (int _i = 0; _i < 2; ++_i) \
        __builtin_amdgcn_raw_ptr_buffer_load_lds(rsrc_##voff, (PG8_LAS void*)(lds + (bufoff) + ldsw + _i * 8192), 16, voff, (int)((goff) + _i * p1step), 0, 0); } while (0)
#define PG8_LD16(p) (*(const PG8_LAS bf16x8*)(p))
#define PG8_LDF(dst, p) do { if constexpr (F8) dst = __builtin_shufflevector(__builtin_bit_cast(v4i_t, PG8_LD16(p)), __builtin_bit_cast(v4i_t, PG8_LD16((p) + 1024)), 0, 1, 2, 3, 4, 5, 6, 7); else { dst.k[0] = PG8_LD16(p); dst.k[1] = PG8_LD16((p) + 1024); } } while (0)
#define PG8_LDA(dst, b, h) do { _Pragma("unroll") for (int m = 0; m < 4; ++m) PG8_LDF(dst[m], lds + aoff + (PG8_SA(b, h) + m * 2048)); } while (0)
#define PG8_LDB(dst, b, h) do { _Pragma("unroll") for (int n = 0; n < 2; ++n) PG8_LDF(dst[n], lds + boff + (PG8_SBR(b, h) + n * 2048)); } while (0)
#define PG8_MMA(ai, bj, At, Bt) do { __builtin_amdgcn_s_setprio(1); _Pragma("unroll") for (int m = 0; m < 4; ++m) _Pragma("unroll") for (int n = 0; n < 2; ++n) { \
        if constexpr (F8) acc[ai][bj][m][n] = __builtin_amdgcn_mfma_scale_f32_16x16x128_f8f6f4(Bt[n], At[m], acc[ai][bj][m][n], 0, 0, 0, 0, 0, 0); \
        else { _Pragma("unroll") for (int k = 0; k < 2; ++k) acc[ai][bj][m][n] = __builtin_amdgcn_mfma_f32_16x16x32_bf16(Bt[n].k[k], At[m].k[k], acc[ai][bj][m][n], 0, 0, 0); } } __builtin_amdgcn_s_setprio(0); } while (0)
#define PG8_WAIT_V(n) asm volatile("s_waitcnt vmcnt(" #n ")" ::: "memory")
#define PG8_WAIT_VN(n) asm volatile("s_waitcnt vmcnt(%0)" :: "n"(n) : "memory")
#define PG8_EPI_HALF(AI, un) do { if constexpr (SPLIT) { int z_e; asm volatile("s_mov_b32 %0, 0" : "=s"(z_e)); const int lane_e = (int)__builtin_amdgcn_mbcnt_hi(~0u, __builtin_amdgcn_mbcnt_lo(~0u, (unsigned)z_e)); \
        E.template half<AI>(acc, un, wr, wc, lane_e & 15, lane_e >> 4); \
        _Pragma("unroll") for (int b_ = 0; b_ < 2; ++b_) _Pragma("unroll") for (int m_ = 0; m_ < 4; ++m_) _Pragma("unroll") for (int n_ = 0; n_ < 2; ++n_) acc[AI][b_][m_][n_] = (f32x4){0.f, 0.f, 0.f, 0.f}; } } while (0)
#define PG8_WAIT_L(n) asm volatile("s_waitcnt lgkmcnt(" #n ")" ::: "memory")
#define PG8_BAR __builtin_amdgcn_s_barrier()
#define PG8_SCHED __builtin_amdgcn_sched_barrier(0)
    constexpr bool SPLIT = SP2 && !Epi::AFTER_DRAIN && (epi_split<Epi>::nst >= 0); constexpr int NST = SPLIT ? epi_split<Epi>::nst : 0;
    Unit cur, nxt, prv; int ui = 0;
    if (!S.next(0, cur)) return;
    prv = cur;
    f32x4 acc[2][2][4][2];
#pragma unroll
    for (int a = 0; a < 2; ++a)
#pragma unroll
        for (int b = 0; b < 2; ++b)
#pragma unroll
            for (int m = 0; m < 4; ++m)
#pragma unroll
                for (int n = 0; n < 2; ++n) acc[a][b][m][n] = (f32x4){0.f, 0.f, 0.f, 0.f};
    typedef typename FragT<F8>::type frag_t; frag_t At[4], B0[2], B1[2];
    unsigned cA = (unsigned)cur.pm * tstep, cB = (unsigned)cur.pn * tstep;
    const __amdgpu_buffer_rsrc_t rsrc_voffA = __builtin_amdgcn_make_buffer_rsrc((void*)g.A, 0, 0x7fffffff, 0x00020000), rsrc_voffB = __builtin_amdgcn_make_buffer_rsrc((void*)g.Bt, 0, 0x7fffffff, 0x00020000);
    S.a_ready(cur);
    if constexpr (SP2) {
        PG8_STAGE(PG8_SB(0, 0), cB, voffB); PG8_STAGE(PG8_SB(0, 1), cB + hstep, voffB); PG8_STAGE(PG8_SA(0, 0), cA, voffA); PG8_STAGE(PG8_SA(0, 1), cA + hstep, voffA);
        if (wr == 1) PG8_BAR;
        PG8_WAIT_V(2); PG8_BAR;
        PG8_STAGE(PG8_SB(1, 0), cB + kstep, voffB); PG8_STAGE(PG8_SA(1, 0), cA + kstep, voffA); PG8_STAGE(PG8_SB(1, 1), cB + hstep + kstep, voffB);
        PG8_WAIT_V(6); PG8_BAR;
    } else {
        PG8_STAGE(PG8_SB(0, 0), cB, voffB); PG8_STAGE(PG8_SA(0, 0), cA, voffA); PG8_STAGE(PG8_SB(0, 1), cB + hstep, voffB); PG8_STAGE(PG8_SA(0, 1), cA + hstep, voffA);
        if (wr == 1) PG8_BAR;
        PG8_WAIT_V(4); PG8_BAR;
        PG8_STAGE(PG8_SB(1, 0), cB + kstep, voffB); PG8_STAGE(PG8_SA(1, 0), cA + kstep, voffA); PG8_STAGE(PG8_SB(1, 1), cB + hstep + kstep, voffB);
        PG8_WAIT_V(6); PG8_BAR;
    }
    for (;;) {
        const bool has_next = S.next(ui + 1, nxt);
        const unsigned nA = has_next ? (unsigned)nxt.pm * tstep : cA, nB = has_next ? (unsigned)nxt.pn * tstep : cB;
#pragma nounroll
        for (int t = 0; t < nt; t += 2) {
            const bool last = (t == nt - 2);
            const unsigned a1 = cA + (unsigned)(t + 1) * kstep;
            const unsigned a2 = last ? nA : cA + (unsigned)(t + 2) * kstep, b2 = last ? nB : cB + (unsigned)(t + 2) * kstep;
            const unsigned a3 = a2 + kstep, b3 = b2 + kstep;
            if (last && has_next) S.a_ready(nxt);
            if constexpr (SP2) {
            if (SPLIT && t == 0 && ui > 0) {
                PG8_STAGE(PG8_SA(1, 1), a1 + hstep, voffA); PG8_SCHED;
                PG8_EPI_HALF(1, prv); PG8_SCHED;
                PG8_LDB(B0, 0, 0); PG8_LDB(B1, 0, 1); PG8_SCHED; PG8_LDA(At, 0, 0);
                PG8_WAIT_VN(8 + NST); PG8_WAIT_L(0); PG8_BAR;
            } else {
            PG8_LDB(B0, 0, 0); PG8_LDB(B1, 0, 1); PG8_SCHED; PG8_LDA(At, 0, 0); PG8_STAGE(PG8_SA(1, 1), a1 + hstep, voffA);
            PG8_WAIT_V(8); PG8_WAIT_L(0); PG8_BAR; }
            PG8_MMA(0, 0, At, B0); PG8_MMA(0, 1, At, B1); PG8_BAR; PG8_SCHED;
            PG8_LDA(At, 0, 1); PG8_STAGE(PG8_SB(0, 0), b2, voffB); PG8_STAGE(PG8_SB(0, 1), b2 + hstep, voffB); PG8_STAGE(PG8_SA(0, 0), a2, voffA);
            PG8_WAIT_V(8); PG8_WAIT_L(0); PG8_BAR; PG8_MMA(1, 0, At, B0); PG8_MMA(1, 1, At, B1); PG8_BAR; PG8_SCHED;
            PG8_LDB(B0, 1, 0); PG8_LDB(B1, 1, 1); PG8_SCHED; PG8_LDA(At, 1, 0); PG8_STAGE(PG8_SA(0, 1), a2 + hstep, voffA);
            PG8_WAIT_V(8); PG8_WAIT_L(0); PG8_BAR; PG8_MMA(0, 0, At, B0); PG8_MMA(0, 1, At, B1); PG8_BAR; PG8_SCHED;
            if (SPLIT && last) {
                PG8_STAGE(PG8_SB(1, 0), b3, voffB); PG8_STAGE(PG8_SB(1, 1), b3 + hstep, voffB); PG8_STAGE(PG8_SA(1, 0), a3, voffA); PG8_SCHED;
                PG8_EPI_HALF(0, cur); PG8_SCHED;
                PG8_LDA(At, 1, 1);
                PG8_WAIT_VN(8 + NST); PG8_WAIT_L(0); PG8_BAR;
            } else {
            PG8_LDA(At, 1, 1); PG8_STAGE(PG8_SB(1, 0), b3, voffB); PG8_STAGE(PG8_SB(1, 1), b3 + hstep, voffB); PG8_STAGE(PG8_SA(1, 0), a3, voffA);
            PG8_WAIT_V(8); PG8_WAIT_L(0); PG8_BAR; }
            PG8_MMA(1, 0, At, B0); PG8_MMA(1, 1, At, B1); PG8_BAR; PG8_SCHED;
            } else {
            PG8_LDB(B0, 0, 0); PG8_SCHED; PG8_LDA(At, 0, 0); PG8_STAGE(PG8_SA(1, 1), a1 + hstep, voffA);
            PG8_WAIT_L(8); PG8_BAR; PG8_WAIT_L(0); PG8_MMA(0, 0, At, B0); PG8_BAR; PG8_SCHED;
            PG8_LDB(B1, 0, 1); PG8_STAGE(PG8_SB(0, 0), b2, voffB);
            PG8_BAR; PG8_WAIT_L(0); PG8_MMA(0, 1, At, B1); PG8_BAR;
            PG8_LDA(At, 0, 1); PG8_STAGE(PG8_SA(0, 0), a2, voffA);
            PG8_BAR; PG8_WAIT_L(0); PG8_MMA(1, 0, At, B0); PG8_BAR; PG8_SCHED;
            PG8_STAGE(PG8_SB(0, 1), b2 + hstep, voffB);
            PG8_WAIT_V(6); PG8_BAR; PG8_MMA(1, 1, At, B1); PG8_BAR;
            PG8_LDB(B0, 1, 0); PG8_SCHED; PG8_LDA(At, 1, 0); PG8_STAGE(PG8_SA(0, 1), a2 + hstep, voffA);
            PG8_WAIT_L(8); PG8_BAR; PG8_WAIT_L(0); PG8_MMA(0, 0, At, B0); PG8_BAR; PG8_SCHED;
            PG8_LDB(B1, 1, 1); PG8_STAGE(PG8_SB(1, 0), b3, voffB);
            PG8_BAR; PG8_WAIT_L(0); PG8_MMA(0, 1, At, B1); PG8_BAR;
            PG8_LDA(At, 1, 1); PG8_STAGE(PG8_SA(1, 0), a3, voffA);
            PG8_BAR; PG8_WAIT_L(0); PG8_MMA(1, 0, At, B0); PG8_BAR; PG8_SCHED;
            PG8_STAGE(PG8_SB(1, 1), b3 + hstep, voffB);
            PG8_WAIT_V(6); PG8_BAR; PG8_MMA(1, 1, At, B1); PG8_BAR;
            }
        }
        if constexpr (SPLIT) {
            S.done(cur); prv = cur;
            if (!has_next) { PG8_EPI_HALF(1, cur); break; }
            cur = nxt; cA = nA; cB = nB; ++ui; continue;
        }
        if constexpr (ALIGN_EPI) { if (wr == 0) PG8_BAR; }
        if constexpr (!Epi::AFTER_DRAIN) { int z_e; asm volatile("s_mov_b32 %0, 0" : "=s"(z_e)); const int lane_e = (int)__builtin_amdgcn_mbcnt_hi(~0u, __builtin_amdgcn_mbcnt_lo(~0u, (unsigned)z_e)); const int fr_e = lane_e & 15, fq_e = lane_e >> 4;
#if PROBE_UDUP >= 0 && defined(PROBE_NOEPI)
            if (!cur.dup)
#endif
            E(acc, cur, wr, wc, fr_e, fq_e); S.done(cur); }
        if (!has_next) break;
#pragma unroll
        for (int a = 0; a < 2; ++a)
#pragma unroll
            for (int b = 0; b < 2; ++b)
#pragma unroll
                for (int m = 0; m < 4; ++m)
#pragma unroll
                    for (int n = 0; n < 2; ++n) acc[a][b][m][n] = (f32x4){0.f, 0.f, 0.f, 0.f};
        cur = nxt; cA = nA; cB = nB; ++ui;
        if constexpr (ALIGN_EPI) { if (wr == 1) PG8_BAR; }
    }
    PG8_WAIT_V(0);
    if constexpr (!ALIGN_EPI || SPLIT) { if (wr == 0) PG8_BAR; }
    PG8_BAR;
    if constexpr (Epi::AFTER_DRAIN) { E.fused(acc, cur, wr, wc, fr, fq, lds, wid, lane); S.done(cur); }
#undef PG8_SA
#undef PG8_SB
#undef PG8_SBR
#undef PG8_STAGE
#undef PG8_LDA
#undef PG8_LDB
#undef PG8_MMA
#undef PG8_LDF
#undef PG8_LD16
#undef PG8_WAIT_V
#undef PG8_WAIT_L
#undef PG8_WAIT_VN
#undef PG8_EPI_HALF
#undef PG8_BAR
#undef PG8_SCHED
}
}
constexpr int D = 1024, NB = 16, SEQ = 2048, CTXL = 256, RB = SEQ + CTXL  , M_ALL = NB * RB  ;
constexpr int FF = 3584, NE = 8;
constexpr int EV_IN = 1792, EV_P = 1280;
constexpr int OD_IN = 3072;
constexpr int OP_P = 2048;
constexpr int MAX_SLOT_TILES = 304, MAX_SLOTS = MAX_SLOT_TILES * 256;
#ifndef DIFF_V128
#define DIFF_V128 1
#endif
#ifndef FFN_FP8
#define FFN_FP8 14
#endif
#ifndef FFN_FP8_DN
#define FFN_FP8_DN FFN_FP8
#endif
constexpr int F8_MASK = FFN_FP8, F8D_MASK = FFN_FP8_DN;
constexpr float LOG2E = 1.4426950408889634f;
constexpr float QSCALE = 0.125f * LOG2E;

__device__ __forceinline__ float fast_sigmoid(float x) { return __builtin_amdgcn_rcpf(1.f + __builtin_amdgcn_exp2f(-x * LOG2E)); }
__device__ __forceinline__ float fast_silu(float x) { return x * fast_sigmoid(x); }
__device__ __forceinline__ unsigned pk4_fp8(float a, float b, float c, float d) { int w = __builtin_amdgcn_cvt_pk_fp8_f32(a, b, 0, false); w = __builtin_amdgcn_cvt_pk_fp8_f32(c, d, w, true); return (unsigned)w; }

namespace pg8 {
struct EpiStoreBf16 {
    static constexpr bool PERM = true, AFTER_DRAIN = false;
    bf16_t* O; int ldc; int coloff;
    __device__ __forceinline__ void operator()(const f32x4 (&acc)[2][2][4][2], const Unit& u, int wr, int wc, int fr, int fq) const {
        const int row0 = u.pm * BM + wr * 64 + fr, col0 = coloff + u.pn * BM + wc * 32 + 8 * fq;
#pragma unroll
        for (int ai = 0; ai < 2; ++ai)
#pragma unroll
            for (int m = 0; m < 4; ++m) { bf16_t* rowp = O + (size_t)(row0 + ai * HALF + m * 16) * ldc + col0;
#pragma unroll
                for (int bj = 0; bj < 2; ++bj) { const f32x4 v0 = acc[ai][bj][m][0], v1 = acc[ai][bj][m][1];
                    u32x4 w; w.x = cvt_pk_bf16(v0[0], v0[1]); w.y = cvt_pk_bf16(v0[2], v0[3]); w.z = cvt_pk_bf16(v1[0], v1[1]); w.w = cvt_pk_bf16(v1[2], v1[3]);
                    *(u32x4*)(rowp + bj * HALF) = w; } }
    }
};
struct EpiEvenIn {
    static constexpr bool PERM = true, AFTER_DRAIN = false;
    bf16_t* EV;
    __device__ __forceinline__ void operator()(const f32x4 (&acc)[2][2][4][2], const Unit& u, int wr, int wc, int fr, int fq) const {
        const int row0 = u.pm * BM + wr * 64 + fr;
        if (u.pn < 4) {
            const int col0 = u.pn * HALF + wc * 32 + 8 * fq;
#pragma unroll
            for (int ai = 0; ai < 2; ++ai)
#pragma unroll
                for (int m = 0; m < 4; ++m) { bf16_t* rowp = EV + (size_t)(row0 + ai * HALF + m * 16) * EV_P + col0;
                    const f32x4 a0 = acc[ai][0][m][0], a1 = acc[ai][0][m][1], g0 = acc[ai][1][m][0], g1 = acc[ai][1][m][1];
                    u32x4 w; w.x = cvt_pk_bf16(a0[0] * fast_sigmoid(g0[0]), a0[1] * fast_sigmoid(g0[1])); w.y = cvt_pk_bf16(a0[2] * fast_sigmoid(g0[2]), a0[3] * fast_sigmoid(g0[3]));
                    w.z = cvt_pk_bf16(a1[0] * fast_sigmoid(g1[0]), a1[1] * fast_sigmoid(g1[1])); w.w = cvt_pk_bf16(a1[2] * fast_sigmoid(g1[2]), a1[3] * fast_sigmoid(g1[3]));
                    *(u32x4*)rowp = w; }
        } else {
            const int col0 = 512 + (u.pn - 4) * BM + wc * 32 + 8 * fq;
#pragma unroll
            for (int ai = 0; ai < 2; ++ai)
#pragma unroll
                for (int m = 0; m < 4; ++m) { bf16_t* rowp = EV + (size_t)(row0 + ai * HALF + m * 16) * EV_P + col0;
#pragma unroll
                    for (int bj = 0; bj < 2; ++bj) { const f32x4 v0 = acc[ai][bj][m][0], v1 = acc[ai][bj][m][1];
                        u32x4 w; w.x = cvt_pk_bf16(v0[0], v0[1]); w.y = cvt_pk_bf16(v0[2], v0[3]); w.z = cvt_pk_bf16(v1[0], v1[1]); w.w = cvt_pk_bf16(v1[2], v1[3]);
                        *(u32x4*)(rowp + bj * HALF) = w; } }
        }
    }
};
__device__ __forceinline__ void st16_swap(bf16_t* p, const unsigned __attribute__((ext_vector_type(2))) w1, const unsigned __attribute__((ext_vector_type(2))) w2) {
    const auto sx = __builtin_amdgcn_permlane16_swap(w1.x, w2.x, false, false), sy = __builtin_amdgcn_permlane16_swap(w1.y, w2.y, false, false);
    u32x4 w; w.x = sx[0]; w.y = sy[0]; w.z = sx[1]; w.w = sy[1]; *(u32x4*)p = w;
}
struct EpiOddIn {
    static constexpr bool PERM = false, AFTER_DRAIN = false;
    bf16_t* QKV; const float* cosT; float asc;
    __device__ __forceinline__ void operator()(const f32x4 (&acc)[2][2][4][2], const Unit& u, int wr, int wc, int fr, int fq) const {
        typedef unsigned u32x2 __attribute__((ext_vector_type(2)));
        const int b = u.pm / 9, jt = u.pm - 9 * b, kind = u.pn >> 2; const bool rope = (jt < 8) && (kind < 2); const float sc = ((kind == 0) ? QSCALE : 1.f) * asc;
        const float* sinT = cosT + 1024; const int col0 = u.pn * BM + wc * 32 + (fq & 1) * 16 + (fq >> 1) * 8;
        if (rope) {
            f32x4 cs[2][4], sn[2][4];
#pragma unroll
            for (int ai = 0; ai < 2; ++ai)
#pragma unroll
                for (int m = 0; m < 4; ++m) { const int t = jt * BM + ai * HALF + wr * 64 + m * 16 + fr; const int pv = (wc & 1) ? (t & 63) : (t >> 6);
                    cs[ai][m] = *(const f32x4*)(cosT + pv * 16 + 4 * fq) * sc; sn[ai][m] = *(const f32x4*)(sinT + pv * 16 + 4 * fq) * sc; }
#pragma unroll
            for (int ai = 0; ai < 2; ++ai)
#pragma unroll
                for (int m = 0; m < 4; ++m) { const int rowt = ai * HALF + wr * 64 + m * 16 + fr; bf16_t* rowp = QKV + (size_t)(u.pm * BM + rowt) * OD_IN + col0;
#pragma unroll
                    for (int bj = 0; bj < 2; ++bj) { const f32x4 x1 = acc[ai][bj][m][0], x2 = acc[ai][bj][m][1]; const f32x4 y1 = x1 * cs[ai][m] - x2 * sn[ai][m], y2 = x2 * cs[ai][m] + x1 * sn[ai][m];
                        u32x2 w1, w2; w1.x = cvt_pk_bf16(y1[0], y1[1]); w1.y = cvt_pk_bf16(y1[2], y1[3]); w2.x = cvt_pk_bf16(y2[0], y2[1]); w2.y = cvt_pk_bf16(y2[2], y2[3]);
                        st16_swap(rowp + bj * HALF, w1, w2); } }
        } else {
#pragma unroll
            for (int ai = 0; ai < 2; ++ai)
#pragma unroll
                for (int m = 0; m < 4; ++m) { const int rowt = ai * HALF + wr * 64 + m * 16 + fr; bf16_t* rowp = QKV + (size_t)(u.pm * BM + rowt) * OD_IN + col0;
#pragma unroll
                    for (int bj = 0; bj < 2; ++bj) { const f32x4 y1 = acc[ai][bj][m][0] * sc, y2 = acc[ai][bj][m][1] * sc;
                        u32x2 w1, w2; w1.x = cvt_pk_bf16(y1[0], y1[1]); w1.y = cvt_pk_bf16(y1[2], y1[3]); w2.x = cvt_pk_bf16(y2[0], y2[1]); w2.y = cvt_pk_bf16(y2[2], y2[3]);
                        st16_swap(rowp + bj * HALF, w1, w2); } }
        }
    }
};
struct EpiEvenIn2 {
    static constexpr bool PERM = false, AFTER_DRAIN = false;
    bf16_t* EV; const float* cosT; const float* qg; const float* kg; PG8_LAS float* SS; float asc;
    __device__ __forceinline__ void operator()(const f32x4 (&acc)[2][2][4][2], const Unit& u, int wr, int wc, int fr, int fq) const {
        typedef unsigned u32x2 __attribute__((ext_vector_type(2)));
        if (u.pn < 4) {
            const int col0 = u.pn * HALF + wc * 32 + (fq & 1) * 16 + (fq >> 1) * 8;
            const float ne = -asc * LOG2E;
#pragma unroll
            for (int ai = 0; ai < 2; ++ai)
#pragma unroll
                for (int m = 0; m < 4; ++m) { bf16_t* rowp = EV + (size_t)(u.pm * BM + ai * HALF + wr * 64 + m * 16 + fr) * EV_P + col0;
                    u32x2 w[2];
#pragma unroll
                    for (int n = 0; n < 2; ++n) { const f32x4 a = acc[ai][0][m][n], g = acc[ai][1][m][n];
                        #define GL_(a_, g_) ((a_) * asc * __builtin_amdgcn_rcpf(1.f + __builtin_amdgcn_exp2f((g_) * ne)))
                        w[n].x = cvt_pk_bf16(GL_(a[0], g[0]), GL_(a[1], g[1])); w[n].y = cvt_pk_bf16(GL_(a[2], g[2]), GL_(a[3], g[3])); }
#undef GL_
                    st16_swap(rowp, w[0], w[1]); }
            return;
        }
        const int b = u.pm / 9, jt = u.pm - 9 * b; const bool lat = jt < 8, isq = u.pn < 6;
#pragma unroll
        for (int ai = 0; ai < 2; ++ai)
#pragma unroll
            for (int m = 0; m < 4; ++m)
#pragma unroll
                for (int bj = 0; bj < 2; ++bj) { const f32x4 x1 = acc[ai][bj][m][0], x2 = acc[ai][bj][m][1];
                    float s = (x1[0] * x1[0] + x1[1] * x1[1]) + (x1[2] * x1[2] + x1[3] * x1[3]) + (x2[0] * x2[0] + x2[1] * x2[1]) + (x2[2] * x2[2] + x2[3] * x2[3]);
                    { const auto r_ = __builtin_amdgcn_permlane16_swap(__float_as_uint(s), __float_as_uint(s), false, false); s = __uint_as_float(r_[0]) + __uint_as_float(r_[1]); }
                    { const auto r_ = __builtin_amdgcn_permlane32_swap(__float_as_uint(s), __float_as_uint(s), false, false); s = __uint_as_float(r_[0]) + __uint_as_float(r_[1]); }
                    if (fq == 0) SS[(bj * BM + ai * HALF + wr * 64 + m * 16 + fr) * 4 + wc] = s; }
        asm volatile("s_waitcnt lgkmcnt(0)" ::: "memory"); __builtin_amdgcn_s_barrier(); asm volatile("" ::: "memory");
        const float* sinT = cosT + 1024; const int dcol = 32 * (wc & 1) + 4 * fq;
        const float* gq = isq ? qg : kg; const f32x4 g1 = *(const f32x4*)(gq + dcol), g2 = *(const f32x4*)(gq + dcol + 16);
        f32x4 csv[2][4], snv[2][4];
#pragma unroll
        for (int ai = 0; ai < 2; ++ai)
#pragma unroll
            for (int m = 0; m < 4; ++m) { const int t = jt * BM + ai * HALF + wr * 64 + m * 16 + fr; csv[ai][m] = (f32x4){1.f, 1.f, 1.f, 1.f}; snv[ai][m] = (f32x4){0.f, 0.f, 0.f, 0.f};
                if (lat) { const int pv = (wc & 1) ? (t & 63) : (t >> 6); csv[ai][m] = *(const f32x4*)(cosT + pv * 16 + 4 * fq); snv[ai][m] = *(const f32x4*)(sinT + pv * 16 + 4 * fq); } }
#pragma unroll
        for (int ai = 0; ai < 2; ++ai)
#pragma unroll
            for (int m = 0; m < 4; ++m) { const int rowt = ai * HALF + wr * 64 + m * 16 + fr; bf16_t* rowp = EV + (size_t)(u.pm * BM + rowt) * EV_P + 512 + (u.pn - 4) * BM + wc * 32 + (fq & 1) * 16 + (fq >> 1) * 8;
                const f32x4 cs = csv[ai][m], sn = snv[ai][m];
#pragma unroll
                for (int bj = 0; bj < 2; ++bj) { f32x4 y1 = acc[ai][bj][m][0], y2 = acc[ai][bj][m][1];
                    if (isq || bj == 0) { const PG8_LAS float* sp = SS + (bj * BM + rowt) * 4 + (wc & 2); const float rs = asc / sqrtf((sp[0] + sp[1]) * (asc * asc * (1.f / 64.f)) + 1e-6f);
                        const f32x4 x1 = y1 * rs * g1, x2 = y2 * rs * g2; const float sc = isq ? QSCALE : 1.f; y1 = (x1 * cs - x2 * sn) * sc; y2 = (x2 * cs + x1 * sn) * sc; }
                    else { y1 = y1 * asc; y2 = y2 * asc; }
                    u32x2 w1, w2; w1.x = cvt_pk_bf16(y1[0], y1[1]); w1.y = cvt_pk_bf16(y1[2], y1[3]); w2.x = cvt_pk_bf16(y2[0], y2[1]); w2.y = cvt_pk_bf16(y2[2], y2[3]);
                    st16_swap(rowp + bj * HALF, w1, w2); } }
    }
};
struct EpiSwiGLU {
    static constexpr bool PERM = true, AFTER_DRAIN = false;
    bf16_t* ACT; int npl; float isc;
    __device__ __forceinline__ void operator()(const f32x4 (&acc)[2][2][4][2], const Unit& u, int wr, int wc, int fr, int fq) const {
        const int row0 = u.pm * BM + wr * 64 + fr, col0 = (u.pn % npl) * HALF + wc * 32 + 8 * fq;
#pragma unroll
        for (int ai = 0; ai < 2; ++ai)
#pragma unroll
            for (int m = 0; m < 4; ++m) { bf16_t* rowp = ACT + (size_t)(row0 + ai * HALF + m * 16) * FF + col0;
                const f32x4 g0 = acc[ai][0][m][0] * isc, g1 = acc[ai][0][m][1] * isc, u0 = acc[ai][1][m][0] * isc, u1 = acc[ai][1][m][1] * isc;
                u32x4 w; w.x = cvt_pk_bf16(fast_silu(g0[0]) * u0[0], fast_silu(g0[1]) * u0[1]); w.y = cvt_pk_bf16(fast_silu(g0[2]) * u0[2], fast_silu(g0[3]) * u0[3]);
                w.z = cvt_pk_bf16(fast_silu(g1[0]) * u1[0], fast_silu(g1[1]) * u1[1]); w.w = cvt_pk_bf16(fast_silu(g1[2]) * u1[2], fast_silu(g1[3]) * u1[3]);
                *(u32x4*)rowp = w; }
    }
};
struct EpiSwiGLU8 {
    static constexpr bool PERM = true, AFTER_DRAIN = false;
    unsigned char* ACT; int npl; float isc;
    template <int AI> __device__ __forceinline__ void half(const f32x4 (&acc)[2][2][4][2], const Unit& u, int wr, int wc, int fr, int fq) const {
        typedef unsigned u32x2 __attribute__((ext_vector_type(2)));
        const int row0 = u.pm * BM + wr * 64 + fr, col0 = (u.pn % npl) * HALF + wc * 32 + 8 * fq;
        const float ne = -isc * LOG2E, rs = 1.f / (isc * isc);
#pragma unroll
        for (int m = 0; m < 4; ++m) { unsigned char* rowp = ACT + (size_t)(row0 + AI * HALF + m * 16) * FF + col0;
            const f32x4 g0 = acc[AI][0][m][0], g1 = acc[AI][0][m][1], u0 = acc[AI][1][m][0], u1 = acc[AI][1][m][1];
#define SG_(g, u) ((g) * (u) * __builtin_amdgcn_rcpf(__builtin_fmaf(__builtin_amdgcn_exp2f((g) * ne), rs, rs)))
            u32x2 w; w.x = pk4_fp8(SG_(g0[0], u0[0]), SG_(g0[1], u0[1]), SG_(g0[2], u0[2]), SG_(g0[3], u0[3]));
            w.y = pk4_fp8(SG_(g1[0], u1[0]), SG_(g1[1], u1[1]), SG_(g1[2], u1[2]), SG_(g1[3], u1[3]));
#undef SG_
            *(u32x2*)rowp = w; }
    }
    __device__ __forceinline__ void operator()(const f32x4 (&acc)[2][2][4][2], const Unit& u, int wr, int wc, int fr, int fq) const { half<0>(acc, u, wr, wc, fr, fq); half<1>(acc, u, wr, wc, fr, fq); }
};
struct EpiResid {
    static constexpr bool PERM = false, AFTER_DRAIN = false;
    float* out; float* xc; const float* gate; float asc; const float* lsrc;
    __device__ __forceinline__ void operator()(const f32x4 (&acc)[2][2][4][2], const Unit& u, int wr, int wc, int fr, int fq) const {
        const int b = u.pm / 9, j = u.pm - b * 9;
        float* base = (j < 8) ? out + (size_t)(b * SEQ + j * BM) * D : xc + (size_t)(b * CTXL) * D;
        const float* sbase = (j < 8) ? lsrc + (size_t)(b * SEQ + j * BM) * D : base;
        const float* gp = gate + (size_t)((j < 8) ? b : NB) * 6144;
        const int col0 = u.pn * BM + wc * 32 + 4 * fq;
        f32x4 gv[2][2];
#pragma unroll
        for (int bj = 0; bj < 2; ++bj)
#pragma unroll
            for (int n = 0; n < 2; ++n) gv[bj][n] = *(const f32x4*)(gp + col0 + bj * HALF + n * 16) * asc;
        const size_t rb = (size_t)(wr * 64 + fr) * D + col0;
        f32x4 x0[4][2][2], x1[4][2][2];
#pragma unroll
        for (int m = 0; m < 4; ++m)
#pragma unroll
            for (int bj = 0; bj < 2; ++bj)
#pragma unroll
                for (int n = 0; n < 2; ++n) x0[m][bj][n] = *(const f32x4*)(sbase + rb + (size_t)(m * 16) * D + bj * HALF + n * 16);
#pragma unroll
        for (int m = 0; m < 4; ++m)
#pragma unroll
            for (int bj = 0; bj < 2; ++bj)
#pragma unroll
                for (int n = 0; n < 2; ++n) x0[m][bj][n] += gv[bj][n] * acc[0][bj][m][n];
#pragma unroll
        for (int m = 0; m < 4; ++m)
#pragma unroll
            for (int bj = 0; bj < 2; ++bj)
#pragma unroll
                for (int n = 0; n < 2; ++n) x1[m][bj][n] = *(const f32x4*)(sbase + rb + (size_t)(HALF + m * 16) * D + bj * HALF + n * 16);
#pragma unroll
        for (int m = 0; m < 4; ++m)
#pragma unroll
            for (int bj = 0; bj < 2; ++bj)
#pragma unroll
                for (int n = 0; n < 2; ++n) *(f32x4*)(base + rb + (size_t)(m * 16) * D + bj * HALF + n * 16) = x0[m][bj][n];
#pragma unroll
        for (int m = 0; m < 4; ++m)
#pragma unroll
            for (int bj = 0; bj < 2; ++bj)
#pragma unroll
                for (int n = 0; n < 2; ++n) *(f32x4*)(base + rb + (size_t)(HALF + m * 16) * D + bj * HALF + n * 16) = x1[m][bj][n] + gv[bj][n] * acc[1][bj][m][n];
    }
};
struct EpiMoeY {
    static constexpr bool PERM = true, AFTER_DRAIN = false;
    bf16_t* Y; float asc;
    __device__ __forceinline__ void operator()(const f32x4 (&acc)[2][2][4][2], const Unit& u, int wr, int wc, int fr, int fq) const {
        const int row0 = u.pm * BM + wr * 64 + fr, col0 = (u.pn & 3) * BM + wc * 32 + 8 * fq;
#pragma unroll
        for (int ai = 0; ai < 2; ++ai)
#pragma unroll
            for (int m = 0; m < 4; ++m) { bf16_t* rowp = Y + (size_t)(row0 + ai * HALF + m * 16) * D + col0;
#pragma unroll
                for (int bj = 0; bj < 2; ++bj) { const f32x4 v0 = acc[ai][bj][m][0] * asc, v1 = acc[ai][bj][m][1] * asc;
                    u32x4 w; w.x = cvt_pk_bf16(v0[0], v0[1]); w.y = cvt_pk_bf16(v0[2], v0[3]); w.z = cvt_pk_bf16(v1[0], v1[1]); w.w = cvt_pk_bf16(v1[2], v1[3]);
                    *(u32x4*)(rowp + bj * HALF) = w; } }
    }
};
struct EpiResidMoe {
    static constexpr bool PERM = false, AFTER_DRAIN = false;
    float* out; float* xc; const float* gate; const int* slot_tok; const float* slot_w; float asc;
    __device__ __forceinline__ void operator()(const f32x4 (&acc)[2][2][4][2], const Unit& u, int wr, int wc, int fr, int fq) const {
        const int col0 = (u.pn & 3) * BM + wc * 32 + 4 * fq;
#pragma unroll
        for (int ai = 0; ai < 2; ++ai)
#pragma unroll
            for (int m = 0; m < 4; ++m) { const int slot = u.pm * BM + ai * HALF + wr * 64 + m * 16 + fr; const int tok = slot_tok[slot];
                if (tok >= 0) { const float w = slot_w[slot] * asc; const int b = tok / RB, t = tok - b * RB;
                    float* rowp = ((t < SEQ) ? out + (size_t)(b * SEQ + t) * D : xc + (size_t)(b * CTXL + t - SEQ) * D) + col0;
                    const float* gp = gate + (size_t)((t < SEQ) ? b : NB) * 6144 + col0;
#pragma unroll
                    for (int bj = 0; bj < 2; ++bj)
#pragma unroll
                        for (int n = 0; n < 2; ++n) { float* p = rowp + bj * HALF + n * 16; const f32x4 g = *(const f32x4*)(gp + bj * HALF + n * 16); const f32x4 v = (g * w) * acc[ai][bj][m][n];
                            *(f32x4*)p = *(f32x4*)p + v; } } }
    }
};
struct MapOrder {
    StaticOrder so; int mode; int tlo; int npl; const PG8_LAS int* tab;
    __device__ __forceinline__ void init(int nM, int nN, int G, int c, int mode_, int   = 0, int   = 1, int tlo_ = 0, int npl_ = 0, const PG8_LAS int* tab_ = nullptr) { so.init(nM * BM, nN * BM, G, c); mode = mode_; tlo = tlo_; npl = npl_; tab = tab_; }
    __device__ __forceinline__ bool next(int i, Unit& u) const {
        if (!so.next(i, u)) return false;
        if (mode == 1) u.pm = (u.pm >> 3) * 9 + (u.pm & 7);
        else if (mode == 2) { u.pm += tlo; const int e = __builtin_amdgcn_readfirstlane(tab[u.pm]); u.pn += e * npl; }
        return true;
    }
    __device__ __forceinline__ void a_ready(const Unit&) const {}
    __device__ __forceinline__ void done(const Unit&) const {}
};
}
namespace attn_body {
using bf16=__hip_bfloat16;
using bf16x8=__attribute__((ext_vector_type(8)))short;
using s16x4=__attribute__((ext_vector_type(4)))short;
using f32x16=__attribute__((ext_vector_type(16)))float;
using u32x4=__attribute__((ext_vector_type(4)))unsigned;
constexpr int D=64;
constexpr int NW=8,QBLK=32,QB=QBLK*NW,KVBLK=64;
constexpr int ATTN_UNIT_ROWS=QB;
__device__ __forceinline__ int crow(int r,int hi){return (r&3)+8*(r>>2)+4*hi;}
#define SBAR() __builtin_amdgcn_sched_barrier(0)
constexpr int NSLOT=3, SLOTB=8192;
constexpr int LDS_K=0, LDS_V=NSLOT*SLOTB, LDS_WS=2*NSLOT*SLOTB, LDS_OST=LDS_WS+NW*64*4, LDS_BYTES=LDS_OST+NW*4096;
constexpr float C2=0.125f*1.4426950408889634f;
__device__ __forceinline__ void glds16(const void*gsrc,unsigned lds_dst){unsigned keep;
  asm volatile("s_mov_b32 %0, m0\n\ts_mov_b32 m0, %2\n\ts_nop 0\n\tglobal_load_lds_dwordx4 %1, off\n\ts_mov_b32 m0, %0":"=&s"(keep):"v"(gsrc),"s"(lds_dst):"memory");}
__device__ __forceinline__ float max3f(float a,float b,float c){float r;asm("v_max3_f32 %0, %1, %2, %3":"=v"(r):"v"(a),"v"(b),"v"(c));return r;}
__device__ __forceinline__ float max2f(float a,float b){float r;asm("v_max_f32_e32 %0, %1, %2":"=v"(r):"v"(a),"v"(b));return r;}
__device__ __forceinline__ float fadd_s(float a,float b){float r;asm("v_add_f32_e32 %0, %1, %2":"=v"(r):"v"(a),"v"(b));return r;}
__device__ __forceinline__ float fsub_s(float a,float b){float r;asm("v_sub_f32_e32 %0, %1, %2":"=v"(r):"v"(a),"v"(b));return r;}
typedef float f32x2_t __attribute__((ext_vector_type(2))); typedef __bf16 bf16x2_t __attribute__((ext_vector_type(2)));
__device__ __forceinline__ unsigned cvtpk_s(float lo,float hi){f32x2_t v={lo,hi};bf16x2_t b=__builtin_convertvector(v,bf16x2_t);return __builtin_bit_cast(unsigned,b);}
#define WAIT_BAR(N) asm volatile("s_waitcnt vmcnt(" #N ") lgkmcnt(0)\n\ts_barrier":::"memory")

__device__ __forceinline__ void qkt(f32x16&p0,f32x16&p1,const char*Kslot,const bf16x8*qr,const f32x16&negm,int r32,int hi){
  const char*kb=Kslot+hi*1024+r32*16;
  #pragma unroll
  for(int d0=0;d0<4;++d0){
    const bf16x8 b0=*reinterpret_cast<const bf16x8*>(kb+d0*2048);
    const bf16x8 b1=*reinterpret_cast<const bf16x8*>(kb+d0*2048+512);
    if(d0==0){p0=__builtin_amdgcn_mfma_f32_32x32x16_bf16(b0,qr[0],negm,0,0,0);p1=__builtin_amdgcn_mfma_f32_32x32x16_bf16(b1,qr[0],negm,0,0,0);}
    else{p0=__builtin_amdgcn_mfma_f32_32x32x16_bf16(b0,qr[d0],p0,0,0,0);p1=__builtin_amdgcn_mfma_f32_32x32x16_bf16(b1,qr[d0],p1,0,0,0);}}
}
typedef __attribute__((address_space(3))) const char* lds_cptr;
typedef short v4i16_t __attribute__((ext_vector_type(4)));
__device__ __forceinline__ void kload8(bf16x8*kf,lds_cptr kp){
  kf[0]=*(const __attribute__((address_space(3))) bf16x8*)(kp);      kf[1]=*(const __attribute__((address_space(3))) bf16x8*)(kp+512);
  kf[2]=*(const __attribute__((address_space(3))) bf16x8*)(kp+2048); kf[3]=*(const __attribute__((address_space(3))) bf16x8*)(kp+2560);
  kf[4]=*(const __attribute__((address_space(3))) bf16x8*)(kp+4096); kf[5]=*(const __attribute__((address_space(3))) bf16x8*)(kp+4608);
  kf[6]=*(const __attribute__((address_space(3))) bf16x8*)(kp+6144); kf[7]=*(const __attribute__((address_space(3))) bf16x8*)(kp+6656);
}
__device__ __forceinline__ void kload2(bf16x8*kf,lds_cptr kp,int j){ kf[2*j]=*(const __attribute__((address_space(3))) bf16x8*)(kp+j*2048); kf[2*j+1]=*(const __attribute__((address_space(3))) bf16x8*)(kp+j*2048+512); }
__device__ __forceinline__ s16x4 vtr(lds_cptr p){ return __builtin_bit_cast(s16x4,__builtin_amdgcn_ds_read_tr16_b64_v4i16((__attribute__((address_space(3))) v4i16_t*)p)); }
__device__ __forceinline__ float rowmax(const f32x16&p0,const f32x16&p1){
  float a=max3f(p0[0],p0[1],p1[0]),b=max3f(p0[2],p0[3],p1[1]);a=max3f(a,p1[2],p1[3]);
  #pragma unroll
  for(int r=4;r<16;r+=4){a=max3f(a,p0[r],p0[r+1]);b=max3f(b,p0[r+2],p0[r+3]);a=max3f(a,p1[r],p1[r+1]);b=max3f(b,p1[r+2],p1[r+3]);}
  const float m=max2f(a,b);
  auto rr=__builtin_amdgcn_permlane32_swap(__float_as_uint(m),__float_as_uint(m),false,false);
  return max2f(__uint_as_float(rr[0]),__uint_as_float(rr[1]));
}
__device__ __forceinline__ void pv(f32x16*o,int vb,bf16x8 pa0,bf16x8 pa1,bf16x8 pa2,bf16x8 pa3){
  #pragma unroll
  for(int d0=0;d0<2;++d0){s16x4 lo[4],hi[4];
    #pragma unroll
    for(int ks=0;ks<4;++ks){
      asm volatile("ds_read_b64_tr_b16 %0,%1 offset:%c2":"=&v"(lo[ks]):"v"(vb),"i"(d0*4096+ks*1024):"memory");
      asm volatile("ds_read_b64_tr_b16 %0,%1 offset:%c2":"=&v"(hi[ks]):"v"(vb),"i"(d0*4096+ks*1024+512):"memory");}
    asm volatile("s_waitcnt lgkmcnt(0)":::"memory");SBAR();
    #define PK(k) (bf16x8){lo[k][0],lo[k][1],lo[k][2],lo[k][3],hi[k][0],hi[k][1],hi[k][2],hi[k][3]}
    o[d0]=__builtin_amdgcn_mfma_f32_32x32x16_bf16(pa0,PK(0),o[d0],0,0,0);
    o[d0]=__builtin_amdgcn_mfma_f32_32x32x16_bf16(pa1,PK(1),o[d0],0,0,0);
    o[d0]=__builtin_amdgcn_mfma_f32_32x32x16_bf16(pa2,PK(2),o[d0],0,0,0);
    o[d0]=__builtin_amdgcn_mfma_f32_32x32x16_bf16(pa3,PK(3),o[d0],0,0,0);
    #undef PK
  }
}

#ifndef ATTN_STORE16
#define ATTN_STORE16(p,v) (*(u32x4*)(p)=(v))
#endif
template<int THRL,int qp,int kp_,int vp_e,int op> __device__ __forceinline__ void attn_unit(const bf16*Qw0,const bf16*Kh,const bf16*Vh,bf16*Ow0,int NT,char*shm,const int tid){
  const int lane=tid&63,r32=lane&31,hi=lane>>5; const int wid=__builtin_amdgcn_readfirstlane(tid>>6);
  const bf16*Qw=Qw0+(long)(wid*QBLK)*qp;
  const unsigned lds0=(unsigned)(uintptr_t)shm;
  float*wsf=(float*)(shm+LDS_WS)+wid*64;
  const bf16*ksrc=Kh+(long)lane*kp_+wid*8;
  const bf16*vsrc=Vh+(long)(16*(wid&3)+(lane>>2))*vp_e+(wid>>2)*32+(lane&3)*8;
  const unsigned kdst=lds0+LDS_K+wid*1024, vdst=lds0+LDS_V+wid*1024;
  #define DMA_K(t,slot) glds16(ksrc+(long)(t)*KVBLK*kp_,(unsigned)__builtin_amdgcn_readfirstlane(kdst+(slot)))
  #define DMA_V(t,slot) glds16(vsrc+(long)(t)*KVBLK*vp_e,(unsigned)__builtin_amdgcn_readfirstlane(vdst+(slot)))
  const int vb0=(int)(lds0+LDS_V)+((lane>>4)&1)*32+(lane&3)*8+(4*hi+((lane&15)>>2))*64;
  const char*Kbase=shm+LDS_K; bf16x8 kf[8];
  const lds_cptr shm3=(lds_cptr)shm; const lds_cptr kp0=shm3+LDS_K+hi*1024+r32*16; const lds_cptr vp0=shm3+LDS_V+((lane>>4)&1)*32+(lane&3)*8+(4*hi+((lane&15)>>2))*64;
  DMA_K(0,0);DMA_V(0,0);DMA_K(1,SLOTB);
  bf16x8 qr[4];
  #pragma unroll
  for(int d0=0;d0<4;++d0)qr[d0]=*reinterpret_cast<const bf16x8*>(&Qw[(long)r32*qp+d0*16+hi*8]);
  float mhat=0.f,l_reg=0.f;f32x16 o[2];o[0]=f32x16{};o[1]=f32x16{};f32x16 negm=f32x16{};asm volatile("":"+v"(negm));
  #define CMASK(P0,P1,t) do{}while(0)
  bool resc=false;
  #define START(P0,P1) do{ const float rm=rowmax(P0,P1); resc=false; \
    { const float dl=rm; mhat=fadd_s(mhat,dl); \
      _Pragma("unroll") for(int r=0;r<16;++r){P0[r]=fsub_s(P0[r],dl);P1[r]=fsub_s(P1[r],dl);} \
      _Pragma("unroll") for(int r=0;r<16;++r)negm[r]=-mhat; asm volatile("":"+v"(negm)); } \
    _Pragma("unroll") for(int r=0;r<16;++r)P0[r]=__builtin_amdgcn_exp2f(P0[r]); }while(0)
  #define RESC() do{ if(resc){ asm volatile("s_waitcnt lgkmcnt(0)":::"memory"); \
      _Pragma("unroll") for(int d_=0;d_<2;++d_) _Pragma("unroll") for(int r=0;r<16;++r)o[d_][r]*=wsf[crow(r,hi)]; } }while(0)
  f32x16 pA0,pA1,pB0,pB1;
  int sl_prev=0,sl_cur=0,sl_next=SLOTB;
  #define ROT() do{sl_prev=sl_cur;sl_cur=sl_next;sl_next=(sl_next==(NSLOT-1)*SLOTB)?0:sl_next+SLOTB;}while(0)
  DMA_K(2,2*SLOTB);
  WAIT_BAR(3);
  qkt(pA0,pA1,Kbase,qr,negm,r32,hi);asm volatile("s_nop 15\n\ts_nop 7":"+v"(pA0),"+v"(pA1));CMASK(pA0,pA1,0);
  START(pA0,pA1);
  _Pragma("unroll") for(int r=0;r<16;++r)pA1[r]=__builtin_amdgcn_exp2f(pA1[r]);
  WAIT_BAR(0);
  DMA_K(3,0);DMA_V(1,SLOTB);
  ROT();
  kload8(kf,kp0+sl_cur);
  WAIT_BAR(2);
  s16x4 vlo[8],vhi[8]; u32x4 pw0,pw1,pw2,pw3;
  #define PKW(P,B) cvtpk_s(P[B],P[B+1])
  #define PAF(k) __builtin_bit_cast(bf16x8,pw##k)
  #define VFR(i) (bf16x8){vlo[i][0],vlo[i][1],vlo[i][2],vlo[i][3],vhi[i][0],vhi[i][1],vhi[i][2],vhi[i][3]}
  #define PIN(x) asm volatile("":"+v"(x))
  #define MX3(a,b,c) __builtin_fmaxf(__builtin_fmaxf((a),(b)),(c))
  #define GAPA(MF,A0,A1,A2,A3,W0,W1,PW) do{ MF; sacc+=A0; sacc+=A1; sacc+=A2; sacc+=A3; PIN(sacc); W0; W1; PIN(PW); SBAR(); }while(0)
  #define EX(v) __builtin_amdgcn_exp2f(v)
  #define GAPB(MF,X,B) do{ MF; X[B]=EX(X[B]); X[B+1]=EX(X[B+1]); X[B+2]=EX(X[B+2]); X[B+3]=EX(X[B+3]); PIN(X); SBAR(); }while(0)
  #define VRD(i) do{ vlo[i]=vtr(vp_+(((i)>>2)*4096+((i)&3)*1024)); vhi[i]=vtr(vp_+(((i)>>2)*4096+((i)&3)*1024+512)); }while(0)
  #define KRD(G,j) do{ if(G){ kload2(kf,kp0+sl_next,j); SBAR(); } }while(0)
  #define STEP(C0,C1,P0,P1,t,GK,GV,GL) do{ SBAR(); \
    const lds_cptr vp_=vp0+sl_prev; \
    VRD(0); SBAR(); float sacc=(P0[0]+P0[1]); \
    GAPA(C0=__builtin_amdgcn_mfma_f32_32x32x16_bf16(kf[0],qr[0],negm,0,0,0), P0[2],P0[3],P0[4],P0[5],     pw0[0]=PKW(P0,0), pw0[1]=PKW(P0,2), pw0); \
    VRD(4); SBAR(); GAPA(C1=__builtin_amdgcn_mfma_f32_32x32x16_bf16(kf[1],qr[0],negm,0,0,0), P0[6],P0[7],P0[8],P0[9],     pw0[2]=PKW(P0,4), pw0[3]=PKW(P0,6), pw0); \
    VRD(1); SBAR(); GAPA(C0=__builtin_amdgcn_mfma_f32_32x32x16_bf16(kf[2],qr[1],C0,0,0,0),   P0[10],P0[11],P0[12],P0[13], pw1[0]=PKW(P0,8), pw1[1]=PKW(P0,10), pw1); \
    VRD(5); SBAR(); GAPA(C1=__builtin_amdgcn_mfma_f32_32x32x16_bf16(kf[3],qr[1],C1,0,0,0),   P0[14],P0[15],P1[0],P1[1],   pw1[2]=PKW(P0,12),pw1[3]=PKW(P0,14), pw1); \
    VRD(2); SBAR(); GAPA(C0=__builtin_amdgcn_mfma_f32_32x32x16_bf16(kf[4],qr[2],C0,0,0,0),   P1[2],P1[3],P1[4],P1[5],     pw2[0]=PKW(P1,0), pw2[1]=PKW(P1,2), pw2); \
    VRD(6); SBAR(); GAPA(C1=__builtin_amdgcn_mfma_f32_32x32x16_bf16(kf[5],qr[2],C1,0,0,0),   P1[6],P1[7],P1[8],P1[9],     pw2[2]=PKW(P1,4), pw2[3]=PKW(P1,6), pw2); \
    VRD(3); SBAR(); GAPA(C0=__builtin_amdgcn_mfma_f32_32x32x16_bf16(kf[6],qr[3],C0,0,0,0),   P1[10],P1[11],P1[12],P1[13], pw3[0]=PKW(P1,8), pw3[1]=PKW(P1,10), pw3); \
    VRD(7); SBAR(); GAPA(C1=__builtin_amdgcn_mfma_f32_32x32x16_bf16(kf[7],qr[3],C1,0,0,0),   P1[14],P1[15],0.f,0.f,       pw3[2]=PKW(P1,12),pw3[3]=PKW(P1,14), pw3); \
    l_reg+=sacc; \
    if(GK){DMA_K((t)+3,sl_cur);} if(GV){DMA_V((t)+1,sl_next);} \
    CMASK(C0,C1,t); \
    { float a=MX3(C0[0],C0[1],C1[0]),b=MX3(C0[2],C0[3],C1[1]); a=MX3(a,C1[2],C1[3]); \
      _Pragma("unroll") for(int r=4;r<16;r+=4){a=MX3(a,C0[r],C0[r+1]);b=MX3(b,C0[r+2],C0[r+3]);a=MX3(a,C1[r],C1[r+1]);b=MX3(b,C1[r+2],C1[r+3]);} \
      float rm=__builtin_fmaxf(a,b); { auto rr=__builtin_amdgcn_permlane32_swap(__float_as_uint(rm),__float_as_uint(rm),false,false); rm=__builtin_fmaxf(__uint_as_float(rr[0]),__uint_as_float(rr[1])); } \
      resc=false; \
      if(__builtin_expect(__any(rm>(float)THRL),0)){ const float dl=__builtin_fmaxf(rm,0.f); mhat+=dl; \
        _Pragma("unroll") for(int r=0;r<16;++r){C0[r]-=dl;C1[r]-=dl;} \
        _Pragma("unroll") for(int r=0;r<16;++r)negm[r]=-mhat; asm volatile("":"+v"(negm)); \
        const float f=__builtin_amdgcn_exp2f(-dl); l_reg*=f; if(hi==0)wsf[r32]=f; resc=true; } } \
    SBAR(); \
    GAPB(o[0]=__builtin_amdgcn_mfma_f32_32x32x16_bf16(PAF(0),VFR(0),o[0],0,0,0), C0,0); \
    GAPB(o[1]=__builtin_amdgcn_mfma_f32_32x32x16_bf16(PAF(0),VFR(4),o[1],0,0,0), C0,4); \
    KRD(GL,0); GAPB(o[0]=__builtin_amdgcn_mfma_f32_32x32x16_bf16(PAF(1),VFR(1),o[0],0,0,0), C0,8); \
    KRD(GL,1); GAPB(o[1]=__builtin_amdgcn_mfma_f32_32x32x16_bf16(PAF(1),VFR(5),o[1],0,0,0), C0,12); \
    KRD(GL,2); GAPB(o[0]=__builtin_amdgcn_mfma_f32_32x32x16_bf16(PAF(2),VFR(2),o[0],0,0,0), C1,0); \
    KRD(GL,3); GAPB(o[1]=__builtin_amdgcn_mfma_f32_32x32x16_bf16(PAF(2),VFR(6),o[1],0,0,0), C1,4); \
    GAPB(o[0]=__builtin_amdgcn_mfma_f32_32x32x16_bf16(PAF(3),VFR(3),o[0],0,0,0), C1,8); \
    GAPB(o[1]=__builtin_amdgcn_mfma_f32_32x32x16_bf16(PAF(3),VFR(7),o[1],0,0,0), C1,12); \
    }while(0)
  int t=1;
  for(;t+5<NT;t+=2){
    STEP(pB0,pB1,pA0,pA1,t,true,true,true);     WAIT_BAR(2); RESC(); ROT();
    STEP(pA0,pA1,pB0,pB1,t+1,true,true,true);   WAIT_BAR(2); RESC(); ROT();
  }
  #define ENDW(tt) do{ if((tt)+3<NT){WAIT_BAR(2);} else if((tt)+2<NT){WAIT_BAR(1);} else {WAIT_BAR(0);} }while(0)
  for(;t+1<NT;t+=2){
    STEP(pB0,pB1,pA0,pA1,t,(t+3<NT),(t+1<NT),(t+1<NT));       ENDW(t);   RESC(); ROT();
    STEP(pA0,pA1,pB0,pB1,t+1,(t+4<NT),(t+2<NT),(t+2<NT));     ENDW(t+1); RESC(); ROT();
  }
  STEP(pB0,pB1,pA0,pA1,NT-1,false,false,false); RESC();
  { float sacc=pB0[0]+pB0[1]; _Pragma("unroll") for(int r=2;r<16;++r)sacc+=pB0[r]; _Pragma("unroll") for(int r=0;r<16;++r)sacc+=pB1[r]; l_reg+=sacc;
    pw0=(u32x4){PKW(pB0,0),PKW(pB0,2),PKW(pB0,4),PKW(pB0,6)};pw1=(u32x4){PKW(pB0,8),PKW(pB0,10),PKW(pB0,12),PKW(pB0,14)};pw2=(u32x4){PKW(pB1,0),PKW(pB1,2),PKW(pB1,4),PKW(pB1,6)};pw3=(u32x4){PKW(pB1,8),PKW(pB1,10),PKW(pB1,12),PKW(pB1,14)};
    SBAR(); pv(o,vb0+sl_cur,PAF(0),PAF(1),PAF(2),PAF(3)); }
  #undef PKW
  #undef PAF
  #undef VFR
  #undef PIN
  #undef MX3
  #undef GAPA
  #undef GAPB
  #undef EX
  #undef VRD
  #undef KRD
  #undef STEP
  #undef ENDW
  {auto rr=__builtin_amdgcn_permlane32_swap(__float_as_uint(l_reg),__float_as_uint(l_reg),false,false);l_reg=__uint_as_float(rr[0])+__uint_as_float(rr[1]);}
  if(hi==0)wsf[32+r32]=l_reg;asm volatile("s_waitcnt lgkmcnt(0)":::"memory");
  float rli[16];
  #pragma unroll
  for(int r=0;r<16;++r)rli[r]=__builtin_amdgcn_rcpf(wsf[32+crow(r,hi)]);
  bf16*Ow=Ow0+(long)(wid*QBLK)*op;
  { bf16*stg=(bf16*)(shm+LDS_OST)+wid*2048;
    #pragma unroll
    for(int r=0;r<16;++r){const int orow=crow(r,hi);
      #pragma unroll
      for(int d0=0;d0<2;++d0)stg[orow*64+d0*32+r32]=__float2bfloat16(o[d0][r]*rli[r]);}
    asm volatile("s_waitcnt lgkmcnt(0)":::"memory");
    #pragma unroll
    for(int i=0;i<4;++i){const int row=i*8+(lane>>3),ch=lane&7; const u32x4 v=*(const u32x4*)(stg+row*64+ch*8); ATTN_STORE16(Ow+(long)row*op+ch*8,v);} }
  asm volatile("s_waitcnt lgkmcnt(0)\n\ts_barrier":::"memory");
  #undef DMA_K
  #undef DMA_V
  #undef CMASK
  #undef START
  #undef RESC
  #undef ROT
}
constexpr int V128_WS=NSLOT*SLOTB+NSLOT*2*SLOTB, V128_OST=V128_WS+NW*64*4, V128_LDS_BYTES=V128_OST+NW*4096;
template<int THRL,int qp,int kp_,int vp_e,int op> __device__ __forceinline__ void attn_unit_v128(const bf16*Qw0,const bf16*Kh,const bf16*Vh,bf16*Ow0,int NT,char*shm,const int tid){
  const int lane=tid&63,r32=lane&31,hi=lane>>5; const int wid=__builtin_amdgcn_readfirstlane(tid>>6);
  const bf16*Qw=Qw0+(long)(wid*QBLK)*qp;
  const unsigned lds0=(unsigned)(uintptr_t)shm;
  float*wsf=(float*)(shm+V128_WS)+wid*64;
  const bf16*ksrc=Kh+(long)lane*kp_+wid*8;
  const bf16*vsrc=Vh+(long)(16*(wid&3)+(lane>>2))*vp_e+(wid>>2)*32+(lane&3)*8;
  const unsigned kdst=lds0+LDS_K+wid*1024, vdst=lds0+LDS_V+wid*1024;
  #define DMA_K(t,slot) glds16(ksrc+(long)(t)*KVBLK*kp_,(unsigned)__builtin_amdgcn_readfirstlane(kdst+(slot)))
  #define DMA_V(t,slot) do{ glds16(vsrc+(long)(t)*KVBLK*vp_e,(unsigned)__builtin_amdgcn_readfirstlane(vdst+2*(slot))); glds16(vsrc+(long)(t)*KVBLK*vp_e+64,(unsigned)__builtin_amdgcn_readfirstlane(vdst+2*(slot)+8192)); }while(0)
  const int vb0=(int)(lds0+LDS_V)+((lane>>4)&1)*32+(lane&3)*8+(4*hi+((lane&15)>>2))*64;
  const char*Kbase=shm+LDS_K; bf16x8 kf[8];
  const lds_cptr shm3=(lds_cptr)shm; const lds_cptr kp0=shm3+LDS_K+hi*1024+r32*16; const lds_cptr vp0=shm3+LDS_V+((lane>>4)&1)*32+(lane&3)*8+(4*hi+((lane&15)>>2))*64;
  DMA_K(0,0);DMA_V(0,0);DMA_K(1,SLOTB);
  bf16x8 qr[4];
  #pragma unroll
  for(int d0=0;d0<4;++d0)qr[d0]=*reinterpret_cast<const bf16x8*>(&Qw[(long)r32*qp+d0*16+hi*8]);
  typedef __attribute__((address_space(3))) bf16x8 lds_bf16x8; const lds_cptr qst=shm3+V128_OST+wid*4096+lane*16;
  #define QF(d0) (*(const lds_bf16x8*)(qst+(d0)*1024))
  float mhat=0.f,l_reg=0.f;f32x16 o[4];o[0]=f32x16{};o[1]=f32x16{};o[2]=f32x16{};o[3]=f32x16{};const f32x16 zero16=f32x16{};
  #define CMASK(P0,P1,t) do{}while(0)
  bool resc=false;
  #define START(P0,P1) do{ const float rm=rowmax(P0,P1); resc=false; \
    { const float dl=rm; mhat=fadd_s(mhat,dl); \
      _Pragma("unroll") for(int r=0;r<16;++r){P0[r]=fsub_s(P0[r],dl);P1[r]=fsub_s(P1[r],dl);} \
      } \
    _Pragma("unroll") for(int r=0;r<16;++r)P0[r]=__builtin_amdgcn_exp2f(P0[r]); }while(0)
  #define RESC() do{ if(resc){ asm volatile("s_waitcnt lgkmcnt(0)":::"memory"); \
      _Pragma("unroll") for(int d_=0;d_<4;++d_) _Pragma("unroll") for(int r=0;r<16;++r)o[d_][r]*=wsf[crow(r,hi)]; } }while(0)
  f32x16 pA0,pA1,pB0,pB1;
  int sl_prev=0,sl_cur=0,sl_next=SLOTB;
  #define ROT() do{sl_prev=sl_cur;sl_cur=sl_next;sl_next=(sl_next==(NSLOT-1)*SLOTB)?0:sl_next+SLOTB;}while(0)
  DMA_K(2,2*SLOTB);
  WAIT_BAR(4);
  qkt(pA0,pA1,Kbase,qr,zero16,r32,hi);asm volatile("s_nop 15\n\ts_nop 7":"+v"(pA0),"+v"(pA1));CMASK(pA0,pA1,0);
  _Pragma("unroll") for(int d0=0;d0<4;++d0)*(__attribute__((address_space(3))) bf16x8*)(qst+d0*1024)=qr[d0];
  START(pA0,pA1);
  _Pragma("unroll") for(int r=0;r<16;++r)pA1[r]=__builtin_amdgcn_exp2f(pA1[r]);
  WAIT_BAR(0);
  DMA_K(3,0);DMA_V(1,SLOTB);
  ROT();
  kload8(kf,kp0+sl_cur);
  WAIT_BAR(3);
  s16x4 vlo[8],vhi[8]; u32x4 pw0,pw1,pw2,pw3;
  #define PKW(P,B) cvtpk_s(P[B],P[B+1])
  #define PAF(k) __builtin_bit_cast(bf16x8,pw##k)
  #define VFR(i) (bf16x8){vlo[i][0],vlo[i][1],vlo[i][2],vlo[i][3],vhi[i][0],vhi[i][1],vhi[i][2],vhi[i][3]}
  #define PIN(x) asm volatile("":"+v"(x))
  #define MX3(a,b,c) __builtin_fmaxf(__builtin_fmaxf((a),(b)),(c))
  #define GAPA(MF,A0,A1,A2,A3,W0,W1,PW) do{ MF; sacc+=A0; sacc+=A1; sacc+=A2; sacc+=A3; PIN(sacc); W0; W1; PIN(PW); SBAR(); }while(0)
  #define EX(v) __builtin_amdgcn_exp2f(v)
  #define GAPB(MF,X,B) do{ MF; X[B]=EX(X[B]); X[B+1]=EX(X[B+1]); X[B+2]=EX(X[B+2]); X[B+3]=EX(X[B+3]); PIN(X); SBAR(); }while(0)
  #define GAPB2(MF,X,B) do{ MF; X[B]=EX(X[B]); X[B+1]=EX(X[B+1]); PIN(X); SBAR(); }while(0)
  #define VRD2(i) do{ vlo[i]=vtr(vp_+(8192+((i)>>2)*4096+((i)&3)*1024)); vhi[i]=vtr(vp_+(8192+((i)>>2)*4096+((i)&3)*1024+512)); }while(0)
  #define VRD(i) do{ vlo[i]=vtr(vp_+(((i)>>2)*4096+((i)&3)*1024)); vhi[i]=vtr(vp_+(((i)>>2)*4096+((i)&3)*1024+512)); }while(0)
  #define KRD(G,j) do{ if(G){ kload2(kf,kp0+sl_next,j); SBAR(); } }while(0)
  #define STEP(C0,C1,P0,P1,t,GK,GV,GL) do{ SBAR(); \
    const lds_cptr vp_=vp0+2*sl_prev; \
    bf16x8 qa_=QF(0); VRD(0); SBAR(); float sacc=(P0[0]+P0[1]); \
    GAPA(C0=__builtin_amdgcn_mfma_f32_32x32x16_bf16(kf[0],qa_,zero16,0,0,0), P0[2],P0[3],P0[4],P0[5],     pw0[0]=PKW(P0,0), pw0[1]=PKW(P0,2), pw0); \
    VRD(4); SBAR(); GAPA(C1=__builtin_amdgcn_mfma_f32_32x32x16_bf16(kf[1],qa_,zero16,0,0,0), P0[6],P0[7],P0[8],P0[9],     pw0[2]=PKW(P0,4), pw0[3]=PKW(P0,6), pw0); \
    qa_=QF(1); VRD(1); SBAR(); GAPA(C0=__builtin_amdgcn_mfma_f32_32x32x16_bf16(kf[2],qa_,C0,0,0,0),   P0[10],P0[11],P0[12],P0[13], pw1[0]=PKW(P0,8), pw1[1]=PKW(P0,10), pw1); \
    VRD(5); SBAR(); GAPA(C1=__builtin_amdgcn_mfma_f32_32x32x16_bf16(kf[3],qa_,C1,0,0,0),   P0[14],P0[15],P1[0],P1[1],   pw1[2]=PKW(P0,12),pw1[3]=PKW(P0,14), pw1); \
    qa_=QF(2); VRD(2); SBAR(); GAPA(C0=__builtin_amdgcn_mfma_f32_32x32x16_bf16(kf[4],qa_,C0,0,0,0),   P1[2],P1[3],P1[4],P1[5],     pw2[0]=PKW(P1,0), pw2[1]=PKW(P1,2), pw2); \
    VRD(6); SBAR(); GAPA(C1=__builtin_amdgcn_mfma_f32_32x32x16_bf16(kf[5],qa_,C1,0,0,0),   P1[6],P1[7],P1[8],P1[9],     pw2[2]=PKW(P1,4), pw2[3]=PKW(P1,6), pw2); \
    qa_=QF(3); VRD(3); SBAR(); GAPA(C0=__builtin_amdgcn_mfma_f32_32x32x16_bf16(kf[6],qa_,C0,0,0,0),   P1[10],P1[11],P1[12],P1[13], pw3[0]=PKW(P1,8), pw3[1]=PKW(P1,10), pw3); \
    VRD(7); SBAR(); GAPA(C1=__builtin_amdgcn_mfma_f32_32x32x16_bf16(kf[7],qa_,C1,0,0,0),   P1[14],P1[15],0.f,0.f,       pw3[2]=PKW(P1,12),pw3[3]=PKW(P1,14), pw3); \
    l_reg+=sacc; \
    if(GK){DMA_K((t)+3,sl_cur);} if(GV){DMA_V((t)+1,sl_next);} \
    asm volatile("s_nop 15\n\ts_nop 7":"+v"(C0),"+v"(C1));   \
    _Pragma("unroll") for(int r=0;r<16;++r){C0[r]=fsub_s(C0[r],mhat);C1[r]=fsub_s(C1[r],mhat);} \
    CMASK(C0,C1,t); \
    { float a=MX3(C0[0],C0[1],C1[0]),b=MX3(C0[2],C0[3],C1[1]); a=MX3(a,C1[2],C1[3]); \
      _Pragma("unroll") for(int r=4;r<16;r+=4){a=MX3(a,C0[r],C0[r+1]);b=MX3(b,C0[r+2],C0[r+3]);a=MX3(a,C1[r],C1[r+1]);b=MX3(b,C1[r+2],C1[r+3]);} \
      float rm=__builtin_fmaxf(a,b); { auto rr=__builtin_amdgcn_permlane32_swap(__float_as_uint(rm),__float_as_uint(rm),false,false); rm=__builtin_fmaxf(__uint_as_float(rr[0]),__uint_as_float(rr[1])); } \
      resc=false; \
      if(__builtin_expect(__any(rm>(float)THRL),0)){ const float dl=__builtin_fmaxf(rm,0.f); mhat+=dl; \
        _Pragma("unroll") for(int r=0;r<16;++r){C0[r]-=dl;C1[r]-=dl;} \
        const float f=__builtin_amdgcn_exp2f(-dl); l_reg*=f; if(hi==0)wsf[r32]=f; resc=true; } } \
    SBAR(); \
    GAPB2(o[0]=__builtin_amdgcn_mfma_f32_32x32x16_bf16(PAF(0),VFR(0),o[0],0,0,0), C0,0);  VRD2(0); SBAR(); \
    GAPB2(o[1]=__builtin_amdgcn_mfma_f32_32x32x16_bf16(PAF(0),VFR(4),o[1],0,0,0), C0,2);  VRD2(4); SBAR(); \
    KRD(GL,0); GAPB2(o[0]=__builtin_amdgcn_mfma_f32_32x32x16_bf16(PAF(1),VFR(1),o[0],0,0,0), C0,4);  VRD2(1); SBAR(); \
    KRD(GL,1); GAPB2(o[1]=__builtin_amdgcn_mfma_f32_32x32x16_bf16(PAF(1),VFR(5),o[1],0,0,0), C0,6);  VRD2(5); SBAR(); \
    KRD(GL,2); GAPB2(o[0]=__builtin_amdgcn_mfma_f32_32x32x16_bf16(PAF(2),VFR(2),o[0],0,0,0), C0,8);  VRD2(2); SBAR(); \
    KRD(GL,3); GAPB2(o[1]=__builtin_amdgcn_mfma_f32_32x32x16_bf16(PAF(2),VFR(6),o[1],0,0,0), C0,10); VRD2(6); SBAR(); \
    GAPB2(o[0]=__builtin_amdgcn_mfma_f32_32x32x16_bf16(PAF(3),VFR(3),o[0],0,0,0), C0,12); VRD2(3); SBAR(); \
    GAPB2(o[1]=__builtin_amdgcn_mfma_f32_32x32x16_bf16(PAF(3),VFR(7),o[1],0,0,0), C0,14); VRD2(7); SBAR(); \
    GAPB2(o[2]=__builtin_amdgcn_mfma_f32_32x32x16_bf16(PAF(0),VFR(0),o[2],0,0,0), C1,0); \
    GAPB2(o[3]=__builtin_amdgcn_mfma_f32_32x32x16_bf16(PAF(0),VFR(4),o[3],0,0,0), C1,2); \
    GAPB2(o[2]=__builtin_amdgcn_mfma_f32_32x32x16_bf16(PAF(1),VFR(1),o[2],0,0,0), C1,4); \
    GAPB2(o[3]=__builtin_amdgcn_mfma_f32_32x32x16_bf16(PAF(1),VFR(5),o[3],0,0,0), C1,6); \
    GAPB2(o[2]=__builtin_amdgcn_mfma_f32_32x32x16_bf16(PAF(2),VFR(2),o[2],0,0,0), C1,8); \
    GAPB2(o[3]=__builtin_amdgcn_mfma_f32_32x32x16_bf16(PAF(2),VFR(6),o[3],0,0,0), C1,10); \
    GAPB2(o[2]=__builtin_amdgcn_mfma_f32_32x32x16_bf16(PAF(3),VFR(3),o[2],0,0,0), C1,12); \
    GAPB2(o[3]=__builtin_amdgcn_mfma_f32_32x32x16_bf16(PAF(3),VFR(7),o[3],0,0,0), C1,14); \
    }while(0)
  int t=1;
  for(;t+5<NT;t+=2){
    STEP(pB0,pB1,pA0,pA1,t,true,true,true);     WAIT_BAR(3); RESC(); ROT();
    STEP(pA0,pA1,pB0,pB1,t+1,true,true,true);   WAIT_BAR(3); RESC(); ROT();
  }
  #define ENDW(tt) do{ if((tt)+3<NT){WAIT_BAR(3);} else if((tt)+2<NT){WAIT_BAR(2);} else {WAIT_BAR(0);} }while(0)
  for(;t+1<NT;t+=2){
    STEP(pB0,pB1,pA0,pA1,t,(t+3<NT),(t+1<NT),(t+1<NT));       ENDW(t);   RESC(); ROT();
    STEP(pA0,pA1,pB0,pB1,t+1,(t+4<NT),(t+2<NT),(t+2<NT));     ENDW(t+1); RESC(); ROT();
  }
  STEP(pB0,pB1,pA0,pA1,NT-1,false,false,false); RESC();
  { float sacc=pB0[0]+pB0[1]; _Pragma("unroll") for(int r=2;r<16;++r)sacc+=pB0[r]; _Pragma("unroll") for(int r=0;r<16;++r)sacc+=pB1[r]; l_reg+=sacc;
    pw0=(u32x4){PKW(pB0,0),PKW(pB0,2),PKW(pB0,4),PKW(pB0,6)};pw1=(u32x4){PKW(pB0,8),PKW(pB0,10),PKW(pB0,12),PKW(pB0,14)};pw2=(u32x4){PKW(pB1,0),PKW(pB1,2),PKW(pB1,4),PKW(pB1,6)};pw3=(u32x4){PKW(pB1,8),PKW(pB1,10),PKW(pB1,12),PKW(pB1,14)};
    SBAR(); pv(o,vb0+2*sl_cur,PAF(0),PAF(1),PAF(2),PAF(3)); pv(o+2,vb0+2*sl_cur+8192,PAF(0),PAF(1),PAF(2),PAF(3)); }
  #undef PKW
  #undef PAF
  #undef VFR
  #undef PIN
  #undef MX3
  #undef GAPA
  #undef GAPB
  #undef EX
  #undef VRD
  #undef VRD2
  #undef GAPB2
  #undef KRD
  #undef STEP
  #undef ENDW
  {auto rr=__builtin_amdgcn_permlane32_swap(__float_as_uint(l_reg),__float_as_uint(l_reg),false,false);l_reg=__uint_as_float(rr[0])+__uint_as_float(rr[1]);}
  if(hi==0)wsf[32+r32]=l_reg;asm volatile("s_waitcnt lgkmcnt(0)":::"memory");
  float rli[16];
  #pragma unroll
  for(int r=0;r<16;++r)rli[r]=__builtin_amdgcn_rcpf(wsf[32+crow(r,hi)]);
  bf16*Ow=Ow0+(long)(wid*QBLK)*op;
  { bf16*stg=(bf16*)(shm+V128_OST)+wid*2048;
    #pragma unroll
    for(int ps=0;ps<2;++ps){
      #pragma unroll
      for(int r=0;r<16;++r){const int orow=crow(r,hi);
        #pragma unroll
        for(int d0=0;d0<2;++d0)stg[orow*64+d0*32+r32]=__float2bfloat16(o[2*ps+d0][r]*rli[r]);}
      asm volatile("s_waitcnt lgkmcnt(0)":::"memory");
      #pragma unroll
      for(int i=0;i<4;++i){const int row=i*8+(lane>>3),ch=lane&7; const u32x4 v=*(const u32x4*)(stg+row*64+ch*8); ATTN_STORE16(Ow+(long)row*op+ps*64+ch*8,v);}
      asm volatile("s_waitcnt lgkmcnt(0)":::"memory"); } }
  asm volatile("s_waitcnt lgkmcnt(0)\n\ts_barrier":::"memory");
  #undef DMA_K
  #undef DMA_V
  #undef CMASK
  #undef START
  #undef RESC
  #undef ROT
  #undef QF
}
constexpr int ATTN_LDS_BYTES=LDS_BYTES;
#undef SBAR
#undef WAIT_BAR
}
#define GAS __attribute__((address_space(1)))
#define LAS __attribute__((address_space(3)))
typedef unsigned short bf16;
typedef unsigned v4u __attribute__((ext_vector_type(4)));
typedef float f32x4 __attribute__((ext_vector_type(4)));
typedef short bf16x8 __attribute__((ext_vector_type(8)));
typedef GAS unsigned gu32;
typedef GAS unsigned long long gu64;
#define RLX_AGENT __ATOMIC_RELAXED, __HIP_MEMORY_SCOPE_AGENT
#define LDS_WAIT() asm volatile("s_waitcnt lgkmcnt(0)" ::: "memory")
#define VM_WAIT() asm volatile("s_waitcnt vmcnt(0)" ::: "memory")
__device__ __forceinline__ unsigned long long rt() { return __builtin_amdgcn_s_memrealtime(); }
__device__ __forceinline__ unsigned f2bf(float f) { unsigned u = __builtin_bit_cast(unsigned, f); return (u + 0x7fffu + ((u >> 16) & 1u)) >> 16; }
__device__ __forceinline__ unsigned pk2(float lo, float hi) { return f2bf(lo) | (f2bf(hi) << 16); }

#define XB_TMO      128
#define XB_XCNT(j)  (256  + 64 * (j))
#define XB_XSUB(j)  (1280 + 64 * (j))
#define XB_XGEN(j)  (2304 + 64 * (j))
#define XB_TOP      3328
#define XB_TOPGEN   3392
#define XCD_BAR_WORDS 3456
#define XB_SPIN_CAP (1u << 18)

__device__ __forceinline__ unsigned xb_ld(unsigned* p)              { return __hip_atomic_load(p, __ATOMIC_RELAXED, __HIP_MEMORY_SCOPE_AGENT); }
__device__ __forceinline__ unsigned xb_add(unsigned* p, unsigned v) { return __hip_atomic_fetch_add(p, v, __ATOMIC_RELAXED, __HIP_MEMORY_SCOPE_AGENT); }
__device__ __forceinline__ unsigned xb_xcc_id() { return (unsigned)__builtin_amdgcn_s_getreg((3 << 11) | 20) & 0xFu; }
#define XB_SPIN(cond, bar) do { unsigned _sp = 0; while (cond) { __builtin_amdgcn_s_sleep(1); \
    if ((++_sp & 255u) == 0u) { if (xb_ld(&(bar)[XB_TMO])) break; if (_sp > XB_SPIN_CAP) { atomicAdd(&(bar)[XB_TMO], 1u); break; } } } } while (0)

struct XcdBarrier {
    unsigned* bar; unsigned x;
    volatile LAS unsigned* st;
};

__device__ __forceinline__ XcdBarrier xcd_barrier_post(unsigned* bar, volatile LAS unsigned* st, const int tid_) {
    XcdBarrier b; b.bar = bar; b.x = xb_xcc_id(); b.st = st;
    if (tid_ == 0) (void)xb_add(&bar[XB_XCNT(b.x)], 1u);
    return b;
}
__device__ __forceinline__ void xcd_barrier_complete(unsigned* bar, unsigned x, unsigned& nloc, unsigned& nx) {
    const unsigned G = gridDim.x * gridDim.y * gridDim.z;
    unsigned sum, cnt, mine, sp = 0u;
    for (;;) {
        sum = 0u; cnt = 0u; mine = 0u;
#pragma unroll
        for (unsigned j = 0; j < 16; ++j) { const unsigned c = xb_ld(&bar[XB_XCNT(j)]); sum += c; cnt += (c > 0u) ? 1u : 0u; mine = (j == x) ? c : mine; }
        if (sum == G) break;
        __builtin_amdgcn_s_sleep(1);
        if ((++sp & 255u) == 0u) { if (xb_ld(&bar[XB_TMO])) break; if (sp > XB_SPIN_CAP) { atomicAdd(&bar[XB_TMO], 1u); break; } }
    }
    nloc = mine > 0u ? mine : 1u; nx = cnt > 0u ? cnt : 1u;
}

__device__ __forceinline__ void xcd_barrier(const XcdBarrier& b, const int tid_) {
    asm volatile("s_waitcnt vmcnt(0)" ::: "memory");
    __syncthreads();
    if (tid_ == 0) {
        unsigned* bar = b.bar;
        __builtin_amdgcn_s_waitcnt(0);
        unsigned nloc = b.st[0], nx = b.st[1];
        if (nloc == 0u) { xcd_barrier_complete(bar, b.x, nloc, nx); b.st[0] = nloc; b.st[1] = nx; }
        const unsigned old = xb_add(&bar[XB_XSUB(b.x)], 1u);
        const unsigned gen = old / nloc;
        if (old + 1u == (gen + 1u) * nloc) {
            __builtin_amdgcn_fence(__ATOMIC_RELEASE, "agent");
            asm volatile("s_waitcnt vmcnt(0)" ::: "memory");
            const unsigned og = xb_add(&bar[XB_TOP], 1u);
            const unsigned tg = og / nx;
            if (og + 1u == (tg + 1u) * nx) xb_add(&bar[XB_TOPGEN], 1u);
            else XB_SPIN(xb_ld(&bar[XB_TOPGEN]) == tg, bar);
            __builtin_amdgcn_fence(__ATOMIC_ACQUIRE, "agent");
            xb_add(&bar[XB_XGEN(b.x)], 1u);
            asm volatile("s_waitcnt vmcnt(0)" ::: "memory");
        } else {
            XB_SPIN(xb_ld(&bar[XB_XGEN(b.x)]) == gen, bar);
            __builtin_amdgcn_fence(__ATOMIC_ACQUIRE, "agent");
            asm volatile("s_waitcnt vmcnt(0)" ::: "memory");
        }
    }
    __syncthreads();
}
constexpr size_t MiB = 1u << 20;
constexpr size_t WS_CTL = 0, CTL_ZERO_BYTES = 81920;
constexpr size_t WS_MOD = 1 * MiB;
constexpr size_t WS_ROPE = 3 * MiB;
constexpr size_t WS_ROUTE_E = 3 * MiB + 65536;
constexpr size_t WS_ROUTE_W = 3 * MiB + 262144;
constexpr size_t WS_SLOT_TOK = 4 * MiB;
constexpr size_t WS_SLOT_W = 4 * MiB + 524288;
constexpr size_t WS_TOKSLOT = 5 * MiB;
constexpr size_t WS_XC = 8 * MiB;
constexpr size_t WS_H = 24 * MiB;
constexpr size_t WS_WT = 96 * MiB;
constexpr size_t WT_IN = 0, WT_OUT = 6 * MiB, WT_GU = 8 * MiB, WT_DN = 120 * MiB;
constexpr size_t WS_HP = 286 * MiB;
constexpr size_t WS_R1 = 438 * MiB;
constexpr size_t R1_OPART = 216 * MiB;
constexpr size_t WS_END = 970 * MiB;

constexpr int CW_TMO = 0, CW_CODE = 1;
constexpr int CW_BAR = 4096;
constexpr int CW_MOE = 16384;

constexpr int RING_OFF = 0, RING_BYTES = 131072;
constexpr int LDSCTL_OFF = RING_BYTES, MISC_OFF = LDSCTL_OFF + 320;
constexpr int TAB_OFF = LDSCTL_OFF + 1024;
constexpr int SS_OFF = LDSCTL_OFF + 4096;
constexpr int LDS_BYTES = 147456;
constexpr int NWAVES = 8;

struct Args { const float* in[27]; float* out; unsigned char* ws; int ph_lo, ph_hi; };
struct Frame { LAS unsigned char* lds; gu32* ctl; int tid, lane, wave, vcu, G; };
constexpr int ARGS_OFF = LDSCTL_OFF + 512;
#define ARG_LO(k) ((unsigned)__builtin_amdgcn_readfirstlane((int)((const LAS unsigned*)(F.lds + ARGS_OFF))[2 * (k)]))
#define ARG_HI(k) ((unsigned)__builtin_amdgcn_readfirstlane((int)((const LAS unsigned*)(F.lds + ARGS_OFF))[2 * (k) + 1]))
#define ARG_U64(k) (((unsigned long long)ARG_HI(k) << 32) | (unsigned long long)ARG_LO(k))
#define ARG_IN(k) ((const float*)(const GAS float*)ARG_U64(k))
#define ARG_OUT ((float*)(GAS float*)ARG_U64(27))
#define ARG_WS ((unsigned char*)(GAS unsigned char*)ARG_U64(28))

__device__ __forceinline__ float wave_sum(float v) {
#define WS_DPP(ctrl) v += __int_as_float(__builtin_amdgcn_update_dpp(0, __float_as_int(v), (ctrl), 0xf, 0xf, true))
    WS_DPP(0xB1); WS_DPP(0x4E); WS_DPP(0x141); WS_DPP(0x140);
#undef WS_DPP
    { const auto r = __builtin_amdgcn_permlane16_swap(__float_as_uint(v), __float_as_uint(v), false, false); v = __uint_as_float(r[0]) + __uint_as_float(r[1]); }
    { const auto r = __builtin_amdgcn_permlane32_swap(__float_as_uint(v), __float_as_uint(v), false, false); v = __uint_as_float(r[0]) + __uint_as_float(r[1]); }
    return v;
}
__device__ __forceinline__ float* resid_row(float* out, float* xc, int r) { const int b = r / RB, t = r - b * RB; return t < SEQ ? out + (size_t)(b * SEQ + t) * D : xc + (size_t)(b * CTXL + t - SEQ) * D; }

__device__ __forceinline__ void p0_phase(const Frame& F) {
    const size_t gt = (size_t)F.vcu * 512 + F.tid, NT_ = (size_t)F.G * 512;
    { const f32x4* s = (const f32x4*)ARG_IN(2); f32x4* d = (f32x4*)(ARG_WS + WS_XC); for (size_t i = gt; i < (size_t)NB * CTXL * D / 4; i += NT_) d[i] = s[i]; }
    if (F.vcu == 0) { for (int i = F.tid; i < 1024; i += 512) { const int v = i >> 4, k = i & 15; const float inv = powf(10000.f, -(float)k / 16.f), ang = (float)v * inv;
        float* rt_ = (float*)(ARG_WS + WS_ROPE); rt_[i] = cosf(ang); rt_[1024 + i] = sinf(ang); } }
    LAS float* S = (LAS float*)(F.lds);
    LAS float* R = (LAS float*)(F.lds + 17 * 1024 * 4);
    { const float* c_ = ARG_IN(1); const float* cc_ = ARG_IN(3);
    for (int i = F.tid; i < 17 * 1024; i += 512) { const float v = (i < 16 * 1024) ? c_[i] : cc_[i - 16 * 1024]; S[i] = v / (1.f + __expf(-v)); } }
    __syncthreads();
    const float* adaw = ARG_IN(4); const float* adab = ARG_IN(5); float* MODw = (float*)(ARG_WS + WS_MOD);
    const int cl = F.tid & 31, kc = F.tid >> 5;
    for (int item = F.vcu; item < 4 * 192; item += F.G) {
        const int l = item / 192, n0 = (item % 192) * 32;
        const float* W = adaw + ((size_t)l * D + kc * 64) * 6144 + n0 + cl;
        float acc[17];
#pragma unroll
        for (int bb = 0; bb < 17; ++bb) acc[bb] = 0.f;
        float w[64];
#pragma unroll
        for (int j = 0; j < 64; ++j) w[j] = W[(size_t)j * 6144];
#pragma unroll
        for (int k = 0; k < 64; k += 16) {
#pragma unroll
            for (int bb = 0; bb < 17; ++bb) {
#pragma unroll
                for (int j = 0; j < 16; j += 4) { const f32x4 s4 = *(const LAS f32x4*)(S + bb * 1024 + kc * 64 + k + j); acc[bb] += (s4[0] * w[k + j] + s4[1] * w[k + j + 1]) + (s4[2] * w[k + j + 2] + s4[3] * w[k + j + 3]); } }
        }
#pragma unroll
        for (int bb = 0; bb < 17; ++bb) R[(kc * 17 + bb) * 32 + cl] = acc[bb];
        __syncthreads();
        for (int o = F.tid; o < 17 * 32; o += 512) { const int bb = o >> 5, c = o & 31; float sum = 0.f;
#pragma unroll
            for (int q = 0; q < 16; ++q) sum += R[(q * 17 + bb) * 32 + c];
            MODw[(size_t)(l * 17 + bb) * 6144 + n0 + c] = adab[l * 6144 + n0 + c] + sum; }
        __syncthreads();
    }
}

__device__ __forceinline__ void transpose_item(const float* W, int K, int N, bf16* WT, int k0, int n0, int drow, LAS float* scr, int lane) {
    float wv[32];
#pragma unroll
    for (int i = 0; i < 32; ++i) wv[i] = __builtin_nontemporal_load(&W[(size_t)(k0 + 2 * i + (lane >> 5)) * N + n0 + (lane & 31)]);
#pragma unroll
    for (int i = 0; i < 32; ++i) scr[(2 * i + (lane >> 5)) * 33 + (lane & 31)] = wv[i];
    LDS_WAIT(); asm volatile("" ::: "memory");
    const int c = lane & 7;
#pragma unroll
    for (int j = 0; j < 4; ++j) { const int n = (lane >> 3) + 8 * j; const LAS float* s = scr + (8 * c) * 33 + n;
        v4u o; o.x = pk2(s[0 * 33], s[1 * 33]); o.y = pk2(s[2 * 33], s[3 * 33]); o.z = pk2(s[4 * 33], s[5 * 33]); o.w = pk2(s[6 * 33], s[7 * 33]);
        *(GAS v4u*)(WT + (size_t)(drow + n) * K + k0 + 8 * c) = o; }
    LDS_WAIT(); asm volatile("" ::: "memory");
}
__device__ __forceinline__ void transpose_item8(const float* W, int K, int N, unsigned char* WT, int k0, int n0, int drow, LAS float* scr, int lane, float scl) {
    float wv[32];
#pragma unroll
    for (int i = 0; i < 32; ++i) wv[i] = __builtin_nontemporal_load(&W[(size_t)(k0 + 2 * i + (lane >> 5)) * N + n0 + (lane & 31)]);
#pragma unroll
    for (int i = 0; i < 32; ++i) scr[(2 * i + (lane >> 5)) * 33 + (lane & 31)] = wv[i];
    LDS_WAIT(); asm volatile("" ::: "memory");
    const int c = lane & 7; typedef unsigned u32x2 __attribute__((ext_vector_type(2)));
#pragma unroll
    for (int j = 0; j < 4; ++j) { const int n = (lane >> 3) + 8 * j; const LAS float* s = scr + (8 * c) * 33 + n;
        u32x2 o; o.x = pk4_fp8(s[0 * 33] * scl, s[1 * 33] * scl, s[2 * 33] * scl, s[3 * 33] * scl); o.y = pk4_fp8(s[4 * 33] * scl, s[5 * 33] * scl, s[6 * 33] * scl, s[7 * 33] * scl);
        *(GAS u32x2*)(WT + (size_t)(drow + n) * K + k0 + 8 * c) = o; }
    LDS_WAIT(); asm volatile("" ::: "memory");
}
__device__ __forceinline__ void transpose_item8w(const float* W, int K, int N, unsigned char* WT, int k0, int n0, int drow, LAS unsigned short* scr, int lane, float scl) {
    f32x4 wv[16];
#pragma unroll
    for (int i = 0; i < 16; ++i) wv[i] = __builtin_nontemporal_load((const f32x4*)(W + (size_t)(k0 + 4 * i + (lane >> 4)) * N + n0 + 4 * (lane & 15)));
#pragma unroll
    for (int i = 0; i < 16; ++i) { LAS unsigned* d = (LAS unsigned*)(scr + (4 * i + (lane >> 4)) * 66 + 4 * (lane & 15)); d[0] = pk2(wv[i][0] * scl, wv[i][1] * scl); d[1] = pk2(wv[i][2] * scl, wv[i][3] * scl); }
    LDS_WAIT(); asm volatile("" ::: "memory");
    const int c = lane & 7; typedef unsigned u32x2 __attribute__((ext_vector_type(2)));
#pragma unroll
    for (int j = 0; j < 8; ++j) { const int n = (lane >> 3) + 8 * j; const LAS unsigned short* s = scr + (8 * c) * 66 + n;
        float f[8];
#pragma unroll
        for (int q = 0; q < 8; ++q) f[q] = __uint_as_float((unsigned)s[q * 66] << 16);
        u32x2 o; o.x = pk4_fp8(f[0], f[1], f[2], f[3]); o.y = pk4_fp8(f[4], f[5], f[6], f[7]);
        *(GAS u32x2*)(WT + (size_t)(drow + n) * K + k0 + 8 * c) = o; }
    LDS_WAIT(); asm volatile("" ::: "memory");
}
__device__ __forceinline__ int wt_drow(int mode, int e, int N, int n0) {
    if (mode == 0) return e * N + n0;
    if (mode == 1) return n0 < 512 ? (n0 >> 7) * 256 + (n0 & 127) : (n0 < 1024 ? ((n0 - 512) >> 7) * 256 + 128 + (n0 & 127) : n0);
    return e * 2 * N + (n0 >> 7) * 256 + (n0 & 127) + (mode == 3 ? 128 : 0);
}
template <bool TO8 = false>
__device__ __forceinline__ int wconv_job(const Frame& F, int& it, int step, const float* W, int nexp, int K, int N, bf16* WT, int mode, float scl = 1.f) {
    constexpr int NW_ = TO8 ? 64 : 32;
    const int per = (K / 64) * (N / NW_), tot = nexp * per, nblk = N / NW_;
    LAS float* scr = (LAS float*)(F.lds + RING_OFF + F.wave * 16384);
    for (; it < tot; it += step) { const int e = it / per, r = it - e * per, kb = r / nblk, nb = r - kb * nblk;
        if (TO8) transpose_item8w(W + (size_t)e * K * N, K, N, (unsigned char*)WT, 64 * kb, NW_ * nb, wt_drow(mode, e, N, NW_ * nb), (LAS unsigned short*)scr, F.lane, scl);
        else transpose_item(W + (size_t)e * K * N, K, N, WT, 64 * kb, 32 * nb, wt_drow(mode, e, N, 32 * nb), scr, F.lane); }
    it -= tot; return tot;
}
template <bool F8, bool F8D, bool W8IN = false, bool W8OUT = false, bool W8EV = false>
__device__ __forceinline__ void wconv_phase(const Frame& F, int l) {
    const int i = l >> 1, step = F.G * NWAVES; int it = F.vcu * NWAVES + F.wave;
    bf16* WT = (bf16*)(ARG_WS + WS_WT);
    if ((l & 1) == 0) {
        wconv_job<W8EV>(F, it, step, ARG_IN(8) + (size_t)i * D * EV_IN, 1, D, EV_IN, WT + WT_IN / 2, 1, W8EV ? 32.f : 1.f);
        wconv_job(F, it, step, ARG_IN(14) + (size_t)i * D * D, 1, D, D, WT + WT_OUT / 2, 0);
        wconv_job<F8>(F, it, step, ARG_IN(15) + (size_t)i * D * FF, 1, D, FF, WT + WT_GU / 2, 2, 32.f);
        wconv_job<F8>(F, it, step, ARG_IN(16) + (size_t)i * D * FF, 1, D, FF, WT + WT_GU / 2, 3, 32.f);
        wconv_job<F8D>(F, it, step, ARG_IN(17) + (size_t)i * FF * D, 1, FF, D, WT + WT_DN / 2, 0, 64.f);
    } else {
        wconv_job<W8IN>(F, it, step, ARG_IN(18) + (size_t)i * D * OD_IN, 1, D, OD_IN, WT + WT_IN / 2, 0, W8IN ? 32.f : 1.f);
        wconv_job<W8OUT>(F, it, step, ARG_IN(21) + (size_t)i * D * D, 1, D, D, WT + WT_OUT / 2, 0, W8OUT ? 32.f : 1.f);
        wconv_job<F8>(F, it, step, ARG_IN(23) + (size_t)i * NE * D * FF, NE, D, FF, WT + WT_GU / 2, 2, 32.f);
        wconv_job<F8>(F, it, step, ARG_IN(24) + (size_t)i * NE * D * FF, NE, D, FF, WT + WT_GU / 2, 3, 32.f);
        wconv_job<F8D>(F, it, step, ARG_IN(25) + (size_t)i * NE * FF * D, NE, FF, D, WT + WT_DN / 2, 0, 64.f);
    }
}

template <bool ROUTER, bool OUT8 = false, bool MOEADD = false>
__device__ __forceinline__ void norm_phase(const Frame& F, int l, int which, bool lat_only) {
    const float* MOD = (const float*)(ARG_WS + WS_MOD) + (size_t)l * 17 * 6144;
    const float* G = (which ? ARG_IN(7) : ARG_IN(6)) + l * D;
    unsigned char* ws_ = ARG_WS; float* xc = (float*)(ws_ + WS_XC); bf16* H = (bf16*)(ws_ + WS_H); const float* outp = (l == 0 && which == 0) ? ARG_IN(0) : ARG_OUT;
    int* routeE = (int*)(ws_ + WS_ROUTE_E); float* routeW = (float*)(ws_ + WS_ROUTE_W);
    LAS float* RW = (LAS float*)(F.lds);
    LAS unsigned* LC = (LAS unsigned*)(F.lds + TAB_OFF);
    if (ROUTER) {
        const float* rw = ARG_IN(22) + (size_t)(l >> 1) * D * NE;
        for (int i = F.tid; i < D * NE; i += 512) { const int c = i >> 3, e = i & 7, ln = (c & 255) >> 2, j = c >> 8, q = c & 3; RW[(((j * 4 + q) * 2 + (e >> 2)) * 64 + ln) * 4 + (e & 3)] = rw[i]; }
        if (F.tid < 16) LC[F.tid] = 0u;
        int* st = (int*)(ws_ + WS_SLOT_TOK); for (int i = F.vcu * 512 + F.tid; i < MAX_SLOTS; i += F.G * 512) st[i] = -1;
        __syncthreads();
    }
    const int gw = F.vcu * NWAVES + F.wave, NGW = F.G * NWAVES, RPW = (M_ALL + NGW - 1) / NGW, r0_ = gw * RPW, r1_ = (r0_ + RPW < M_ALL) ? r0_ + RPW : M_ALL;
    int mkey = -1; f32x4 mg[4], msh[4], vn[4];
    const int* TS_ = (const int*)(ws_ + WS_TOKSLOT); const bf16* Y_ = (const bf16*)(ws_ + WS_HP);
    int sn0 = 0, sn1 = 0; float wn0 = 0.f, wn1 = 0.f, wc0 = 0.f, wc1 = 0.f; unsigned long long yn0[4], yn1[4]; f32x4 g5v[4];
#define NRM_ROUTE(rr) do { sn0 = TS_[2 * (rr)]; sn1 = TS_[2 * (rr) + 1]; wn0 = routeW[2 * (rr)]; wn1 = routeW[2 * (rr) + 1]; } while (0)
#define NRM_YROW() do { wc0 = wn0; wc1 = wn1; _Pragma("unroll") for (int j = 0; j < 4; ++j) { const int c = 4 * F.lane + 256 * j; yn0[j] = *(const unsigned long long*)(Y_ + (size_t)sn0 * D + c); yn1[j] = *(const unsigned long long*)(Y_ + (size_t)sn1 * D + c); } } while (0)
    if (r0_ < r1_) { const int b = r0_ / RB, t = r0_ - b * RB; const float* xr = (t < SEQ) ? outp + (size_t)(b * SEQ + t) * D : xc + (size_t)(b * CTXL + t - SEQ) * D;
        if (MOEADD) NRM_ROUTE(r0_);
#pragma unroll
        for (int j = 0; j < 4; ++j) vn[j] = *(const f32x4*)(xr + 4 * F.lane + 256 * j);
        if (MOEADD) { NRM_YROW(); if (r0_ + 1 < r1_) NRM_ROUTE(r0_ + 1); } }
    for (int r = r0_; r < r1_; ++r) {
        const int b = r / RB, t = r - b * RB;
        { const int key = (t < SEQ) ? b : NB;
          if (key != mkey) { mkey = key; const float* mp = MOD + (size_t)key * 6144 + (which ? 3 : 0) * D;
#pragma unroll
            for (int j = 0; j < 4; ++j) { const int c = 4 * F.lane + 256 * j; const f32x4 g = *(const f32x4*)(G + c), sh = *(const f32x4*)(mp + c), sc = *(const f32x4*)(mp + D + c); mg[j] = g * (sc + 1.f); msh[j] = sh;
                if (MOEADD) g5v[j] = *(const f32x4*)(MOD - 17 * 6144 + (size_t)key * 6144 + 5 * D + c); } } }
        f32x4 v[4]; float s = 0.f;
#pragma unroll
        for (int j = 0; j < 4; ++j) v[j] = vn[j];
        unsigned long long y0[4], y1[4]; const float w0 = wc0, w1 = wc1;
        if (MOEADD) {
#pragma unroll
            for (int j = 0; j < 4; ++j) { y0[j] = yn0[j]; y1[j] = yn1[j]; } }
        if (r + 1 < r1_) { const int b2 = (r + 1) / RB, t2 = (r + 1) - b2 * RB; const float* xr = (t2 < SEQ) ? outp + (size_t)(b2 * SEQ + t2) * D : xc + (size_t)(b2 * CTXL + t2 - SEQ) * D;
#pragma unroll
            for (int j = 0; j < 4; ++j) vn[j] = *(const f32x4*)(xr + 4 * F.lane + 256 * j);
            if (MOEADD) { NRM_YROW(); if (r + 2 < r1_) NRM_ROUTE(r + 2); } }
        if (lat_only && t >= SEQ) continue;
        if (MOEADD) { float* xw = (t < SEQ) ? ARG_OUT + (size_t)(b * SEQ + t) * D : xc + (size_t)(b * CTXL + t - SEQ) * D;
#pragma unroll
            for (int j = 0; j < 4; ++j) { const int c = 4 * F.lane + 256 * j;
                f32x4 a0, a1; a0.x = __uint_as_float((unsigned)y0[j] << 16); a0.y = __uint_as_float((unsigned)y0[j] & 0xffff0000u); a0.z = __uint_as_float((unsigned)(y0[j] >> 32) << 16); a0.w = __uint_as_float((unsigned)(y0[j] >> 32) & 0xffff0000u);
                a1.x = __uint_as_float((unsigned)y1[j] << 16); a1.y = __uint_as_float((unsigned)y1[j] & 0xffff0000u); a1.z = __uint_as_float((unsigned)(y1[j] >> 32) << 16); a1.w = __uint_as_float((unsigned)(y1[j] >> 32) & 0xffff0000u);
                v[j] = v[j] + g5v[j] * (a0 * w0 + a1 * w1); *(f32x4*)(xw + c) = v[j]; } }
#pragma unroll
        for (int j = 0; j < 4; ++j) s += (v[j].x * v[j].x + v[j].y * v[j].y) + (v[j].z * v[j].z + v[j].w * v[j].w);
        const float rs = 1.f / sqrtf(wave_sum(s) * (1.f / D) + 1e-6f);
#pragma unroll
        for (int j = 0; j < 4; ++j) { const int c = 4 * F.lane + 256 * j;
            v[j] = (v[j] * rs) * mg[j] + msh[j];
            if (OUT8) *(unsigned*)((unsigned char*)H + (size_t)r * D + c) = pk4_fp8(v[j].x, v[j].y, v[j].z, v[j].w);
            else *(unsigned long long*)(H + (size_t)r * D + c) = (unsigned long long)pk2(v[j].x, v[j].y) | ((unsigned long long)pk2(v[j].z, v[j].w) << 32); }
        if (ROUTER) {
            float lg[8];
#pragma unroll
            for (int e = 0; e < 8; ++e) lg[e] = 0.f;
#pragma unroll
            for (int j = 0; j < 4; ++j)
#pragma unroll
                for (int q = 0; q < 4; ++q) { const f32x4 w0 = *(const LAS f32x4*)(RW + (((j * 4 + q) * 2 + 0) * 64 + F.lane) * 4), w1 = *(const LAS f32x4*)(RW + (((j * 4 + q) * 2 + 1) * 64 + F.lane) * 4); const float hv = v[j][q];
                    lg[0] += hv * w0[0]; lg[1] += hv * w0[1]; lg[2] += hv * w0[2]; lg[3] += hv * w0[3]; lg[4] += hv * w1[0]; lg[5] += hv * w1[1]; lg[6] += hv * w1[2]; lg[7] += hv * w1[3]; }
#pragma unroll
            for (int e = 0; e < 8; ++e) lg[e] = wave_sum(lg[e]);
            int e0 = 0; float v0 = lg[0];
#pragma unroll
            for (int e = 1; e < 8; ++e) if (lg[e] > v0) { v0 = lg[e]; e0 = e; }
            int e1 = -1; float v1 = -INFINITY;
#pragma unroll
            for (int e = 0; e < 8; ++e) if (e != e0 && lg[e] > v1) { v1 = lg[e]; e1 = e; }
            if (F.lane == 0) { const float w0 = 1.f / (1.f + __expf(v1 - v0));
                routeE[r] = e0 | (e1 << 8); routeW[2 * r] = w0; routeW[2 * r + 1] = 1.f - w0;
                __hip_atomic_fetch_add(&LC[e0], 1u, __ATOMIC_RELAXED, __HIP_MEMORY_SCOPE_WORKGROUP); __hip_atomic_fetch_add(&LC[e1], 1u, __ATOMIC_RELAXED, __HIP_MEMORY_SCOPE_WORKGROUP); }
        }
    }
    if (ROUTER) { __syncthreads(); if (F.tid < 8) { const unsigned c = LC[F.tid]; if (c) __hip_atomic_fetch_add(F.ctl + CW_MOE + 1024 * (l >> 1) + F.tid, c, RLX_AGENT); } __syncthreads(); }
#undef NRM_ROUTE
#undef NRM_YROW
}

template <bool EVEN>
__device__ __forceinline__ void qkpost_phase(const Frame& F, int l) {
    constexpr int NH = EVEN ? 10 : 32, NQ = EVEN ? 8 : 16, P = EVEN ? EV_P : OD_IN;
    bf16* base = (bf16*)(ARG_WS + WS_R1);
    const float* cosT = (const float*)(ARG_WS + WS_ROPE); const float* sinT = cosT + 1024;
    const float* qg = ARG_IN(12) + (l >> 1) * 64; const float* kg = ARG_IN(13) + (l >> 1) * 64;
    const int k = F.lane & 7, sub = F.lane >> 3;
    const long total = (long)M_ALL * NH, step = (long)F.G * NWAVES * 8;
    for (long it = ((long)(F.vcu * NWAVES + F.wave)) * 8 + sub; it < total; it += step) {
        const int r = (int)(it / NH), h = (int)(it - (long)r * NH); const int b = r / RB, t = r - b * RB; const bool isq = h < NQ;
        if (!EVEN && t >= SEQ && !isq) continue;
        bf16* p = base + (size_t)r * P + (EVEN ? (isq ? 512 + 64 * h : 1024 + 64 * (h - 8)) : (isq ? 64 * h : 1024 + 64 * (h - 16))) + 8 * k;
        const v4u raw = *(const v4u*)p; float x[8];
#pragma unroll
        for (int e = 0; e < 4; ++e) { x[2 * e] = __uint_as_float(raw[e] << 16); x[2 * e + 1] = __uint_as_float(raw[e] & 0xffff0000u); }
        if (EVEN) { float ss = 0.f;
#pragma unroll
            for (int e = 0; e < 8; ++e) ss += x[e] * x[e];
            ss += __shfl_xor(ss, 1); ss += __shfl_xor(ss, 2); ss += __shfl_xor(ss, 4);
            const float rs = 1.f / sqrtf(ss * (1.f / 64.f) + 1e-6f); const float* g = (isq ? qg : kg) + 8 * k;
#pragma unroll
            for (int e = 0; e < 8; ++e) x[e] = x[e] * rs * g[e]; }
        float y[8];
#pragma unroll
        for (int e = 0; e < 8; ++e) y[e] = __shfl_xor(x[e], 2);
        if (t < SEQ) { const int pv_ = (k >> 2) ? (t & 63) : (t >> 6); const float* cp = cosT + pv_ * 16 + (k & 1) * 8; const float* sp = sinT + pv_ * 16 + (k & 1) * 8; const float sg = (k & 2) ? 1.f : -1.f;
#pragma unroll
            for (int e = 0; e < 8; ++e) x[e] = x[e] * cp[e] + sg * y[e] * sp[e]; }
        if (isq) {
#pragma unroll
            for (int e = 0; e < 8; ++e) x[e] *= QSCALE; }
        v4u o; o.x = pk2(x[0], x[1]); o.y = pk2(x[2], x[3]); o.z = pk2(x[4], x[5]); o.w = pk2(x[6], x[7]);
        *(v4u*)p = o;
    }
}

__device__ __forceinline__ void conv_phase(const Frame& F, int l) {
    const int i = l >> 1;
    LAS unsigned char* TILE = F.lds;
    LAS float* CW = (LAS float*)(F.lds + 63488);
    const bf16* EV = (const bf16*)(ARG_WS + WS_R1); bf16* MIX = (bf16*)(ARG_WS + WS_H);
    { const float* cw = ARG_IN(9) + (size_t)i * 31 * 512; for (int k = F.tid; k < 31 * 512; k += 512) { const int j = k >> 9, ch = k & 511; CW[(j * 2 + ((ch >> 2) & 1)) * 256 + (ch >> 3) * 4 + (ch & 3)] = cw[k]; } }
    float lg[8], lb[8]; const float* lng_ = ARG_IN(10); const float* lnb_ = ARG_IN(11);
#pragma unroll
    for (int c = 0; c < 8; ++c) { lg[c] = lng_[i * 512 + 8 * F.lane + c]; lb[c] = lnb_[i * 512 + 8 * F.lane + c]; }
    const int NU = NB * 72;
    for (int u = F.vcu; u < NU; u += F.G) {
        const int b = u / 72, v = u - b * 72; const bool lat = v < 64; const int t0 = lat ? 32 * v : 32 * (v - 64), L = lat ? SEQ : CTXL, rbase = b * RB + (lat ? 0 : SEQ);
        __syncthreads();
        for (int rr = F.wave; rr < 62; rr += NWAVES) { const int t = t0 - 15 + rr; v4u val = (v4u){0u, 0u, 0u, 0u};
            if (t >= 0 && t < L) val = *(const v4u*)(EV + (size_t)(rbase + t) * EV_P + 8 * F.lane);
            *(LAS v4u*)(TILE + rr * 1024 + 16 * F.lane) = val; }
        __syncthreads();
        float acc[4][8];
#pragma unroll
        for (int q = 0; q < 4; ++q)
#pragma unroll
            for (int c = 0; c < 8; ++c) acc[q][c] = 0.f;
#pragma unroll 2
        for (int j = 0; j < 31; ++j) {
            const f32x4 w0 = *(const LAS f32x4*)(CW + (j * 2) * 256 + 4 * F.lane), w1 = *(const LAS f32x4*)(CW + (j * 2 + 1) * 256 + 4 * F.lane);
#pragma unroll
            for (int q = 0; q < 4; ++q) { const v4u raw = *(const LAS v4u*)(TILE + (4 * F.wave + q + j) * 1024 + 16 * F.lane);
                acc[q][0] += __uint_as_float(raw[0] << 16) * w0[0]; acc[q][1] += __uint_as_float(raw[0] & 0xffff0000u) * w0[1];
                acc[q][2] += __uint_as_float(raw[1] << 16) * w0[2]; acc[q][3] += __uint_as_float(raw[1] & 0xffff0000u) * w0[3];
                acc[q][4] += __uint_as_float(raw[2] << 16) * w1[0]; acc[q][5] += __uint_as_float(raw[2] & 0xffff0000u) * w1[1];
                acc[q][6] += __uint_as_float(raw[3] << 16) * w1[2]; acc[q][7] += __uint_as_float(raw[3] & 0xffff0000u) * w1[3]; }
        }
#pragma unroll
        for (int q = 0; q < 4; ++q) {
            float s = 0.f;
#pragma unroll
            for (int c = 0; c < 8; ++c) s += acc[q][c];
            const float mean = wave_sum(s) * (1.f / 512.f); float s2 = 0.f;
#pragma unroll
            for (int c = 0; c < 8; ++c) { acc[q][c] -= mean; s2 += acc[q][c] * acc[q][c]; }
            const float rstd = 1.f / sqrtf(wave_sum(s2) * (1.f / 512.f) + 1e-5f);
            float o[8];
#pragma unroll
            for (int c = 0; c < 8; ++c) o[c] = fast_silu(acc[q][c] * rstd * lg[c] + lb[c]);
            v4u w; w.x = pk2(o[0], o[1]); w.y = pk2(o[2], o[3]); w.z = pk2(o[4], o[5]); w.w = pk2(o[6], o[7]);
            *(v4u*)(MIX + (size_t)(rbase + t0 + 4 * F.wave + q) * D + 8 * F.lane) = w;
        }
    }
    __syncthreads();
}

__device__ __forceinline__ void attn_even_phase(const Frame& F, unsigned char* lds_generic) {
    using abf = attn_body::bf16;
    const abf* EV = (const abf*)(ARG_WS + WS_R1); abf* MIX = (abf*)(ARG_WS + WS_H);
    const int NLAT = NB * 8 * 8, per = (NLAT + F.G - 1) / F.G;
    for (int id = F.vcu * per; id < (F.vcu + 1) * per && id < NLAT; ++id) {
        const int qb = id & 7, h = ((id >> 5) & 1) * 4 + ((id >> 3) & 3), b = id >> 6;
        const size_t r0 = (size_t)b * RB;
        attn_body::attn_unit<8, EV_P, EV_P, EV_P, D>(EV + (r0 + qb * 256) * EV_P + 512 + 64 * h, EV + r0 * EV_P + 1024 + 64 * (h >> 2), EV + r0 * EV_P + 1152 + 64 * (h >> 2),
                                MIX + (r0 + qb * 256) * D + 512 + 64 * h, 36, (char*)lds_generic, F.tid);
    }
    const int NCTX = NB * 8, perc = (NCTX + F.G - 1) / F.G;
    const int cv_ = (F.G >= 2 * NCTX) ? F.vcu - (F.G - NCTX) : F.vcu;
    for (int id = cv_ * perc; cv_ >= 0 && id < (cv_ + 1) * perc && id < NCTX; ++id) {
        const int h = id & 7, b = id >> 3; const size_t r0 = (size_t)b * RB + SEQ;
        attn_body::attn_unit<8, EV_P, EV_P, EV_P, D>(EV + r0 * EV_P + 512 + 64 * h, EV + r0 * EV_P + 1024 + 64 * (h >> 2), EV + r0 * EV_P + 1152 + 64 * (h >> 2),
                                MIX + r0 * D + 512 + 64 * h, 4, (char*)lds_generic, F.tid);
    }
}
__device__ __forceinline__ void diffcomb_rows(const Frame& F, int l, int rbase, int nrows, int h) {
    const bf16* OP = (const bf16*)(ARG_WS + WS_R1 + R1_OPART); bf16* MIX = (bf16*)(ARG_WS + WS_H);
    const float* lp = ARG_IN(19) + (l >> 1) * 256; const float lam_init = 0.8f - 0.6f * expf(-0.3f * (float)l);
    const float lam = expf(wave_sum(lp[F.lane] * lp[64 + F.lane])) - expf(wave_sum(lp[128 + F.lane] * lp[192 + F.lane])) + lam_init;
    const int k = F.lane & 15, sub = F.lane >> 4; const float* sg = ARG_IN(20) + (l >> 1) * 128 + 8 * k; const float osc = 1.f - lam_init;
    const bool out8 = ((W8OUT_MASK >> (l >> 1)) & 1) != 0;
    float g[8];
#pragma unroll
    for (int e = 0; e < 8; ++e) g[e] = sg[e] * osc;
    for (int it0 = F.wave * 4 + sub; it0 < nrows; it0 += NWAVES * 16) {
        v4u a[4], c[4];
#pragma unroll
        for (int q = 0; q < 4; ++q) { const bf16* p = OP + (size_t)(rbase + it0 + q * NWAVES * 4) * OP_P + h * 256 + 8 * k; a[q] = *(const v4u*)p; c[q] = *(const v4u*)(p + 128); }
#pragma unroll
        for (int q = 0; q < 4; ++q) { const int r = rbase + it0 + q * NWAVES * 4; float x[8]; float ss = 0.f;
#pragma unroll
            for (int e = 0; e < 4; ++e) { x[2 * e] = __uint_as_float(a[q][e] << 16) - lam * __uint_as_float(c[q][e] << 16); x[2 * e + 1] = __uint_as_float(a[q][e] & 0xffff0000u) - lam * __uint_as_float(c[q][e] & 0xffff0000u); }
#pragma unroll
            for (int e = 0; e < 8; ++e) ss += x[e] * x[e];
#define DC_DPP(ctrl) ss += __int_as_float(__builtin_amdgcn_update_dpp(0, __float_as_int(ss), (ctrl), 0xf, 0xf, true))
            DC_DPP(0xB1); DC_DPP(0x4E); DC_DPP(0x141); DC_DPP(0x140);
#undef DC_DPP
            const float rs = 1.f / sqrtf(ss * (1.f / 128.f) + 1e-6f);
            v4u o; o.x = pk2(x[0] * rs * g[0], x[1] * rs * g[1]); o.y = pk2(x[2] * rs * g[2], x[3] * rs * g[3]); o.z = pk2(x[4] * rs * g[4], x[5] * rs * g[5]); o.w = pk2(x[6] * rs * g[6], x[7] * rs * g[7]);
            if (out8) { typedef unsigned u32x2_ __attribute__((ext_vector_type(2))); u32x2_ o8; o8.x = pk4_fp8(x[0] * rs * g[0], x[1] * rs * g[1], x[2] * rs * g[2], x[3] * rs * g[3]); o8.y = pk4_fp8(x[4] * rs * g[4], x[5] * rs * g[5], x[6] * rs * g[6], x[7] * rs * g[7]);
                *(u32x2_*)((unsigned char*)MIX + (size_t)r * D + h * 128 + 8 * k) = o8; }
            else *(v4u*)(MIX + (size_t)r * D + h * 128 + 8 * k) = o; }
    }
}
__device__ __forceinline__ void attn_odd_phase(const Frame& F, unsigned char* lds_generic, bool need_ctx, int l) {
    using abf = attn_body::bf16;
    const abf* QKV = (const abf*)(ARG_WS + WS_R1); abf* OP = (abf*)(ARG_WS + WS_R1 + R1_OPART);
    const int NLAT = NB * 32 * 8;
    if (F.G * 16 == NLAT) {
        const int b = F.vcu >> 4, h = (F.vcu >> 1) & 7, qh = F.vcu & 1; const size_t r0 = (size_t)b * RB;
#if DIFF_V128
        for (int j = 0; j < 8; ++j) { const int qb = qh * 4 + (j & 3), c = j >> 2;
            attn_body::attn_unit_v128<8, OD_IN, OD_IN, OD_IN, OP_P>(QKV + (r0 + qb * 256) * OD_IN + (h * 2 + c) * 64, QKV + r0 * OD_IN + 1024 + (h * 2 + c) * 64, QKV + r0 * OD_IN + 2048 + h * 128,
                                OP + (r0 + qb * 256) * OP_P + h * 256 + c * 128, 36, (char*)lds_generic, F.tid); }
#else
        for (int j = 0; j < 16; ++j) { const int qb = qh * 4 + (j & 3), cv = j >> 2, c = cv >> 1, vh = cv & 1;
            attn_body::attn_unit<8, OD_IN, OD_IN, OD_IN, OP_P>(QKV + (r0 + qb * 256) * OD_IN + (h * 2 + c) * 64, QKV + r0 * OD_IN + 1024 + (h * 2 + c) * 64, QKV + r0 * OD_IN + 2048 + h * 128 + vh * 64,
                                OP + (r0 + qb * 256) * OP_P + h * 256 + c * 128 + vh * 64, 36, (char*)lds_generic, F.tid); }
#endif
        VM_WAIT(); __syncthreads();
        diffcomb_rows(F, l, b * RB + qh * 1024, 1024, h);
        if (need_ctx && F.vcu < NB * 8) { const int bc = F.vcu >> 3, hc = F.vcu & 7; const size_t rc = (size_t)bc * RB + SEQ;
#if DIFF_V128
            for (int c = 0; c < 2; ++c)
                attn_body::attn_unit_v128<8, OD_IN, OD_IN, OD_IN, OP_P>(QKV + rc * OD_IN + (hc * 2 + c) * 64, QKV + rc * OD_IN + 1024 + (hc * 2 + c) * 64, QKV + rc * OD_IN + 2048 + hc * 128,
                                    OP + rc * OP_P + hc * 256 + c * 128, 4, (char*)lds_generic, F.tid);
#else
            for (int cv = 0; cv < 4; ++cv) { const int c = cv >> 1, vh = cv & 1;
                attn_body::attn_unit<8, OD_IN, OD_IN, OD_IN, OP_P>(QKV + rc * OD_IN + (hc * 2 + c) * 64, QKV + rc * OD_IN + 1024 + (hc * 2 + c) * 64, QKV + rc * OD_IN + 2048 + hc * 128 + vh * 64,
                                    OP + rc * OP_P + hc * 256 + c * 128 + vh * 64, 4, (char*)lds_generic, F.tid); }
#endif
            VM_WAIT(); __syncthreads();
            diffcomb_rows(F, l, bc * RB + SEQ, CTXL, hc); }
        return;
    }
    const int per = (NLAT + F.G - 1) / F.G;
    for (int id = F.vcu * per; id < (F.vcu + 1) * per && id < NLAT; ++id) {
        const int qb = id & 7, cv = (id >> 3) & 3, h = (id >> 5) & 7, b = id >> 8; const int c = cv >> 1, vh = cv & 1;
        const size_t r0 = (size_t)b * RB;
        attn_body::attn_unit<8, OD_IN, OD_IN, OD_IN, OP_P>(QKV + (r0 + qb * 256) * OD_IN + (h * 2 + c) * 64, QKV + r0 * OD_IN + 1024 + (h * 2 + c) * 64, QKV + r0 * OD_IN + 2048 + h * 128 + vh * 64,
                                OP + (r0 + qb * 256) * OP_P + h * 256 + c * 128 + vh * 64, 36, (char*)lds_generic, F.tid);
    }
    if (need_ctx) {
        const int NCTX = NB * 32, perc = (NCTX + F.G - 1) / F.G;
        for (int id = F.vcu * perc; id < (F.vcu + 1) * perc && id < NCTX; ++id) {
            const int cv = id & 3, h = (id >> 2) & 7, b = id >> 5; const int c = cv >> 1, vh = cv & 1; const size_t r0 = (size_t)b * RB + SEQ;
            attn_body::attn_unit<8, OD_IN, OD_IN, OD_IN, OP_P>(QKV + r0 * OD_IN + (h * 2 + c) * 64, QKV + r0 * OD_IN + 1024 + (h * 2 + c) * 64, QKV + r0 * OD_IN + 2048 + h * 128 + vh * 64,
                                    OP + r0 * OP_P + h * 256 + c * 128 + vh * 64, 4, (char*)lds_generic, F.tid);
        }
    }
}
__device__ __forceinline__ void diffcomb_phase(const Frame& F, int l, bool need_ctx) {
    if (F.G * 16 == NB * 32 * 8) return;
    for (int u = F.vcu; u < NB * 8; u += F.G) { const int b = u >> 3, h = u & 7; diffcomb_rows(F, l, b * RB, need_ctx ? RB : SEQ, h); }
}

__device__ __forceinline__ void moe_tables(const Frame& F, int i) {
    LAS int* TAB = (LAS int*)(F.lds + TAB_OFF);
    __syncthreads();
    if (F.tid == 0) { int ts = 0;
        for (int g = 0; g < 8; ++g) { const unsigned c = __hip_atomic_load(F.ctl + CW_MOE + 1024 * i + g, RLX_AGENT); const int nt = (int)((c + 255u) >> 8); TAB[320 + g] = ts;
            for (int q = 0; q < nt && ts + q < MAX_SLOT_TILES; ++q) TAB[ts + q] = g; ts += nt; }
        TAB[336] = ts < MAX_SLOT_TILES ? ts : MAX_SLOT_TILES; }
    __syncthreads();
}
template <bool F8>
__device__ __forceinline__ void moe_assign_phase(const Frame& F, int l, bool lat_only) {
    const int i = l >> 1; moe_tables(F, i);
    LAS int* TAB = (LAS int*)(F.lds + TAB_OFF);
    LAS unsigned* LCNT = (LAS unsigned*)(F.lds);
    LAS int* SL = (LAS int*)(F.lds + 256);
    const int* RE = (const int*)(ARG_WS + WS_ROUTE_E); const float* RWt = (const float*)(ARG_WS + WS_ROUTE_W);
    int* ST = (int*)(ARG_WS + WS_SLOT_TOK); float* SW = (float*)(ARG_WS + WS_SLOT_W);
    const int chunk = (M_ALL + F.G - 1) / F.G, r0 = F.vcu * chunk, nr = (r0 + chunk <= M_ALL) ? chunk : (M_ALL > r0 ? M_ALL - r0 : 0);
    for (int base = 0; base < nr; base += 512) {
        if (F.tid < 32) LCNT[F.tid] = 0u;
        __syncthreads();
        const int r = r0 + base + F.tid; const bool valid = (base + F.tid < nr) && !(lat_only && (r % RB) >= SEQ);
        int e0 = 0, e1 = 0; unsigned lr0 = 0, lr1 = 0;
        if (valid) { const int ee = RE[r]; e0 = ee & 255; e1 = ee >> 8; lr0 = __hip_atomic_fetch_add(&LCNT[e0], 1u, __ATOMIC_RELAXED, __HIP_MEMORY_SCOPE_WORKGROUP); lr1 = __hip_atomic_fetch_add(&LCNT[e1], 1u, __ATOMIC_RELAXED, __HIP_MEMORY_SCOPE_WORKGROUP); }
        __syncthreads();
        if (F.tid < 8) { const unsigned c = LCNT[F.tid]; LCNT[16 + F.tid] = c ? __hip_atomic_fetch_add(F.ctl + CW_MOE + 1024 * i + 64 + F.tid, c, RLX_AGENT) : 0u; }
        __syncthreads();
        int s0 = -1, s1 = -1;
        if (valid) { s0 = TAB[320 + e0] * 256 + (int)(LCNT[16 + e0] + lr0); s1 = TAB[320 + e1] * 256 + (int)(LCNT[16 + e1] + lr1);
            if (s0 < MAX_SLOTS) { ST[s0] = r; SW[s0] = RWt[2 * r]; } else s0 = -1;
            if (s1 < MAX_SLOTS) { ST[s1] = r; SW[s1] = RWt[2 * r + 1]; } else s1 = -1; }
        if (base + F.tid < nr) { SL[2 * F.tid] = s0; SL[2 * F.tid + 1] = s1; if (valid) { int* TS = (int*)(ARG_WS + WS_TOKSLOT); TS[2 * r] = s0; TS[2 * r + 1] = s1; } }
        __syncthreads();
        const int ncp = 2 * ((nr - base) < 512 ? (nr - base) : 512);
        const bf16* H = (const bf16*)(ARG_WS + WS_H); bf16* HP = (bf16*)(ARG_WS + WS_HP);
        for (int cp0 = F.wave; cp0 < ncp; cp0 += 4 * NWAVES) {
            v4u x0[4], x1[4]; int sl[4];
#pragma unroll
            for (int q = 0; q < 4; ++q) { const int cp = cp0 + q * NWAVES; sl[q] = (cp < ncp) ? SL[cp] : -1; const int rr = r0 + base + (cp >> 1);
                if (sl[q] >= 0) { if (F8) x0[q] = ((const v4u*)((const unsigned char*)H + (size_t)rr * D))[F.lane]; else { const v4u* src = (const v4u*)(H + (size_t)rr * D) + F.lane; x0[q] = src[0]; x1[q] = src[64]; } } }
#pragma unroll
            for (int q = 0; q < 4; ++q) if (sl[q] >= 0) { if (F8) ((v4u*)((unsigned char*)HP + (size_t)sl[q] * D))[F.lane] = x0[q]; else { v4u* dst = (v4u*)(HP + (size_t)sl[q] * D) + F.lane; dst[0] = x0[q]; dst[64] = x1[q]; } }
        }
        __syncthreads();
    }
}

__device__ __forceinline__ void final_phase(const Frame& F) {
    const float* G = ARG_IN(26); float* outp = ARG_OUT; unsigned char* ws_ = ARG_WS; const int gw = F.vcu * NWAVES + F.wave, NGW = F.G * NWAVES;
    const int* TS = (const int*)(ws_ + WS_TOKSLOT); const float* RWt = (const float*)(ws_ + WS_ROUTE_W); const bf16* Y = (const bf16*)(ws_ + WS_HP);
    const float* MOD3 = (const float*)(ws_ + WS_MOD) + (size_t)3 * 17 * 6144 + 5 * D;
    const int RPW = (NB * SEQ + NGW - 1) / NGW, r0_ = gw * RPW, r1_ = (r0_ + RPW < NB * SEQ) ? r0_ + RPW : NB * SEQ;
    if (r0_ >= r1_) return;
    f32x4 gf[4];
#pragma unroll
    for (int j = 0; j < 4; ++j) gf[j] = *(const f32x4*)(G + 4 * F.lane + 256 * j);
    int sn0, sn1; float wn0, wn1;
    f32x4 xn[4]; unsigned long long yn0[4], yn1[4]; float wc0, wc1;
#define FIN_ROUTE(rl) do { const int b_ = (rl) / SEQ, r_ = b_ * RB + ((rl) - b_ * SEQ); sn0 = TS[2 * r_]; sn1 = TS[2 * r_ + 1]; wn0 = RWt[2 * r_]; wn1 = RWt[2 * r_ + 1]; } while (0)
#define FIN_ROW(rl) do { const float* xr_ = outp + (size_t)(rl) * D; wc0 = wn0; wc1 = wn1; \
        _Pragma("unroll") for (int j = 0; j < 4; ++j) { const int c = 4 * F.lane + 256 * j; xn[j] = *(const f32x4*)(xr_ + c); yn0[j] = *(const unsigned long long*)(Y + (size_t)sn0 * D + c); yn1[j] = *(const unsigned long long*)(Y + (size_t)sn1 * D + c); } } while (0)
    FIN_ROUTE(r0_); FIN_ROW(r0_); if (r0_ + 1 < r1_) FIN_ROUTE(r0_ + 1);
    int gkey = -1; f32x4 g5v[4];
    for (int rl = r0_; rl < r1_; ++rl) { float* xr = outp + (size_t)rl * D; const int b = rl / SEQ; f32x4 v[4]; float s = 0.f;
        if (b != gkey) { gkey = b; const float* g5 = MOD3 + (size_t)b * 6144;
#pragma unroll
            for (int j = 0; j < 4; ++j) g5v[j] = *(const f32x4*)(g5 + 4 * F.lane + 256 * j); }
        unsigned long long y0[4], y1[4]; const float w0 = wc0, w1 = wc1;
#pragma unroll
        for (int j = 0; j < 4; ++j) { v[j] = xn[j]; y0[j] = yn0[j]; y1[j] = yn1[j]; }
        if (rl + 1 < r1_) FIN_ROW(rl + 1);
        if (rl + 2 < r1_) FIN_ROUTE(rl + 2);
#pragma unroll
        for (int j = 0; j < 4; ++j) {
            f32x4 a0, a1; a0.x = __uint_as_float((unsigned)y0[j] << 16); a0.y = __uint_as_float((unsigned)y0[j] & 0xffff0000u); a0.z = __uint_as_float((unsigned)(y0[j] >> 32) << 16); a0.w = __uint_as_float((unsigned)(y0[j] >> 32) & 0xffff0000u);
            a1.x = __uint_as_float((unsigned)y1[j] << 16); a1.y = __uint_as_float((unsigned)y1[j] & 0xffff0000u); a1.z = __uint_as_float((unsigned)(y1[j] >> 32) << 16); a1.w = __uint_as_float((unsigned)(y1[j] >> 32) & 0xffff0000u);
            v[j] = v[j] + g5v[j] * (a0 * w0 + a1 * w1);
            s += (v[j].x * v[j].x + v[j].y * v[j].y) + (v[j].z * v[j].z + v[j].w * v[j].w); }
        const float rs = 1.f / sqrtf(wave_sum(s) * (1.f / D) + 1e-6f);
#pragma unroll
        for (int j = 0; j < 4; ++j) { const int c = 4 * F.lane + 256 * j; *(f32x4*)(xr + c) = (v[j] * rs) * gf[j]; } }
#undef FIN_ROUTE
#undef FIN_ROW
}

constexpr int PH_PAIR = 21, NPH = 2 + 2 * PH_PAIR;
#ifndef MK_ONE_LAUNCH
#define MK_ONE_LAUNCH 0
#endif
#ifndef PROBE_DUP
#define PROBE_DUP 0
#endif
#define IN(k) (lo <= (k) && (k) < hi)
#if PROBE_UDUP >= 0
#define PROBE_U(k) do { if (PROBE_UDUP == (k)) S.so.tot = S.so.nwg * 2; } while (0)
#else
#define PROBE_U(k) do { } while (0)
#endif
#define REPS(k) (((PROBE_DUP >> (k)) & 1) ? 2 : 1)
#define FRESH(tag) do { int z_; asm volatile("s_mov_b32 %0, 0 ; MARK " tag : "=s"(z_) :: "memory"); F.lane = (int)__builtin_amdgcn_mbcnt_hi(~0u, __builtin_amdgcn_mbcnt_lo(~0u, (unsigned)z_)); F.tid = F.wave * 64 + F.lane; } while (0)
#define SEAM(k) do { if (IN(k) && IN((k) + 1)) xcd_barrier(bar, F.tid); } while (0)
#define WSP(off) (ARG_WS + (off))
#define H_ ((bf16_t*)WSP(WS_H))
#define WT_ ((bf16_t*)WSP(WS_WT))
#define R1_ ((bf16_t*)WSP(WS_R1))
#define XC_ ((float*)WSP(WS_XC))
#define MODL(l) ((const float*)WSP(WS_MOD) + (size_t)(l) * 17 * 6144)
template <int I>
__device__ __forceinline__ void layer_pair(Frame& F, const XcdBarrier& bar, const int lo, const int hi, unsigned char* lds, int bx) {
    using namespace pg8;
    const PG8_LAS int* TAB = (const PG8_LAS int*)(F.lds + TAB_OFF);
    constexpr int il = I; constexpr int pb = 1 + PH_PAIR * il;
    constexpr bool W8W = (W8OUT_MASK >> I) & 1;
    constexpr bool W8E = (W8EV_MASK >> I) & 1;
    constexpr bool W8O = (W8IN_MASK >> I) & 1;
    constexpr bool F8E = (F8_MASK >> (2 * I)) & 1, F8O = (F8_MASK >> (2 * I + 1)) & 1, F8DE = (F8D_MASK >> (2 * I)) & 1, F8DO = (F8D_MASK >> (2 * I + 1)) & 1;
        { const int l = 2 * il;
        FRESH("0"); if (IN(pb + 0)) for (int rep_ = 0; rep_ < REPS(0); ++rep_) { if (rep_) xcd_barrier(bar, F.tid); if (I != 0) { } }

        FRESH("1"); if (IN(pb + 1)) for (int rep_ = 0; rep_ < REPS(1); ++rep_) { if (rep_) xcd_barrier(bar, F.tid); if (I != 0) wconv_phase<F8E, F8DE, false, false, W8E>(F, l); norm_phase<false, W8E, (I != 0)>(F, l, 0, false); }
        SEAM(pb + 1);
        FRESH("2"); if (IN(pb + 2)) for (int rep_ = 0; rep_ < REPS(2); ++rep_) { if (rep_) xcd_barrier(bar, F.tid); Gemm g{H_, WT_ + WT_IN / 2, M_ALL, EV_IN, W8E ? D / 2 : D}; MapOrder S; S.init(M_ALL / 256, EV_IN / 256, F.G, bx, 0, (W8E ? D / 2 : D) / 64); PROBE_U(2); EpiEvenIn2 E{R1_, (const float*)WSP(WS_ROPE), ARG_IN(12) + il * 64, ARG_IN(13) + il * 64, (PG8_LAS float*)(F.lds + SS_OFF), W8E ? 1.f / 32.f : 1.f};
            gemm_phase<EpiEvenIn2, MapOrder, true, true, W8E>(F.lds + RING_OFF, g, S, E, F.tid); }
        SEAM(pb + 2);
        FRESH("3"); if (IN(pb + 3)) for (int rep_ = 0; rep_ < REPS(3); ++rep_) { if (rep_) xcd_barrier(bar, F.tid); }
        FRESH("4"); if (IN(pb + 4)) for (int rep_ = 0; rep_ < REPS(4); ++rep_) { if (rep_) xcd_barrier(bar, F.tid); conv_phase(F, l); attn_even_phase(F, lds); }
        SEAM(pb + 4);
        FRESH("5"); if (IN(pb + 5)) for (int rep_ = 0; rep_ < REPS(5); ++rep_) { if (rep_) xcd_barrier(bar, F.tid); Gemm g{H_, WT_ + WT_OUT / 2, M_ALL, D, D}; MapOrder S; S.init(M_ALL / 256, D / 256, F.G, bx, 0, D / 64, 1); PROBE_U(5); EpiResid E{ARG_OUT, XC_, MODL(l) + 2 * D, 1.f, (l == 0) ? ARG_IN(0) : (const float*)ARG_OUT};
            gemm_phase<EpiResid, MapOrder, true, true>(F.lds + RING_OFF, g, S, E, F.tid); }
        SEAM(pb + 5);
        FRESH("6"); if (IN(pb + 6)) for (int rep_ = 0; rep_ < REPS(6); ++rep_) { if (rep_) xcd_barrier(bar, F.tid); norm_phase<false, F8E>(F, l, 1, false); }
        SEAM(pb + 6);
        FRESH("7"); if (IN(pb + 7)) for (int rep_ = 0; rep_ < REPS(7); ++rep_) { if (rep_) xcd_barrier(bar, F.tid); Gemm g{H_, WT_ + WT_GU / 2, M_ALL, 2 * FF, F8E ? D / 2 : D}; MapOrder S; S.init(M_ALL / 256, 2 * FF / 256, F.G, bx, 0, (F8E ? D / 2 : D) / 64); PROBE_U(7); typedef typename std::conditional<F8DE, EpiSwiGLU8, EpiSwiGLU>::type EpiUp; EpiUp E{(decltype(EpiUp::ACT))R1_, 2 * FF / 256, F8E ? 1.f / 32.f : 1.f};
            gemm_phase<EpiUp, MapOrder, true, true, F8E>(F.lds + RING_OFF, g, S, E, F.tid); }
        SEAM(pb + 7);
        FRESH("8"); if (IN(pb + 8)) for (int rep_ = 0; rep_ < REPS(8); ++rep_) { if (rep_) xcd_barrier(bar, F.tid); Gemm g{R1_, WT_ + WT_DN / 2, M_ALL, D, F8DE ? FF / 2 : FF}; MapOrder S; S.init(M_ALL / 256, D / 256, F.G, bx, 0, (F8DE ? FF / 2 : FF) / 64, 1); PROBE_U(8); EpiResid E{ARG_OUT, XC_, MODL(l) + 5 * D, F8DE ? 1.f / 64.f : 1.f, (const float*)ARG_OUT};
            gemm_phase<EpiResid, MapOrder, true, true, F8DE>(F.lds + RING_OFF, g, S, E, F.tid); }
        SEAM(pb + 8);
        }
        { const int l = 2 * il + 1; const bool need_ctx = (l < 3);
        FRESH("9"); if (IN(pb + 9)) for (int rep_ = 0; rep_ < REPS(9); ++rep_) { if (rep_) xcd_barrier(bar, F.tid); }

        FRESH("10"); if (IN(pb + 10)) for (int rep_ = 0; rep_ < REPS(10); ++rep_) { if (rep_) xcd_barrier(bar, F.tid); wconv_phase<F8O, F8DO, W8O, W8W>(F, l); norm_phase<false, W8O>(F, l, 0, false); }
        SEAM(pb + 10);
        FRESH("11"); if (IN(pb + 11)) for (int rep_ = 0; rep_ < REPS(11); ++rep_) { if (rep_) xcd_barrier(bar, F.tid); Gemm g{H_, WT_ + WT_IN / 2, M_ALL, OD_IN, W8O ? D / 2 : D}; MapOrder S; S.init(M_ALL / 256, OD_IN / 256, F.G, bx, 0, (W8O ? D / 2 : D) / 64); PROBE_U(11); EpiOddIn E{R1_, (const float*)WSP(WS_ROPE), W8O ? 1.f / 32.f : 1.f};
            gemm_phase<EpiOddIn, MapOrder, true, true, W8O>(F.lds + RING_OFF, g, S, E, F.tid); }
        SEAM(pb + 11);
        FRESH("12"); if (IN(pb + 12)) for (int rep_ = 0; rep_ < REPS(12); ++rep_) { if (rep_) xcd_barrier(bar, F.tid); }
        FRESH("13"); if (IN(pb + 13)) for (int rep_ = 0; rep_ < REPS(13); ++rep_) { if (rep_) xcd_barrier(bar, F.tid); attn_odd_phase(F, lds, need_ctx, l); }
        if (F.G * 16 != NB * 32 * 8) SEAM(pb + 13);
        FRESH("14"); if (IN(pb + 14)) for (int rep_ = 0; rep_ < REPS(14); ++rep_) { if (rep_) xcd_barrier(bar, F.tid); diffcomb_phase(F, l, need_ctx); }
        SEAM(pb + 14);
        FRESH("15"); if (IN(pb + 15)) for (int rep_ = 0; rep_ < REPS(15); ++rep_) { if (rep_) xcd_barrier(bar, F.tid); Gemm g{H_, WT_ + WT_OUT / 2, M_ALL, D, W8W ? D / 2 : D}; MapOrder S; S.init(need_ctx ? M_ALL / 256 : NB * 8, D / 256, F.G, bx, need_ctx ? 0 : 1, (W8W ? D / 2 : D) / 64, 1); PROBE_U(15); EpiResid E{ARG_OUT, XC_, MODL(l) + 2 * D, W8W ? 1.f / 32.f : 1.f, (l == 0) ? ARG_IN(0) : (const float*)ARG_OUT};
            gemm_phase<EpiResid, MapOrder, true, true, W8W>(F.lds + RING_OFF, g, S, E, F.tid); }
        SEAM(pb + 15);
        FRESH("16"); if (IN(pb + 16)) for (int rep_ = 0; rep_ < REPS(16); ++rep_) { if (rep_) xcd_barrier(bar, F.tid); norm_phase<true, F8O>(F, l, 1, !need_ctx); }
        SEAM(pb + 16);
        FRESH("17"); if (IN(pb + 17)) for (int rep_ = 0; rep_ < REPS(17); ++rep_) { if (rep_) xcd_barrier(bar, F.tid); moe_assign_phase<F8O>(F, l, !need_ctx); }
        SEAM(pb + 17);
        FRESH("18"); if (IN(pb + 18)) for (int rep_ = 0; rep_ < REPS(18); ++rep_) { if (rep_) xcd_barrier(bar, F.tid); moe_tables(F, il); Gemm g{(const bf16_t*)WSP(WS_HP), WT_ + WT_GU / 2, MAX_SLOTS, NE * 2 * FF, F8O ? D / 2 : D}; MapOrder S; S.init(__builtin_amdgcn_readfirstlane(TAB[336]), 2 * FF / 256, F.G, bx, 2, (F8O ? D / 2 : D) / 64, 1, 0, 2 * FF / 256, TAB); PROBE_U(18); typedef typename std::conditional<F8DO, EpiSwiGLU8, EpiSwiGLU>::type EpiUp; EpiUp E{(decltype(EpiUp::ACT))R1_, 2 * FF / 256, F8O ? 1.f / 32.f : 1.f};
            gemm_phase<EpiUp, MapOrder, true, true, F8O>(F.lds + RING_OFF, g, S, E, F.tid); }
        SEAM(pb + 18);
        FRESH("19"); if (IN(pb + 19)) for (int rep_ = 0; rep_ < REPS(19); ++rep_) { if (rep_) xcd_barrier(bar, F.tid); moe_tables(F, il); Gemm g{R1_, WT_ + WT_DN / 2, MAX_SLOTS, NE * D, F8DO ? FF / 2 : FF}; MapOrder S; S.init(__builtin_amdgcn_readfirstlane(TAB[336]), D / 256, F.G, bx, 2, 0, 1, 0, D / 256, TAB); PROBE_U(19);
            EpiMoeY E{(bf16_t*)WSP(WS_HP), F8DO ? 1.f / 64.f : 1.f};
            gemm_phase<EpiMoeY, MapOrder, true, true, F8DO>(F.lds + RING_OFF, g, S, E, F.tid); }
        SEAM(pb + 19);
        }
}
__global__ void __launch_bounds__(NWAVES * 64, 2) fwd(Args args) {
    extern __shared__ __attribute__((aligned(16))) unsigned char lds[];
    Frame F;
    F.lds = (LAS unsigned char*)lds;
    F.tid = threadIdx.x; F.lane = F.tid & 63; F.wave = __builtin_amdgcn_readfirstlane(F.tid >> 6); asm volatile("" : "+s"(F.wave));
    F.G = gridDim.x; { const int bx = blockIdx.x; F.vcu = (F.G % 8 == 0) ? (bx % 8) * (F.G / 8) + bx / 8 : bx; }
    F.ctl = (gu32*)(args.ws + WS_CTL);
    for (int u = F.tid; u < (LDS_BYTES - LDSCTL_OFF) / 4; u += NWAVES * 64) ((LAS unsigned*)(F.lds + LDSCTL_OFF))[u] = 0u;
    __syncthreads();
    if (F.tid < 58) { const unsigned* ka = (const unsigned*)__builtin_amdgcn_kernarg_segment_ptr(); ((LAS unsigned*)(F.lds + ARGS_OFF))[F.tid] = ka[F.tid]; }
    __syncthreads();
    const int lo = args.ph_lo, hi = args.ph_hi; int bx = (int)blockIdx.x;
    XcdBarrier bar; bar.bar = (unsigned*)(F.ctl + CW_BAR); bar.x = 0; bar.st = nullptr;
    if (hi - lo > 1) bar = xcd_barrier_post((unsigned*)(F.ctl + CW_BAR), (volatile LAS unsigned*)(F.lds + MISC_OFF) + 8, F.tid);

    FRESH("P0"); if (IN(0)) { p0_phase(F); wconv_phase<(F8_MASK & 1) != 0, (F8D_MASK & 1) != 0, false, false, (W8EV_MASK & 1) != 0>(F, 0); }
    SEAM(0);
    layer_pair<0>(F, bar, lo, hi, lds, bx);
    layer_pair<1>(F, bar, lo, hi, lds, bx);
    FRESH("FINAL"); if (IN(NPH - 1)) final_phase(F);
#undef IN
#undef SEAM
}

extern "C" void kernel_launch(void* const* d_in, const int* in_sizes, int n_in, void* d_out, int out_size, void* d_ws, size_t ws_size, hipStream_t stream) {
    static int grid = 0;
    if (grid == 0) {
        if (n_in != 27 || out_size != NB * SEQ * D || ws_size < WS_END) { fprintf(stderr, "kernel_launch: unexpected shapes: n_in %d out %d ws %zu (need %zu)\n", n_in, out_size, ws_size, (size_t)WS_END); grid = -1; return; }
        int dev = 0, cus = 0, per_cu = 0;
        if (hipGetDevice(&dev) != hipSuccess || hipDeviceGetAttribute(&cus, hipDeviceAttributeMultiprocessorCount, dev) != hipSuccess) { grid = -1; return; }
        if (hipFuncSetAttribute((const void*)fwd, hipFuncAttributeMaxDynamicSharedMemorySize, LDS_BYTES) != hipSuccess) { fprintf(stderr, "kernel_launch: hipFuncSetAttribute failed\n"); grid = -1; return; }
        if (hipOccupancyMaxActiveBlocksPerMultiprocessor(&per_cu, (const void*)fwd, NWAVES * 64, LDS_BYTES) != hipSuccess || per_cu < 1) fprintf(stderr, "kernel_launch: occupancy query reports %d blocks per CU\n", per_cu);
        (void)hipGetLastError();
        grid = cus;
    }
    if (grid < 0) return;
    (void)hipMemsetAsync((char*)d_ws + WS_CTL, 0, CTL_ZERO_BYTES, stream);
    Args a{};
    for (int i = 0; i < 27; ++i) a.in[i] = (const float*)d_in[i];
    a.out = (float*)d_out; a.ws = (unsigned char*)d_ws;
#if MK_ONE_LAUNCH
    a.ph_lo = 0; a.ph_hi = NPH;
    hipLaunchKernelGGL(fwd, dim3(grid), dim3(NWAVES * 64), LDS_BYTES, stream, a);
#else
    for (int p = 0; p < NPH; ++p) { a.ph_lo = p; a.ph_hi = p + 1; hipLaunchKernelGGL(fwd, dim3(grid), dim3(NWAVES * 64), LDS_BYTES, stream, a); }
#endif
    const hipError_t le = hipPeekAtLastError();
    if (le != hipSuccess) fprintf(stderr, "kernel_launch: launch failed: %s\n", hipGetErrorName(le));
}
```

```cpp
#include <hip/hip_runtime.h>
#include <hip/hip_bf16.h>
#include <cstdio>
#include <cstdint>
#include <cmath>
#include <type_traits>
#define MK_ONE_LAUNCH 1
#define PROBE_DUP 0
#define FFN_FP8 14
#define FFN_FP8_DN 15
#define PROBE_UDUP -1
#define W8IN_MASK 3
#define W8OUT_MASK 0
#define W8EV_MASK 2
namespace pg8 {
#define PG8_LAS __attribute__((address_space(3)))
typedef unsigned short bf16_t;
typedef short bf16x8 __attribute__((ext_vector_type(8)));
typedef float f32x4 __attribute__((ext_vector_type(4)));
typedef unsigned u32x4 __attribute__((ext_vector_type(4)));
constexpr int BM = 256, BK = 64, HALF = 128, HTB = HALF * BK * 2  , STAGE_BYTES = 8 * HTB, NXCD = 8, WGM = 8;

__host__ __device__ __forceinline__ int lds_byte(int r, int c) { const int st = (r >> 4) * 2 + (c >> 5), rr = r & 15, cc = c & 31, ob = rr * 64 + cc * 2; return st * 1024 + (ob ^ (((ob >> 9) & 1) << 5)); }
__host__ __device__ __forceinline__ void stage_rc(int b, int& R, int& C) { const int st = b / 1024, sb = b % 1024, swz = sb ^ (((sb >> 9) & 1) << 5); R = (st >> 1) * 16 + swz / 64; C = (st & 1) * 32 + (swz % 64) / 2; }
__host__ __device__ __forceinline__ int perm32(int rho) { const int n = rho >> 4, i = rho & 15; return 8 * (i >> 2) + 4 * n + (i & 3); }

#if PROBE_UDUP >= 0
struct Unit { int pm, pn, dup; };
#else
struct Unit { int pm, pn; };
#endif
struct Gemm { const bf16_t* A; const bf16_t* Bt; int M, N, K; };
typedef int v4i_t __attribute__((ext_vector_type(4))); typedef int v8i_t __attribute__((ext_vector_type(8)));

struct StaticOrder {
#if PROBE_UDUP >= 0
    int nM, nN, nwg, G, c, tot;
    __host__ __device__ void init(int M, int N, int G_, int c_) { nM = M / BM; nN = N / BM; nwg = nM * nN; G = G_; c = c_; tot = nwg; }
    __host__ __device__ bool next(int i, Unit& u) const { const long L = (long)i * G + c; if (L >= tot) return false; decode((int)(L % nwg), u); u.dup = (L >= nwg); return true; }
#else
    int nM, nN, nwg, G, c;
    __host__ __device__ void init(int M, int N, int G_, int c_) { nM = M / BM; nN = N / BM; nwg = nM * nN; G = G_; c = c_; }
    __host__ __device__ bool next(int i, Unit& u) const { const long L = (long)i * G + c; if (L >= nwg) return false; decode((int)L, u); return true; }
#endif
    __host__ __device__ void decode(int L, Unit& u) const {
        int wgid = L; { const int q = nwg / NXCD, r = nwg % NXCD, xcd = wgid % NXCD, off = wgid / NXCD; wgid = (xcd < r ? xcd * (q + 1) : r * (q + 1) + (xcd - r) * q) + off; }
        const int nig = WGM * nN, gid = wgid / nig, fm = gid * WGM, gsz = (nM - fm) < WGM ? (nM - fm) : WGM;
        u.pm = fm + ((wgid % nig) % gsz); u.pn = (wgid % nig) / gsz;
    }
    __device__ __forceinline__ void a_ready(const Unit&) const {}
    __device__ __forceinline__ void done(const Unit&) const {}
};

__device__ __forceinline__ unsigned cvt_pk_bf16(float lo, float hi) { unsigned r; asm volatile("v_cvt_pk_bf16_f32 %0, %1, %2" : "=v"(r) : "v"(lo), "v"(hi)); return r; }
template <class...> struct mk_void { typedef void type; };
template <class E, class = void> struct epi_split { static constexpr int nst = -1; };
template <class E> struct epi_split<E, typename mk_void<decltype(E::NST_HALF)>::type> { static constexpr int nst = E::NST_HALF; };
template <bool F8> struct FragT { struct type { bf16x8 k[2]; }; };
template <> struct FragT<true> { typedef v8i_t type; };
template <class Epi, class Sched, bool ALIGN_EPI = false, bool SP2 = false, bool F8 = false>
__device__ __forceinline__ void gemm_phase(PG8_LAS unsigned char* lds, const Gemm g, const Sched& S, const Epi& E, const int tid) {
    const int wid = __builtin_amdgcn_readfirstlane(tid >> 6), lane = tid & 63, wr = wid >> 2, wc = wid & 3, fr = lane & 15, fq = lane >> 4;
    const int K = g.K, nt = K / BK;
    unsigned voffA, voffB;
    { int R, C; stage_rc(tid * 16, R, C); const int Rb = Epi::PERM ? ((R & ~31) + perm32(R & 31)) : R; voffA = (unsigned)(R * K + C) * 2u; voffB = (unsigned)(Rb * K + C) * 2u; }
    const unsigned p1step = 64u * (unsigned)K * 2u;
    const unsigned kstep = (unsigned)(BK * 2);
    const unsigned hstep = (unsigned)HALF * K * 2;
    const unsigned tstep = 2 * hstep;
    const unsigned ldsw = (unsigned)wid * 1024u;
    int aoff = lds_byte(wr * 64 + fr, fq * 8), boff = lds_byte(wc * 32 + fr, fq * 8) + 4 * HTB;
    asm volatile("" : "+v"(aoff), "+v"(boff));
#define PG8_SA(b, h) (((b) * 2 + (h)) * HTB)
#define PG8_SB(b, h) ((4 + (b) * 2 + (h)) * HTB)
#define PG8_SBR(b, h) (((b) * 2 + (h)) * HTB)
#define PG8_STAGE(bufoff, goff, voff) do { _Pragma("unroll") for (int _i = 0; _i < 2; ++_i) \
        __builtin_amdgcn_raw_ptr_buffer_load_lds(rsrc_##voff, (PG8_LAS void*)(lds + (bufoff) + ldsw + _i * 8192), 16, voff, (int)((goff) + _i * p1step), 0, 0); } while (0)
#define PG8_LD16(p) (*(const PG8_LAS bf16x8*)(p))
#define PG8_LDF(dst, p) do { if constexpr (F8) dst = __builtin_shufflevector(__builtin_bit_cast(v4i_t, PG8_LD16(p)), __builtin_bit_cast(v4i_t, PG8_LD16((p) + 1024)), 0, 1, 2, 3, 4, 5, 6, 7); else { dst.k[0] = PG8_LD16(p); dst.k[1] = PG8_LD16((p) + 1024); } } while (0)
#define PG8_LDA(dst, b, h) do { _Pragma("unroll") for (int m = 0; m < 4; ++m) PG8_LDF(dst[m], lds + aoff + (PG8_SA(b, h) + m * 2048)); } while (0)
#define PG8_LDB(dst, b, h) do { _Pragma("unroll") for (int n = 0; n < 2; ++n) PG8_LDF(dst[n], lds + boff + (PG8_SBR(b, h) + n * 2048)); } while (0)
#define PG8_MMA(ai, bj, At, Bt) do { __builtin_amdgcn_s_setprio(1); _Pragma("unroll") for (int m = 0; m < 4; ++m) _Pragma("unroll") for (int n = 0; n < 2; ++n) { \
        if constexpr (F8) acc[ai][bj][m][n] = __builtin_amdgcn_mfma_scale_f32_16x16x128_f8f6f4(Bt[n], At[m], acc[ai][bj][m][n], 0, 0, 0, 0, 0, 0); \
        else { _Pragma("unroll") for (int k = 0; k < 2; ++k) acc[ai][bj][m][n] = __builtin_amdgcn_mfma_f32_16x16x32_bf16(Bt[n].k[k], At[m].k[k], acc[ai][bj][m][n], 0, 0, 0); } } __builtin_amdgcn_s_setprio(0); } while (0)
#define PG8_WAIT_V(n) asm volatile("s_waitcnt vmcnt(" #n ")" ::: "memory")
#define PG8_WAIT_VN(n) asm volatile("s_waitcnt vmcnt(%0)" :: "n"(n) : "memory")
#define PG8_EPI_HALF(AI, un) do { if constexpr (SPLIT) { int z_e; asm volatile("s_mov_b32 %0, 0" : "=s"(z_e)); const int lane_e = (int)__builtin_amdgcn_mbcnt_hi(~0u, __builtin_amdgcn_mbcnt_lo(~0u, (unsigned)z_e)); \
        E.template half<AI>(acc, un, wr, wc, lane_e & 15, lane_e >> 4); \
        _Pragma("unroll") for (int b_ = 0; b_ < 2; ++b_) _Pragma("unroll") for (int m_ = 0; m_ < 4; ++m_) _Pragma("unroll") for (int n_ = 0; n_ < 2; ++n_) acc[AI][b_][m_][n_] = (f32x4){0.f, 0.f, 0.f, 0.f}; } } while (0)
#define PG8_WAIT_L(n) asm volatile("s_waitcnt lgkmcnt(" #n ")" ::: "memory")
#define PG8_BAR __builtin_amdgcn_s_barrier()
#define PG8_SCHED __builtin_amdgcn_sched_barrier(0)
    constexpr bool SPLIT = SP2 && !Epi::AFTER_DRAIN && (epi_split<Epi>::nst >= 0); constexpr int NST = SPLIT ? epi_split<Epi>::nst : 0;
    Unit cur, nxt, prv; int ui = 0;
    if (!S.next(0, cur)) return;
    prv = cur;
    f32x4 acc[2][2][4][2];
#pragma unroll
    for (int a = 0; a < 2; ++a)
#pragma unroll
        for (int b = 0; b < 2; ++b)
#pragma unroll
            for (int m = 0; m < 4; ++m)
#pragma unroll
                for (int n = 0; n < 2; ++n) acc[a][b][m][n] = (f32x4){0.f, 0.f, 0.f, 0.f};
    typedef typename FragT<F8>::type frag_t; frag_t At[4], B0[2], B1[2];
    unsigned cA = (unsigned)cur.pm * tstep, cB = (unsigned)cur.pn * tstep;
    const __amdgpu_buffer_rsrc_t rsrc_voffA = __builtin_amdgcn_make_buffer_rsrc((void*)g.A, 0, 0x7fffffff, 0x00020000), rsrc_voffB = __builtin_amdgcn_make_buffer_rsrc((void*)g.Bt, 0, 0x7fffffff, 0x00020000);
    S.a_ready(cur);
    if constexpr (SP2) {
        PG8_STAGE(PG8_SB(0, 0), cB, voffB); PG8_STAGE(PG8_SB(0, 1), cB + hstep, voffB); PG8_STAGE(PG8_SA(0, 0), cA, voffA); PG8_STAGE(PG8_SA(0, 1), cA + hstep, voffA);
        if (wr == 1) PG8_BAR;
        PG8_WAIT_V(2); PG8_BAR;
        PG8_STAGE(PG8_SB(1, 0), cB + kstep, voffB); PG8_STAGE(PG8_SA(1, 0), cA + kstep, voffA); PG8_STAGE(PG8_SB(1, 1), cB + hstep + kstep, voffB);
        PG8_WAIT_V(6); PG8_BAR;
    } else {
        PG8_STAGE(PG8_SB(0, 0), cB, voffB); PG8_STAGE(PG8_SA(0, 0), cA, voffA); PG8_STAGE(PG8_SB(0, 1), cB + hstep, voffB); PG8_STAGE(PG8_SA(0, 1), cA + hstep, voffA);
        if (wr == 1) PG8_BAR;
        PG8_WAIT_V(4); PG8_BAR;
        PG8_STAGE(PG8_SB(1, 0), cB + kstep, voffB); PG8_STAGE(PG8_SA(1, 0), cA + kstep, voffA); PG8_STAGE(PG8_SB(1, 1), cB + hstep + kstep, voffB);
        PG8_WAIT_V(6); PG8_BAR;
    }
    for (;;) {
        const bool has_next = S.next(ui + 1, nxt);
        const unsigned nA = has_next ? (unsigned)nxt.pm * tstep : cA, nB = has_next ? (unsigned)nxt.pn * tstep : cB;
#pragma nounroll
        for (int t = 0; t < nt; t += 2) {
            const bool last = (t == nt - 2);
            const unsigned a1 = cA + (unsigned)(t + 1) * kstep;
            const unsigned a2 = last ? nA : cA + (unsigned)(t + 2) * kstep, b2 = last ? nB : cB + (unsigned)(t + 2) * kstep;
            const unsigned a3 = a2 + kstep, b3 = b2 + kstep;
            if (last && has_next) S.a_ready(nxt);
            if constexpr (SP2) {
            if (SPLIT && t == 0 && ui > 0) {
                PG8_STAGE(PG8_SA(1, 1), a1 + hstep, voffA); PG8_SCHED;
                PG8_EPI_HALF(1, prv); PG8_SCHED;
                PG8_LDB(B0, 0, 0); PG8_LDB(B1, 0, 1); PG8_SCHED; PG8_LDA(At, 0, 0);
                PG8_WAIT_VN(8 + NST); PG8_WAIT_L(0); PG8_BAR;
            } else {
            PG8_LDB(B0, 0, 0); PG8_LDB(B1, 0, 1); PG8_SCHED; PG8_LDA(At, 0, 0); PG8_STAGE(PG8_SA(1, 1), a1 + hstep, voffA);
            PG8_WAIT_V(8); PG8_WAIT_L(0); PG8_BAR; }
            PG8_MMA(0, 0, At, B0); PG8_MMA(0, 1, At, B1); PG8_BAR; PG8_SCHED;
            PG8_LDA(At, 0, 1); PG8_STAGE(PG8_SB(0, 0), b2, voffB); PG8_STAGE(PG8_SB(0, 1), b2 + hstep, voffB); PG8_STAGE(PG8_SA(0, 0), a2, voffA);
            PG8_WAIT_V(8); PG8_WAIT_L(0); PG8_BAR; PG8_MMA(1, 0, At, B0); PG8_MMA(1, 1, At, B1); PG8_BAR; PG8_SCHED;
            PG8_LDB(B0, 1, 0); PG8_LDB(B1, 1, 1); PG8_SCHED; PG8_LDA(At, 1, 0); PG8_STAGE(PG8_SA(0, 1), a2 + hstep, voffA);
            PG8_WAIT_V(8); PG8_WAIT_L(0); PG8_BAR; PG8_MMA(0, 0, At, B0); PG8_MMA(0, 1, At, B1); PG8_BAR; PG8_SCHED;
            if (SPLIT && last) {
                PG8_STAGE(PG8_SB(1, 0), b3, voffB); PG8_STAGE(PG8_SB(1, 1), b3 + hstep, voffB); PG8_STAGE(PG8_SA(1, 0), a3, voffA); PG8_SCHED;
                PG8_EPI_HALF(0, cur); PG8_SCHED;
                PG8_LDA(At, 1, 1);
                PG8_WAIT_VN(8 + NST); PG8_WAIT_L(0); PG8_BAR;
            } else {
            PG8_LDA(At, 1, 1); PG8_STAGE(PG8_SB(1, 0), b3, voffB); PG8_STAGE(PG8_SB(1, 1), b3 + hstep, voffB); PG8_STAGE(PG8_SA(1, 0), a3, voffA);
            PG8_WAIT_V(8); PG8_WAIT_L(0); PG8_BAR; }
            PG8_MMA(1, 0, At, B0); PG8_MMA(1, 1, At, B1); PG8_BAR; PG8_SCHED;
            } else {
            PG8_LDB(B0, 0, 0); PG8_SCHED; PG8_LDA(At, 0, 0); PG8_STAGE(PG8_SA(1, 1), a1 + hstep, voffA);
            PG8_WAIT_L(8); PG8_BAR; PG8_WAIT_L(0); PG8_MMA(0, 0, At, B0); PG8_BAR; PG8_SCHED;
            PG8_LDB(B1, 0, 1); PG8_STAGE(PG8_SB(0, 0), b2, voffB);
            PG8_BAR; PG8_WAIT_L(0); PG8_MMA(0, 1, At, B1); PG8_BAR;
            PG8_LDA(At, 0, 1); PG8_STAGE(PG8_SA(0, 0), a2, voffA);
            PG8_BAR; PG8_WAIT_L(0); PG8_MMA(1, 0, At, B0); PG8_BAR; PG8_SCHED;
            PG8_STAGE(PG8_SB(0, 1), b2 + hstep, voffB);
            PG8_WAIT_V(6); PG8_BAR; PG8_MMA(1, 1, At, B1); PG8_BAR;
            PG8_LDB(B0, 1, 0); PG8_SCHED; PG8_LDA(At, 1, 0); PG8_STAGE(PG8_SA(0, 1), a2 + hstep, voffA);
            PG8_WAIT_L(8); PG8_BAR; PG8_WAIT_L(0); PG8_MMA(0, 0, At, B0); PG8_BAR; PG8_SCHED;
            PG8_LDB(B1, 1, 1); PG8_STAGE(PG8_SB(1, 0), b3, voffB);
            PG8_BAR; PG8_WAIT_L(0); PG8_MMA(0, 1, At, B1); PG8_BAR;
            PG8_LDA(At, 1, 1); PG8_STAGE(PG8_SA(1, 0), a3, voffA);
            PG8_BAR; PG8_WAIT_L(0); PG8_MMA(1, 0, At, B0); PG8_BAR; PG8_SCHED;
            PG8_STAGE(PG8_SB(1, 1), b3 + hstep, voffB);
            PG8_WAIT_V(6); PG8_BAR; PG8_MMA(1, 1, At, B1); PG8_BAR;
            }
        }
        if constexpr (SPLIT) {
            S.done(cur); prv = cur;
            if (!has_next) { PG8_EPI_HALF(1, cur); break; }
            cur = nxt; cA = nA; cB = nB; ++ui; continue;
        }
        if constexpr (ALIGN_EPI) { if (wr == 0) PG8_BAR; }
        if constexpr (!Epi::AFTER_DRAIN) { int z_e; asm volatile("s_mov_b32 %0, 0" : "=s"(z_e)); const int lane_e = (int)__builtin_amdgcn_mbcnt_hi(~0u, __builtin_amdgcn_mbcnt_lo(~0u, (unsigned)z_e)); const int fr_e = lane_e & 15, fq_e = lane_e >> 4;
#if PROBE_UDUP >= 0 && defined(PROBE_NOEPI)
            if (!cur.dup)
#endif
            E(acc, cur, wr, wc, fr_e, fq_e); S.done(cur); }
        if (!has_next) break;
#pragma unroll
        for (int a = 0; a < 2; ++a)
#pragma unroll
            for (int b = 0; b < 2; ++b)
#pragma unroll
                for (int m = 0; m < 4; ++m)
#pragma unroll
                    for (int n = 0; n < 2; ++n) acc[a][b][m][n] = (f32x4){0.f, 0.f, 0.f, 0.f};
        cur = nxt; cA = nA; cB = nB; ++ui;
        if constexpr (ALIGN_EPI) { if (wr == 1) PG8_BAR; }
    }
    PG8_WAIT_V(0);
    if constexpr (!ALIGN_EPI || SPLIT) { if (wr == 0) PG8_BAR; }
    PG8_BAR;
    if constexpr (Epi::AFTER_DRAIN) { E.fused(acc, cur, wr, wc, fr, fq, lds, wid, lane); S.done(cur); }
#undef PG8_SA
#undef PG8_SB
#undef PG8_SBR
#undef PG8_STAGE
#undef PG8_LDA
#undef PG8_LDB
#undef PG8_MMA
#undef PG8_LDF
#undef PG8_LD16
#undef PG8_WAIT_V
#undef PG8_WAIT_L
#undef PG8_WAIT_VN
#undef PG8_EPI_HALF
#undef PG8_BAR
#undef PG8_SCHED
}
}
constexpr int D = 1024, NB = 16, SEQ = 2048, CTXL = 256, RB = SEQ + CTXL  , M_ALL = NB * RB  ;
constexpr int FF = 3584, NE = 8;
constexpr int EV_IN = 1792, EV_P = 1280;
constexpr int OD_IN = 3072;
constexpr int OP_P = 2048;
constexpr int MAX_SLOT_TILES = 304, MAX_SLOTS = MAX_SLOT_TILES * 256;
#ifndef DIFF_V128
#define DIFF_V128 1
#endif
#ifndef FFN_FP8
#define FFN_FP8 14
#endif
#ifndef FFN_FP8_DN
#define FFN_FP8_DN FFN_FP8
#endif
constexpr int F8_MASK = FFN_FP8, F8D_MASK = FFN_FP8_DN;
constexpr float LOG2E = 1.4426950408889634f;
constexpr float QSCALE = 0.125f * LOG2E;

__device__ __forceinline__ float fast_sigmoid(float x) { return __builtin_amdgcn_rcpf(1.f + __builtin_amdgcn_exp2f(-x * LOG2E)); }
__device__ __forceinline__ float fast_silu(float x) { return x * fast_sigmoid(x); }
__device__ __forceinline__ unsigned pk4_fp8(float a, float b, float c, float d) { int w = __builtin_amdgcn_cvt_pk_fp8_f32(a, b, 0, false); w = __builtin_amdgcn_cvt_pk_fp8_f32(c, d, w, true); return (unsigned)w; }

namespace pg8 {
struct EpiStoreBf16 {
    static constexpr bool PERM = true, AFTER_DRAIN = false;
    bf16_t* O; int ldc; int coloff;
    __device__ __forceinline__ void operator()(const f32x4 (&acc)[2][2][4][2], const Unit& u, int wr, int wc, int fr, int fq) const {
        const int row0 = u.pm * BM + wr * 64 + fr, col0 = coloff + u.pn * BM + wc * 32 + 8 * fq;
#pragma unroll
        for (int ai = 0; ai < 2; ++ai)
#pragma unroll
            for (int m = 0; m < 4; ++m) { bf16_t* rowp = O + (size_t)(row0 + ai * HALF + m * 16) * ldc + col0;
#pragma unroll
                for (int bj = 0; bj < 2; ++bj) { const f32x4 v0 = acc[ai][bj][m][0], v1 = acc[ai][bj][m][1];
                    u32x4 w; w.x = cvt_pk_bf16(v0[0], v0[1]); w.y = cvt_pk_bf16(v0[2], v0[3]); w.z = cvt_pk_bf16(v1[0], v1[1]); w.w = cvt_pk_bf16(v1[2], v1[3]);
                    *(u32x4*)(rowp + bj * HALF) = w; } }
    }
};
struct EpiEvenIn {
    static constexpr bool PERM = true, AFTER_DRAIN = false;
    bf16_t* EV;
    __device__ __forceinline__ void operator()(const f32x4 (&acc)[2][2][4][2], const Unit& u, int wr, int wc, int fr, int fq) const {
        const int row0 = u.pm * BM + wr * 64 + fr;
        if (u.pn < 4) {
            const int col0 = u.pn * HALF + wc * 32 + 8 * fq;
#pragma unroll
            for (int ai = 0; ai < 2; ++ai)
#pragma unroll
                for (int m = 0; m < 4; ++m) { bf16_t* rowp = EV + (size_t)(row0 + ai * HALF + m * 16) * EV_P + col0;
                    const f32x4 a0 = acc[ai][0][m][0], a1 = acc[ai][0][m][1], g0 = acc[ai][1][m][0], g1 = acc[ai][1][m][1];
                    u32x4 w; w.x = cvt_pk_bf16(a0[0] * fast_sigmoid(g0[0]), a0[1] * fast_sigmoid(g0[1])); w.y = cvt_pk_bf16(a0[2] * fast_sigmoid(g0[2]), a0[3] * fast_sigmoid(g0[3]));
                    w.z = cvt_pk_bf16(a1[0] * fast_sigmoid(g1[0]), a1[1] * fast_sigmoid(g1[1])); w.w = cvt_pk_bf16(a1[2] * fast_sigmoid(g1[2]), a1[3] * fast_sigmoid(g1[3]));
                    *(u32x4*)rowp = w; }
        } else {
            const int col0 = 512 + (u.pn - 4) * BM + wc * 32 + 8 * fq;
#pragma unroll
            for (int ai = 0; ai < 2; ++ai)
#pragma unroll
                for (int m = 0; m < 4; ++m) { bf16_t* rowp = EV + (size_t)(row0 + ai * HALF + m * 16) * EV_P + col0;
#pragma unroll
                    for (int bj = 0; bj < 2; ++bj) { const f32x4 v0 = acc[ai][bj][m][0], v1 = acc[ai][bj][m][1];
                        u32x4 w; w.x = cvt_pk_bf16(v0[0], v0[1]); w.y = cvt_pk_bf16(v0[2], v0[3]); w.z = cvt_pk_bf16(v1[0], v1[1]); w.w = cvt_pk_bf16(v1[2], v1[3]);
                        *(u32x4*)(rowp + bj * HALF) = w; } }
        }
    }
};
__device__ __forceinline__ void st16_swap(bf16_t* p, const unsigned __attribute__((ext_vector_type(2))) w1, const unsigned __attribute__((ext_vector_type(2))) w2) {
    const auto sx = __builtin_amdgcn_permlane16_swap(w1.x, w2.x, false, false), sy = __builtin_amdgcn_permlane16_swap(w1.y, w2.y, false, false);
    u32x4 w; w.x = sx[0]; w.y = sy[0]; w.z = sx[1]; w.w = sy[1]; *(u32x4*)p = w;
}
struct EpiOddIn {
    static constexpr bool PERM = false, AFTER_DRAIN = false;
    bf16_t* QKV; const float* cosT; float asc;
    __device__ __forceinline__ void operator()(const f32x4 (&acc)[2][2][4][2], const Unit& u, int wr, int wc, int fr, int fq) const {
        typedef unsigned u32x2 __attribute__((ext_vector_type(2)));
        const int b = u.pm / 9, jt = u.pm - 9 * b, kind = u.pn >> 2; const bool rope = (jt < 8) && (kind < 2); const float sc = ((kind == 0) ? QSCALE : 1.f) * asc;
        const float* sinT = cosT + 1024; const int col0 = u.pn * BM + wc * 32 + (fq & 1) * 16 + (fq >> 1) * 8;
        if (rope) {
            f32x4 cs[2][4], sn[2][4];
#pragma unroll
            for (int ai = 0; ai < 2; ++ai)
#pragma unroll
                for (int m = 0; m < 4; ++m) { const int t = jt * BM + ai * HALF + wr * 64 + m * 16 + fr; const int pv = (wc & 1) ? (t & 63) : (t >> 6);
                    cs[ai][m] = *(const f32x4*)(cosT + pv * 16 + 4 * fq) * sc; sn[ai][m] = *(const f32x4*)(sinT + pv * 16 + 4 * fq) * sc; }
#pragma unroll
            for (int ai = 0; ai < 2; ++ai)
#pragma unroll
                for (int m = 0; m < 4; ++m) { const int rowt = ai * HALF + wr * 64 + m * 16 + fr; bf16_t* rowp = QKV + (size_t)(u.pm * BM + rowt) * OD_IN + col0;
#pragma unroll
                    for (int bj = 0; bj < 2; ++bj) { const f32x4 x1 = acc[ai][bj][m][0], x2 = acc[ai][bj][m][1]; const f32x4 y1 = x1 * cs[ai][m] - x2 * sn[ai][m], y2 = x2 * cs[ai][m] + x1 * sn[ai][m];
                        u32x2 w1, w2; w1.x = cvt_pk_bf16(y1[0], y1[1]); w1.y = cvt_pk_bf16(y1[2], y1[3]); w2.x = cvt_pk_bf16(y2[0], y2[1]); w2.y = cvt_pk_bf16(y2[2], y2[3]);
                        st16_swap(rowp + bj * HALF, w1, w2); } }
        } else {
#pragma unroll
            for (int ai = 0; ai < 2; ++ai)
#pragma unroll
                for (int m = 0; m < 4; ++m) { const int rowt = ai * HALF + wr * 64 + m * 16 + fr; bf16_t* rowp = QKV + (size_t)(u.pm * BM + rowt) * OD_IN + col0;
#pragma unroll
                    for (int bj = 0; bj < 2; ++bj) { const f32x4 y1 = acc[ai][bj][m][0] * sc, y2 = acc[ai][bj][m][1] * sc;
                        u32x2 w1, w2; w1.x = cvt_pk_bf16(y1[0], y1[1]); w1.y = cvt_pk_bf16(y1[2], y1[3]); w2.x = cvt_pk_bf16(y2[0], y2[1]); w2.y = cvt_pk_bf16(y2[2], y2[3]);
                        st16_swap(rowp + bj * HALF, w1, w2); } }
        }
    }
};
struct EpiEvenIn2 {
    static constexpr bool PERM = false, AFTER_DRAIN = false;
    bf16_t* EV; const float* cosT; const float* qg; const float* kg; PG8_LAS float* SS; float asc;
    __device__ __forceinline__ void operator()(const f32x4 (&acc)[2][2][4][2], const Unit& u, int wr, int wc, int fr, int fq) const {
        typedef unsigned u32x2 __attribute__((ext_vector_type(2)));
        if (u.pn < 4) {
            const int col0 = u.pn * HALF + wc * 32 + (fq & 1) * 16 + (fq >> 1) * 8;
            const float ne = -asc * LOG2E;
#pragma unroll
            for (int ai = 0; ai < 2; ++ai)
#pragma unroll
                for (int m = 0; m < 4; ++m) { bf16_t* rowp = EV + (size_t)(u.pm * BM + ai * HALF + wr * 64 + m * 16 + fr) * EV_P + col0;
                    u32x2 w[2];
#pragma unroll
                    for (int n = 0; n < 2; ++n) { const f32x4 a = acc[ai][0][m][n], g = acc[ai][1][m][n];
                        #define GL_(a_, g_) ((a_) * asc * __builtin_amdgcn_rcpf(1.f + __builtin_amdgcn_exp2f((g_) * ne)))
                        w[n].x = cvt_pk_bf16(GL_(a[0], g[0]), GL_(a[1], g[1])); w[n].y = cvt_pk_bf16(GL_(a[2], g[2]), GL_(a[3], g[3])); }
#undef GL_
                    st16_swap(rowp, w[0], w[1]); }
            return;
        }
        const int b = u.pm / 9, jt = u.pm - 9 * b; const bool lat = jt < 8, isq = u.pn < 6;
#pragma unroll
        for (int ai = 0; ai < 2; ++ai)
#pragma unroll
            for (int m = 0; m < 4; ++m)
#pragma unroll
                for (int bj = 0; bj < 2; ++bj) { const f32x4 x1 = acc[ai][bj][m][0], x2 = acc[ai][bj][m][1];
                    float s = (x1[0] * x1[0] + x1[1] * x1[1]) + (x1[2] * x1[2] + x1[3] * x1[3]) + (x2[0] * x2[0] + x2[1] * x2[1]) + (x2[2] * x2[2] + x2[3] * x2[3]);
                    { const auto r_ = __builtin_amdgcn_permlane16_swap(__float_as_uint(s), __float_as_uint(s), false, false); s = __uint_as_float(r_[0]) + __uint_as_float(r_[1]); }
                    { const auto r_ = __builtin_amdgcn_permlane32_swap(__float_as_uint(s), __float_as_uint(s), false, false); s = __uint_as_float(r_[0]) + __uint_as_float(r_[1]); }
                    if (fq == 0) SS[(bj * BM + ai * HALF + wr * 64 + m * 16 + fr) * 4 + wc] = s; }
        asm volatile("s_waitcnt lgkmcnt(0)" ::: "memory"); __builtin_amdgcn_s_barrier(); asm volatile("" ::: "memory");
        const float* sinT = cosT + 1024; const int dcol = 32 * (wc & 1) + 4 * fq;
        const float* gq = isq ? qg : kg; const f32x4 g1 = *(const f32x4*)(gq + dcol), g2 = *(const f32x4*)(gq + dcol + 16);
        f32x4 csv[2][4], snv[2][4];
#pragma unroll
        for (int ai = 0; ai < 2; ++ai)
#pragma unroll
            for (int m = 0; m < 4; ++m) { const int t = jt * BM + ai * HALF + wr * 64 + m * 16 + fr; csv[ai][m] = (f32x4){1.f, 1.f, 1.f, 1.f}; snv[ai][m] = (f32x4){0.f, 0.f, 0.f, 0.f};
                if (lat) { const int pv = (wc & 1) ? (t & 63) : (t >> 6); csv[ai][m] = *(const f32x4*)(cosT + pv * 16 + 4 * fq); snv[ai][m] = *(const f32x4*)(sinT + pv * 16 + 4 * fq); } }
#pragma unroll
        for (int ai = 0; ai < 2; ++ai)
#pragma unroll
            for (int m = 0; m < 4; ++m) { const int rowt = ai * HALF + wr * 64 + m * 16 + fr; bf16_t* rowp = EV + (size_t)(u.pm * BM + rowt) * EV_P + 512 + (u.pn - 4) * BM + wc * 32 + (fq & 1) * 16 + (fq >> 1) * 8;
                const f32x4 cs = csv[ai][m], sn = snv[ai][m];
#pragma unroll
                for (int bj = 0; bj < 2; ++bj) { f32x4 y1 = acc[ai][bj][m][0], y2 = acc[ai][bj][m][1];
                    if (isq || bj == 0) { const PG8_LAS float* sp = SS + (bj * BM + rowt) * 4 + (wc & 2); const float rs = asc / sqrtf((sp[0] + sp[1]) * (asc * asc * (1.f / 64.f)) + 1e-6f);
                        const f32x4 x1 = y1 * rs * g1, x2 = y2 * rs * g2; const float sc = isq ? QSCALE : 1.f; y1 = (x1 * cs - x2 * sn) * sc; y2 = (x2 * cs + x1 * sn) * sc; }
                    else { y1 = y1 * asc; y2 = y2 * asc; }
                    u32x2 w1, w2; w1.x = cvt_pk_bf16(y1[0], y1[1]); w1.y = cvt_pk_bf16(y1[2], y1[3]); w2.x = cvt_pk_bf16(y2[0], y2[1]); w2.y = cvt_pk_bf16(y2[2], y2[3]);
                    st16_swap(rowp + bj * HALF, w1, w2); } }
    }
};
struct EpiSwiGLU {
    static constexpr bool PERM = true, AFTER_DRAIN = false;
    bf16_t* ACT; int npl; float isc;
    __device__ __forceinline__ void operator()(const f32x4 (&acc)[2][2][4][2], const Unit& u, int wr, int wc, int fr, int fq) const {
        const int row0 = u.pm * BM + wr * 64 + fr, col0 = (u.pn % npl) * HALF + wc * 32 + 8 * fq;
#pragma unroll
        for (int ai = 0; ai < 2; ++ai)
#pragma unroll
            for (int m = 0; m < 4; ++m) { bf16_t* rowp = ACT + (size_t)(row0 + ai * HALF + m * 16) * FF + col0;
                const f32x4 g0 = acc[ai][0][m][0] * isc, g1 = acc[ai][0][m][1] * isc, u0 = acc[ai][1][m][0] * isc, u1 = acc[ai][1][m][1] * isc;
                u32x4 w; w.x = cvt_pk_bf16(fast_silu(g0[0]) * u0[0], fast_silu(g0[1]) * u0[1]); w.y = cvt_pk_bf16(fast_silu(g0[2]) * u0[2], fast_silu(g0[3]) * u0[3]);
                w.z = cvt_pk_bf16(fast_silu(g1[0]) * u1[0], fast_silu(g1[1]) * u1[1]); w.w = cvt_pk_bf16(fast_silu(g1[2]) * u1[2], fast_silu(g1[3]) * u1[3]);
                *(u32x4*)rowp = w; }
    }
};
struct EpiSwiGLU8 {
    static constexpr bool PERM = true, AFTER_DRAIN = false;
    unsigned char* ACT; int npl; float isc;
    template <int AI> __device__ __forceinline__ void half(const f32x4 (&acc)[2][2][4][2], const Unit& u, int wr, int wc, int fr, int fq) const {
        typedef unsigned u32x2 __attribute__((ext_vector_type(2)));
        const int row0 = u.pm * BM + wr * 64 + fr, col0 = (u.pn % npl) * HALF + wc * 32 + 8 * fq;
        const float ne = -isc * LOG2E, rs = 1.f / (isc * isc);
#pragma unroll
        for (int m = 0; m < 4; ++m) { unsigned char* rowp = ACT + (size_t)(row0 + AI * HALF + m * 16) * FF + col0;
            const f32x4 g0 = acc[AI][0][m][0], g1 = acc[AI][0][m][1], u0 = acc[AI][1][m][0], u1 = acc[AI][1][m][1];
#define SG_(g, u) ((g) * (u) * __builtin_amdgcn_rcpf(__builtin_fmaf(__builtin_amdgcn_exp2f((g) * ne), rs, rs)))
            u32x2 w; w.x = pk4_fp8(SG_(g0[0], u0[0]), SG_(g0[1], u0[1]), SG_(g0[2], u0[2]), SG_(g0[3], u0[3]));
            w.y = pk4_fp8(SG_(g1[0], u1[0]), SG_(g1[1], u1[1]), SG_(g1[2], u1[2]), SG_(g1[3], u1[3]));
#undef SG_
            *(u32x2*)rowp = w; }
    }
    __device__ __forceinline__ void operator()(const f32x4 (&acc)[2][2][4][2], const Unit& u, int wr, int wc, int fr, int fq) const { half<0>(acc, u, wr, wc, fr, fq); half<1>(acc, u, wr, wc, fr, fq); }
};
struct EpiResid {
    static constexpr bool PERM = false, AFTER_DRAIN = false;
    float* out; float* xc; const float* gate; float asc; const float* lsrc;
    __device__ __forceinline__ void operator()(const f32x4 (&acc)[2][2][4][2], const Unit& u, int wr, int wc, int fr, int fq) const {
        const int b = u.pm / 9, j = u.pm - b * 9;
        float* base = (j < 8) ? out + (size_t)(b * SEQ + j * BM) * D : xc + (size_t)(b * CTXL) * D;
        const float* sbase = (j < 8) ? lsrc + (size_t)(b * SEQ + j * BM) * D : base;
        const float* gp = gate + (size_t)((j < 8) ? b : NB) * 6144;
        const int col0 = u.pn * BM + wc * 32 + 4 * fq;
        f32x4 gv[2][2];
#pragma unroll
        for (int bj = 0; bj < 2; ++bj)
#pragma unroll
            for (int n = 0; n < 2; ++n) gv[bj][n] = *(const f32x4*)(gp + col0 + bj * HALF + n * 16) * asc;
        const size_t rb = (size_t)(wr * 64 + fr) * D + col0;
        f32x4 x0[4][2][2], x1[4][2][2];
#pragma unroll
        for (int m = 0; m < 4; ++m)
#pragma unroll
            for (int bj = 0; bj < 2; ++bj)
#pragma unroll
                for (int n = 0; n < 2; ++n) x0[m][bj][n] = *(const f32x4*)(sbase + rb + (size_t)(m * 16) * D + bj * HALF + n * 16);
#pragma unroll
        for (int m = 0; m < 4; ++m)
#pragma unroll
            for (int bj = 0; bj < 2; ++bj)
#pragma unroll
                for (int n = 0; n < 2; ++n) x0[m][bj][n] += gv[bj][n] * acc[0][bj][m][n];
#pragma unroll
        for (int m = 0; m < 4; ++m)
#pragma unroll
            for (int bj = 0; bj < 2; ++bj)
#pragma unroll
                for (int n = 0; n < 2; ++n) x1[m][bj][n] = *(const f32x4*)(sbase + rb + (size_t)(HALF + m * 16) * D + bj * HALF + n * 16);
#pragma unroll
        for (int m = 0; m < 4; ++m)
#pragma unroll
            for (int bj = 0; bj < 2; ++bj)
#pragma unroll
                for (int n = 0; n < 2; ++n) *(f32x4*)(base + rb + (size_t)(m * 16) * D + bj * HALF + n * 16) = x0[m][bj][n];
#pragma unroll
        for (int m = 0; m < 4; ++m)
#pragma unroll
            for (int bj = 0; bj < 2; ++bj)
#pragma unroll
                for (int n = 0; n < 2; ++n) *(f32x4*)(base + rb + (size_t)(HALF + m * 16) * D + bj * HALF + n * 16) = x1[m][bj][n] + gv[bj][n] * acc[1][bj][m][n];
    }
};
struct EpiMoeY {
    static constexpr bool PERM = true, AFTER_DRAIN = false;
    bf16_t* Y; float asc;
    __device__ __forceinline__ void operator()(const f32x4 (&acc)[2][2][4][2], const Unit& u, int wr, int wc, int fr, int fq) const {
        const int row0 = u.pm * BM + wr * 64 + fr, col0 = (u.pn & 3) * BM + wc * 32 + 8 * fq;
#pragma unroll
        for (int ai = 0; ai < 2; ++ai)
#pragma unroll
            for (int m = 0; m < 4; ++m) { bf16_t* rowp = Y + (size_t)(row0 + ai * HALF + m * 16) * D + col0;
#pragma unroll
                for (int bj = 0; bj < 2; ++bj) { const f32x4 v0 = acc[ai][bj][m][0] * asc, v1 = acc[ai][bj][m][1] * asc;
                    u32x4 w; w.x = cvt_pk_bf16(v0[0], v0[1]); w.y = cvt_pk_bf16(v0[2], v0[3]); w.z = cvt_pk_bf16(v1[0], v1[1]); w.w = cvt_pk_bf16(v1[2], v1[3]);
                    *(u32x4*)(rowp + bj * HALF) = w; } }
    }
};
struct EpiResidMoe {
    static constexpr bool PERM = false, AFTER_DRAIN = false;
    float* out; float* xc; const float* gate; const int* slot_tok; const float* slot_w; float asc;
    __device__ __forceinline__ void operator()(const f32x4 (&acc)[2][2][4][2], const Unit& u, int wr, int wc, int fr, int fq) const {
        const int col0 = (u.pn & 3) * BM + wc * 32 + 4 * fq;
#pragma unroll
        for (int ai = 0; ai < 2; ++ai)
#pragma unroll
            for (int m = 0; m < 4; ++m) { const int slot = u.pm * BM + ai * HALF + wr * 64 + m * 16 + fr; const int tok = slot_tok[slot];
                if (tok >= 0) { const float w = slot_w[slot] * asc; const int b = tok / RB, t = tok - b * RB;
                    float* rowp = ((t < SEQ) ? out + (size_t)(b * SEQ + t) * D : xc + (size_t)(b * CTXL + t - SEQ) * D) + col0;
                    const float* gp = gate + (size_t)((t < SEQ) ? b : NB) * 6144 + col0;
#pragma unroll
                    for (int bj = 0; bj < 2; ++bj)
#pragma unroll
                        for (int n = 0; n < 2; ++n) { float* p = rowp + bj * HALF + n * 16; const f32x4 g = *(const f32x4*)(gp + bj * HALF + n * 16); const f32x4 v = (g * w) * acc[ai][bj][m][n];
                            *(f32x4*)p = *(f32x4*)p + v; } } }
    }
};
struct MapOrder {
    StaticOrder so; int mode; int tlo; int npl; const PG8_LAS int* tab;
    __device__ __forceinline__ void init(int nM, int nN, int G, int c, int mode_, int   = 0, int   = 1, int tlo_ = 0, int npl_ = 0, const PG8_LAS int* tab_ = nullptr) { so.init(nM * BM, nN * BM, G, c); mode = mode_; tlo = tlo_; npl = npl_; tab = tab_; }
    __device__ __forceinline__ bool next(int i, Unit& u) const {
        if (!so.next(i, u)) return false;
        if (mode == 1) u.pm = (u.pm >> 3) * 9 + (u.pm & 7);
        else if (mode == 2) { u.pm += tlo; const int e = __builtin_amdgcn_readfirstlane(tab[u.pm]); u.pn += e * npl; }
        return true;
    }
    __device__ __forceinline__ void a_ready(const Unit&) const {}
    __device__ __forceinline__ void done(const Unit&) const {}
};
}
namespace attn_body {
using bf16=__hip_bfloat16;
using bf16x8=__attribute__((ext_vector_type(8)))short;
using s16x4=__attribute__((ext_vector_type(4)))short;
using f32x16=__attribute__((ext_vector_type(16)))float;
using u32x4=__attribute__((ext_vector_type(4)))unsigned;
constexpr int D=64;
constexpr int NW=8,QBLK=32,QB=QBLK*NW,KVBLK=64;
constexpr int ATTN_UNIT_ROWS=QB;
__device__ __forceinline__ int crow(int r,int hi){return (r&3)+8*(r>>2)+4*hi;}
#define SBAR() __builtin_amdgcn_sched_barrier(0)
constexpr int NSLOT=3, SLOTB=8192;
constexpr int LDS_K=0, LDS_V=NSLOT*SLOTB, LDS_WS=2*NSLOT*SLOTB, LDS_OST=LDS_WS+NW*64*4, LDS_BYTES=LDS_OST+NW*4096;
constexpr float C2=0.125f*1.4426950408889634f;
__device__ __forceinline__ void glds16(const void*gsrc,unsigned lds_dst){unsigned keep;
  asm volatile("s_mov_b32 %0, m0\n\ts_mov_b32 m0, %2\n\ts_nop 0\n\tglobal_load_lds_dwordx4 %1, off\n\ts_mov_b32 m0, %0":"=&s"(keep):"v"(gsrc),"s"(lds_dst):"memory");}
__device__ __forceinline__ float max3f(float a,float b,float c){float r;asm("v_max3_f32 %0, %1, %2, %3":"=v"(r):"v"(a),"v"(b),"v"(c));return r;}
__device__ __forceinline__ float max2f(float a,float b){float r;asm("v_max_f32_e32 %0, %1, %2":"=v"(r):"v"(a),"v"(b));return r;}
__device__ __forceinline__ float fadd_s(float a,float b){float r;asm("v_add_f32_e32 %0, %1, %2":"=v"(r):"v"(a),"v"(b));return r;}
__device__ __forceinline__ float fsub_s(float a,float b){float r;asm("v_sub_f32_e32 %0, %1, %2":"=v"(r):"v"(a),"v"(b));return r;}
typedef float f32x2_t __attribute__((ext_vector_type(2))); typedef __bf16 bf16x2_t __attribute__((ext_vector_type(2)));
__device__ __forceinline__ unsigned cvtpk_s(float lo,float hi){f32x2_t v={lo,hi};bf16x2_t b=__builtin_convertvector(v,bf16x2_t);return __builtin_bit_cast(unsigned,b);}
#define WAIT_BAR(N) asm volatile("s_waitcnt vmcnt(" #N ") lgkmcnt(0)\n\ts_barrier":::"memory")

__device__ __forceinline__ void qkt(f32x16&p0,f32x16&p1,const char*Kslot,const bf16x8*qr,const f32x16&negm,int r32,int hi){
  const char*kb=Kslot+hi*1024+r32*16;
  #pragma unroll
  for(int d0=0;d0<4;++d0){
    const bf16x8 b0=*reinterpret_cast<const bf16x8*>(kb+d0*2048);
    const bf16x8 b1=*reinterpret_cast<const bf16x8*>(kb+d0*2048+512);
    if(d0==0){p0=__builtin_amdgcn_mfma_f32_32x32x16_bf16(b0,qr[0],negm,0,0,0);p1=__builtin_amdgcn_mfma_f32_32x32x16_bf16(b1,qr[0],negm,0,0,0);}
    else{p0=__builtin_amdgcn_mfma_f32_32x32x16_bf16(b0,qr[d0],p0,0,0,0);p1=__builtin_amdgcn_mfma_f32_32x32x16_bf16(b1,qr[d0],p1,0,0,0);}}
}
typedef __attribute__((address_space(3))) const char* lds_cptr;
typedef short v4i16_t __attribute__((ext_vector_type(4)));
__device__ __forceinline__ void kload8(bf16x8*kf,lds_cptr kp){
  kf[0]=*(const __attribute__((address_space(3))) bf16x8*)(kp);      kf[1]=*(const __attribute__((address_space(3))) bf16x8*)(kp+512);
  kf[2]=*(const __attribute__((address_space(3))) bf16x8*)(kp+2048); kf[3]=*(const __attribute__((address_space(3))) bf16x8*)(kp+2560);
  kf[4]=*(const __attribute__((address_space(3))) bf16x8*)(kp+4096); kf[5]=*(const __attribute__((address_space(3))) bf16x8*)(kp+4608);
  kf[6]=*(const __attribute__((address_space(3))) bf16x8*)(kp+6144); kf[7]=*(const __attribute__((address_space(3))) bf16x8*)(kp+6656);
}
__device__ __forceinline__ void kload2(bf16x8*kf,lds_cptr kp,int j){ kf[2*j]=*(const __attribute__((address_space(3))) bf16x8*)(kp+j*2048); kf[2*j+1]=*(const __attribute__((address_space(3))) bf16x8*)(kp+j*2048+512); }
__device__ __forceinline__ s16x4 vtr(lds_cptr p){ return __builtin_bit_cast(s16x4,__builtin_amdgcn_ds_read_tr16_b64_v4i16((__attribute__((address_space(3))) v4i16_t*)p)); }
__device__ __forceinline__ float rowmax(const f32x16&p0,const f32x16&p1){
  float a=max3f(p0[0],p0[1],p1[0]),b=max3f(p0[2],p0[3],p1[1]);a=max3f(a,p1[2],p1[3]);
  #pragma unroll
  for(int r=4;r<16;r+=4){a=max3f(a,p0[r],p0[r+1]);b=max3f(b,p0[r+2],p0[r+3]);a=max3f(a,p1[r],p1[r+1]);b=max3f(b,p1[r+2],p1[r+3]);}
  const float m=max2f(a,b);
  auto rr=__builtin_amdgcn_permlane32_swap(__float_as_uint(m),__float_as_uint(m),false,false);
  return max2f(__uint_as_float(rr[0]),__uint_as_float(rr[1]));
}
__device__ __forceinline__ void pv(f32x16*o,int vb,bf16x8 pa0,bf16x8 pa1,bf16x8 pa2,bf16x8 pa3){
  #pragma unroll
  for(int d0=0;d0<2;++d0){s16x4 lo[4],hi[4];
    #pragma unroll
    for(int ks=0;ks<4;++ks){
      asm volatile("ds_read_b64_tr_b16 %0,%1 offset:%c2":"=&v"(lo[ks]):"v"(vb),"i"(d0*4096+ks*1024):"memory");
      asm volatile("ds_read_b64_tr_b16 %0,%1 offset:%c2":"=&v"(hi[ks]):"v"(vb),"i"(d0*4096+ks*1024+512):"memory");}
    asm volatile("s_waitcnt lgkmcnt(0)":::"memory");SBAR();
    #define PK(k) (bf16x8){lo[k][0],lo[k][1],lo[k][2],lo[k][3],hi[k][0],hi[k][1],hi[k][2],hi[k][3]}
    o[d0]=__builtin_amdgcn_mfma_f32_32x32x16_bf16(pa0,PK(0),o[d0],0,0,0);
    o[d0]=__builtin_amdgcn_mfma_f32_32x32x16_bf16(pa1,PK(1),o[d0],0,0,0);
    o[d0]=__builtin_amdgcn_mfma_f32_32x32x16_bf16(pa2,PK(2),o[d0],0,0,0);
    o[d0]=__builtin_amdgcn_mfma_f32_32x32x16_bf16(pa3,PK(3),o[d0],0,0,0);
    #undef PK
  }
}

#ifndef ATTN_STORE16
#define ATTN_STORE16(p,v) (*(u32x4*)(p)=(v))
#endif
template<int THRL,int qp,int kp_,int vp_e,int op> __device__ __forceinline__ void attn_unit(const bf16*Qw0,const bf16*Kh,const bf16*Vh,bf16*Ow0,int NT,char*shm,const int tid){
  const int lane=tid&63,r32=lane&31,hi=lane>>5; const int wid=__builtin_amdgcn_readfirstlane(tid>>6);
  const bf16*Qw=Qw0+(long)(wid*QBLK)*qp;
  const unsigned lds0=(unsigned)(uintptr_t)shm;
  float*wsf=(float*)(shm+LDS_WS)+wid*64;
  const bf16*ksrc=Kh+(long)lane*kp_+wid*8;
  const bf16*vsrc=Vh+(long)(16*(wid&3)+(lane>>2))*vp_e+(wid>>2)*32+(lane&3)*8;
  const unsigned kdst=lds0+LDS_K+wid*1024, vdst=lds0+LDS_V+wid*1024;
  #define DMA_K(t,slot) glds16(ksrc+(long)(t)*KVBLK*kp_,(unsigned)__builtin_amdgcn_readfirstlane(kdst+(slot)))
  #define DMA_V(t,slot) glds16(vsrc+(long)(t)*KVBLK*vp_e,(unsigned)__builtin_amdgcn_readfirstlane(vdst+(slot)))
  const int vb0=(int)(lds0+LDS_V)+((lane>>4)&1)*32+(lane&3)*8+(4*hi+((lane&15)>>2))*64;
  const char*Kbase=shm+LDS_K; bf16x8 kf[8];
  const lds_cptr shm3=(lds_cptr)shm; const lds_cptr kp0=shm3+LDS_K+hi*1024+r32*16; const lds_cptr vp0=shm3+LDS_V+((lane>>4)&1)*32+(lane&3)*8+(4*hi+((lane&15)>>2))*64;
  DMA_K(0,0);DMA_V(0,0);DMA_K(1,SLOTB);
  bf16x8 qr[4];
  #pragma unroll
  for(int d0=0;d0<4;++d0)qr[d0]=*reinterpret_cast<const bf16x8*>(&Qw[(long)r32*qp+d0*16+hi*8]);
  float mhat=0.f,l_reg=0.f;f32x16 o[2];o[0]=f32x16{};o[1]=f32x16{};f32x16 negm=f32x16{};asm volatile("":"+v"(negm));
  #define CMASK(P0,P1,t) do{}while(0)
  bool resc=false;
  #define START(P0,P1) do{ const float rm=rowmax(P0,P1); resc=false; \
    { const float dl=rm; mhat=fadd_s(mhat,dl); \
      _Pragma("unroll") for(int r=0;r<16;++r){P0[r]=fsub_s(P0[r],dl);P1[r]=fsub_s(P1[r],dl);} \
      _Pragma("unroll") for(int r=0;r<16;++r)negm[r]=-mhat; asm volatile("":"+v"(negm)); } \
    _Pragma("unroll") for(int r=0;r<16;++r)P0[r]=__builtin_amdgcn_exp2f(P0[r]); }while(0)
  #define RESC() do{ if(resc){ asm volatile("s_waitcnt lgkmcnt(0)":::"memory"); \
      _Pragma("unroll") for(int d_=0;d_<2;++d_) _Pragma("unroll") for(int r=0;r<16;++r)o[d_][r]*=wsf[crow(r,hi)]; } }while(0)
  f32x16 pA0,pA1,pB0,pB1;
  int sl_prev=0,sl_cur=0,sl_next=SLOTB;
  #define ROT() do{sl_prev=sl_cur;sl_cur=sl_next;sl_next=(sl_next==(NSLOT-1)*SLOTB)?0:sl_next+SLOTB;}while(0)
  DMA_K(2,2*SLOTB);
  WAIT_BAR(3);
  qkt(pA0,pA1,Kbase,qr,negm,r32,hi);asm volatile("s_nop 15\n\ts_nop 7":"+v"(pA0),"+v"(pA1));CMASK(pA0,pA1,0);
  START(pA0,pA1);
  _Pragma("unroll") for(int r=0;r<16;++r)pA1[r]=__builtin_amdgcn_exp2f(pA1[r]);
  WAIT_BAR(0);
  DMA_K(3,0);DMA_V(1,SLOTB);
  ROT();
  kload8(kf,kp0+sl_cur);
  WAIT_BAR(2);
  s16x4 vlo[8],vhi[8]; u32x4 pw0,pw1,pw2,pw3;
  #define PKW(P,B) cvtpk_s(P[B],P[B+1])
  #define PAF(k) __builtin_bit_cast(bf16x8,pw##k)
  #define VFR(i) (bf16x8){vlo[i][0],vlo[i][1],vlo[i][2],vlo[i][3],vhi[i][0],vhi[i][1],vhi[i][2],vhi[i][3]}
  #define PIN(x) asm volatile("":"+v"(x))
  #define MX3(a,b,c) __builtin_fmaxf(__builtin_fmaxf((a),(b)),(c))
  #define GAPA(MF,A0,A1,A2,A3,W0,W1,PW) do{ MF; sacc+=A0; sacc+=A1; sacc+=A2; sacc+=A3; PIN(sacc); W0; W1; PIN(PW); SBAR(); }while(0)
  #define EX(v) __builtin_amdgcn_exp2f(v)
  #define GAPB(MF,X,B) do{ MF; X[B]=EX(X[B]); X[B+1]=EX(X[B+1]); X[B+2]=EX(X[B+2]); X[B+3]=EX(X[B+3]); PIN(X); SBAR(); }while(0)
  #define VRD(i) do{ vlo[i]=vtr(vp_+(((i)>>2)*4096+((i)&3)*1024)); vhi[i]=vtr(vp_+(((i)>>2)*4096+((i)&3)*1024+512)); }while(0)
  #define KRD(G,j) do{ if(G){ kload2(kf,kp0+sl_next,j); SBAR(); } }while(0)
  #define STEP(C0,C1,P0,P1,t,GK,GV,GL) do{ SBAR(); \
    const lds_cptr vp_=vp0+sl_prev; \
    VRD(0); SBAR(); float sacc=(P0[0]+P0[1]); \
    GAPA(C0=__builtin_amdgcn_mfma_f32_32x32x16_bf16(kf[0],qr[0],negm,0,0,0), P0[2],P0[3],P0[4],P0[5],     pw0[0]=PKW(P0,0), pw0[1]=PKW(P0,2), pw0); \
    VRD(4); SBAR(); GAPA(C1=__builtin_amdgcn_mfma_f32_32x32x16_bf16(kf[1],qr[0],negm,0,0,0), P0[6],P0[7],P0[8],P0[9],     pw0[2]=PKW(P0,4), pw0[3]=PKW(P0,6), pw0); \
    VRD(1); SBAR(); GAPA(C0=__builtin_amdgcn_mfma_f32_32x32x16_bf16(kf[2],qr[1],C0,0,0,0),   P0[10],P0[11],P0[12],P0[13], pw1[0]=PKW(P0,8), pw1[1]=PKW(P0,10), pw1); \
    VRD(5); SBAR(); GAPA(C1=__builtin_amdgcn_mfma_f32_32x32x16_bf16(kf[3],qr[1],C1,0,0,0),   P0[14],P0[15],P1[0],P1[1],   pw1[2]=PKW(P0,12),pw1[3]=PKW(P0,14), pw1); \
    VRD(2); SBAR(); GAPA(C0=__builtin_amdgcn_mfma_f32_32x32x16_bf16(kf[4],qr[2],C0,0,0,0),   P1[2],P1[3],P1[4],P1[5],     pw2[0]=PKW(P1,0), pw2[1]=PKW(P1,2), pw2); \
    VRD(6); SBAR(); GAPA(C1=__builtin_amdgcn_mfma_f32_32x32x16_bf16(kf[5],qr[2],C1,0,0,0),   P1[6],P1[7],P1[8],P1[9],     pw2[2]=PKW(P1,4), pw2[3]=PKW(P1,6), pw2); \
    VRD(3); SBAR(); GAPA(C0=__builtin_amdgcn_mfma_f32_32x32x16_bf16(kf[6],qr[3],C0,0,0,0),   P1[10],P1[11],P1[12],P1[13], pw3[0]=PKW(P1,8), pw3[1]=PKW(P1,10), pw3); \
    VRD(7); SBAR(); GAPA(C1=__builtin_amdgcn_mfma_f32_32x32x16_bf16(kf[7],qr[3],C1,0,0,0),   P1[14],P1[15],0.f,0.f,       pw3[2]=PKW(P1,12),pw3[3]=PKW(P1,14), pw3); \
    l_reg+=sacc; \
    if(GK){DMA_K((t)+3,sl_cur);} if(GV){DMA_V((t)+1,sl_next);} \
    CMASK(C0,C1,t); \
    { float a=MX3(C0[0],C0[1],C1[0]),b=MX3(C0[2],C0[3],C1[1]); a=MX3(a,C1[2],C1[3]); \
      _Pragma("unroll") for(int r=4;r<16;r+=4){a=MX3(a,C0[r],C0[r+1]);b=MX3(b,C0[r+2],C0[r+3]);a=MX3(a,C1[r],C1[r+1]);b=MX3(b,C1[r+2],C1[r+3]);} \
      float rm=__builtin_fmaxf(a,b); { auto rr=__builtin_amdgcn_permlane32_swap(__float_as_uint(rm),__float_as_uint(rm),false,false); rm=__builtin_fmaxf(__uint_as_float(rr[0]),__uint_as_float(rr[1])); } \
      resc=false; \
      if(__builtin_expect(__any(rm>(float)THRL),0)){ const float dl=__builtin_fmaxf(rm,0.f); mhat+=dl; \
        _Pragma("unroll") for(int r=0;r<16;++r){C0[r]-=dl;C1[r]-=dl;} \
        _Pragma("unroll") for(int r=0;r<16;++r)negm[r]=-mhat; asm volatile("":"+v"(negm)); \
        const float f=__builtin_amdgcn_exp2f(-dl); l_reg*=f; if(hi==0)wsf[r32]=f; resc=true; } } \
    SBAR(); \
    GAPB(o[0]=__builtin_amdgcn_mfma_f32_32x32x16_bf16(PAF(0),VFR(0),o[0],0,0,0), C0,0); \
    GAPB(o[1]=__builtin_amdgcn_mfma_f32_32x32x16_bf16(PAF(0),VFR(4),o[1],0,0,0), C0,4); \
    KRD(GL,0); GAPB(o[0]=__builtin_amdgcn_mfma_f32_32x32x16_bf16(PAF(1),VFR(1),o[0],0,0,0), C0,8); \
    KRD(GL,1); GAPB(o[1]=__builtin_amdgcn_mfma_f32_32x32x16_bf16(PAF(1),VFR(5),o[1],0,0,0), C0,12); \
    KRD(GL,2); GAPB(o[0]=__builtin_amdgcn_mfma_f32_32x32x16_bf16(PAF(2),VFR(2),o[0],0,0,0), C1,0); \
    KRD(GL,3); GAPB(o[1]=__builtin_amdgcn_mfma_f32_32x32x16_bf16(PAF(2),VFR(6),o[1],0,0,0), C1,4); \
    GAPB(o[0]=__builtin_amdgcn_mfma_f32_32x32x16_bf16(PAF(3),VFR(3),o[0],0,0,0), C1,8); \
    GAPB(o[1]=__builtin_amdgcn_mfma_f32_32x32x16_bf16(PAF(3),VFR(7),o[1],0,0,0), C1,12); \
    }while(0)
  int t=1;
  for(;t+5<NT;t+=2){
    STEP(pB0,pB1,pA0,pA1,t,true,true,true);     WAIT_BAR(2); RESC(); ROT();
    STEP(pA0,pA1,pB0,pB1,t+1,true,true,true);   WAIT_BAR(2); RESC(); ROT();
  }
  #define ENDW(tt) do{ if((tt)+3<NT){WAIT_BAR(2);} else if((tt)+2<NT){WAIT_BAR(1);} else {WAIT_BAR(0);} }while(0)
  for(;t+1<NT;t+=2){
    STEP(pB0,pB1,pA0,pA1,t,(t+3<NT),(t+1<NT),(t+1<NT));       ENDW(t);   RESC(); ROT();
    STEP(pA0,pA1,pB0,pB1,t+1,(t+4<NT),(t+2<NT),(t+2<NT));     ENDW(t+1); RESC(); ROT();
  }
  STEP(pB0,pB1,pA0,pA1,NT-1,false,false,false); RESC();
  { float sacc=pB0[0]+pB0[1]; _Pragma("unroll") for(int r=2;r<16;++r)sacc+=pB0[r]; _Pragma("unroll") for(int r=0;r<16;++r)sacc+=pB1[r]; l_reg+=sacc;
    pw0=(u32x4){PKW(pB0,0),PKW(pB0,2),PKW(pB0,4),PKW(pB0,6)};pw1=(u32x4){PKW(pB0,8),PKW(pB0,10),PKW(pB0,12),PKW(pB0,14)};pw2=(u32x4){PKW(pB1,0),PKW(pB1,2),PKW(pB1,4),PKW(pB1,6)};pw3=(u32x4){PKW(pB1,8),PKW(pB1,10),PKW(pB1,12),PKW(pB1,14)};
    SBAR(); pv(o,vb0+sl_cur,PAF(0),PAF(1),PAF(2),PAF(3)); }
  #undef PKW
  #undef PAF
  #undef VFR
  #undef PIN
  #undef MX3
  #undef GAPA
  #undef GAPB
  #undef EX
  #undef VRD
  #undef KRD
  #undef STEP
  #undef ENDW
  {auto rr=__builtin_amdgcn_permlane32_swap(__float_as_uint(l_reg),__float_as_uint(l_reg),false,false);l_reg=__uint_as_float(rr[0])+__uint_as_float(rr[1]);}
  if(hi==0)wsf[32+r32]=l_reg;asm volatile("s_waitcnt lgkmcnt(0)":::"memory");
  float rli[16];
  #pragma unroll
  for(int r=0;r<16;++r)rli[r]=__builtin_amdgcn_rcpf(wsf[32+crow(r,hi)]);
  bf16*Ow=Ow0+(long)(wid*QBLK)*op;
  { bf16*stg=(bf16*)(shm+LDS_OST)+wid*2048;
    #pragma unroll
    for(int r=0;r<16;++r){const int orow=crow(r,hi);
      #pragma unroll
      for(int d0=0;d0<2;++d0)stg[orow*64+d0*32+r32]=__float2bfloat16(o[d0][r]*rli[r]);}
    asm volatile("s_waitcnt lgkmcnt(0)":::"memory");
    #pragma unroll
    for(int i=0;i<4;++i){const int row=i*8+(lane>>3),ch=lane&7; const u32x4 v=*(const u32x4*)(stg+row*64+ch*8); ATTN_STORE16(Ow+(long)row*op+ch*8,v);} }
  asm volatile("s_waitcnt lgkmcnt(0)\n\ts_barrier":::"memory");
  #undef DMA_K
  #undef DMA_V
  #undef CMASK
  #undef START
  #undef RESC
  #undef ROT
}
constexpr int V128_WS=NSLOT*SLOTB+NSLOT*2*SLOTB, V128_OST=V128_WS+NW*64*4, V128_LDS_BYTES=V128_OST+NW*4096;
template<int THRL,int qp,int kp_,int vp_e,int op> __device__ __forceinline__ void attn_unit_v128(const bf16*Qw0,const bf16*Kh,const bf16*Vh,bf16*Ow0,int NT,char*shm,const int tid){
  const int lane=tid&63,r32=lane&31,hi=lane>>5; const int wid=__builtin_amdgcn_readfirstlane(tid>>6);
  const bf16*Qw=Qw0+(long)(wid*QBLK)*qp;
  const unsigned lds0=(unsigned)(uintptr_t)shm;
  float*wsf=(float*)(shm+V128_WS)+wid*64;
  const bf16*ksrc=Kh+(long)lane*kp_+wid*8;
  const bf16*vsrc=Vh+(long)(16*(wid&3)+(lane>>2))*vp_e+(wid>>2)*32+(lane&3)*8;
  const unsigned kdst=lds0+LDS_K+wid*1024, vdst=lds0+LDS_V+wid*1024;
  #define DMA_K(t,slot) glds16(ksrc+(long)(t)*KVBLK*kp_,(unsigned)__builtin_amdgcn_readfirstlane(kdst+(slot)))
  #define DMA_V(t,slot) do{ glds16(vsrc+(long)(t)*KVBLK*vp_e,(unsigned)__builtin_amdgcn_readfirstlane(vdst+2*(slot))); glds16(vsrc+(long)(t)*KVBLK*vp_e+64,(unsigned)__builtin_amdgcn_readfirstlane(vdst+2*(slot)+8192)); }while(0)
  const int vb0=(int)(lds0+LDS_V)+((lane>>4)&1)*32+(lane&3)*8+(4*hi+((lane&15)>>2))*64;
  const char*Kbase=shm+LDS_K; bf16x8 kf[8];
  const lds_cptr shm3=(lds_cptr)shm; const lds_cptr kp0=shm3+LDS_K+hi*1024+r32*16; const lds_cptr vp0=shm3+LDS_V+((lane>>4)&1)*32+(lane&3)*8+(4*hi+((lane&15)>>2))*64;
  DMA_K(0,0);DMA_V(0,0);DMA_K(1,SLOTB);
  bf16x8 qr[4];
  #pragma unroll
  for(int d0=0;d0<4;++d0)qr[d0]=*reinterpret_cast<const bf16x8*>(&Qw[(long)r32*qp+d0*16+hi*8]);
  typedef __attribute__((address_space(3))) bf16x8 lds_bf16x8; const lds_cptr qst=shm3+V128_OST+wid*4096+lane*16;
  #define QF(d0) (*(const lds_bf16x8*)(qst+(d0)*1024))
  float mhat=0.f,l_reg=0.f;f32x16 o[4];o[0]=f32x16{};o[1]=f32x16{};o[2]=f32x16{};o[3]=f32x16{};const f32x16 zero16=f32x16{};
  #define CMASK(P0,P1,t) do{}while(0)
  bool resc=false;
  #define START(P0,P1) do{ const float rm=rowmax(P0,P1); resc=false; \
    { const float dl=rm; mhat=fadd_s(mhat,dl); \
      _Pragma("unroll") for(int r=0;r<16;++r){P0[r]=fsub_s(P0[r],dl);P1[r]=fsub_s(P1[r],dl);} \
      } \
    _Pragma("unroll") for(int r=0;r<16;++r)P0[r]=__builtin_amdgcn_exp2f(P0[r]); }while(0)
  #define RESC() do{ if(resc){ asm volatile("s_waitcnt lgkmcnt(0)":::"memory"); \
      _Pragma("unroll") for(int d_=0;d_<4;++d_) _Pragma("unroll") for(int r=0;r<16;++r)o[d_][r]*=wsf[crow(r,hi)]; } }while(0)
  f32x16 pA0,pA1,pB0,pB1;
  int sl_prev=0,sl_cur=0,sl_next=SLOTB;
  #define ROT() do{sl_prev=sl_cur;sl_cur=sl_next;sl_next=(sl_next==(NSLOT-1)*SLOTB)?0:sl_next+SLOTB;}while(0)
  DMA_K(2,2*SLOTB);
  WAIT_BAR(4);
  qkt(pA0,pA1,Kbase,qr,zero16,r32,hi);asm volatile("s_nop 15\n\ts_nop 7":"+v"(pA0),"+v"(pA1));CMASK(pA0,pA1,0);
  _Pragma("unroll") for(int d0=0;d0<4;++d0)*(__attribute__((address_space(3))) bf16x8*)(qst+d0*1024)=qr[d0];
  START(pA0,pA1);
  _Pragma("unroll") for(int r=0;r<16;++r)pA1[r]=__builtin_amdgcn_exp2f(pA1[r]);
  WAIT_BAR(0);
  DMA_K(3,0);DMA_V(1,SLOTB);
  ROT();
  kload8(kf,kp0+sl_cur);
  WAIT_BAR(3);
  s16x4 vlo[8],vhi[8]; u32x4 pw0,pw1,pw2,pw3;
  #define PKW(P,B) cvtpk_s(P[B],P[B+1])
  #define PAF(k) __builtin_bit_cast(bf16x8,pw##k)
  #define VFR(i) (bf16x8){vlo[i][0],vlo[i][1],vlo[i][2],vlo[i][3],vhi[i][0],vhi[i][1],vhi[i][2],vhi[i][3]}
  #define PIN(x) asm volatile("":"+v"(x))
  #define MX3(a,b,c) __builtin_fmaxf(__builtin_fmaxf((a),(b)),(c))
  #define GAPA(MF,A0,A1,A2,A3,W0,W1,PW) do{ MF; sacc+=A0; sacc+=A1; sacc+=A2; sacc+=A3; PIN(sacc); W0; W1; PIN(PW); SBAR(); }while(0)
  #define EX(v) __builtin_amdgcn_exp2f(v)
  #define GAPB(MF,X,B) do{ MF; X[B]=EX(X[B]); X[B+1]=EX(X[B+1]); X[B+2]=EX(X[B+2]); X[B+3]=EX(X[B+3]); PIN(X); SBAR(); }while(0)
  #define GAPB2(MF,X,B) do{ MF; X[B]=EX(X[B]); X[B+1]=EX(X[B+1]); PIN(X); SBAR(); }while(0)
  #define VRD2(i) do{ vlo[i]=vtr(vp_+(8192+((i)>>2)*4096+((i)&3)*1024)); vhi[i]=vtr(vp_+(8192+((i)>>2)*4096+((i)&3)*1024+512)); }while(0)
  #define VRD(i) do{ vlo[i]=vtr(vp_+(((i)>>2)*4096+((i)&3)*1024)); vhi[i]=vtr(vp_+(((i)>>2)*4096+((i)&3)*1024+512)); }while(0)
  #define KRD(G,j) do{ if(G){ kload2(kf,kp0+sl_next,j); SBAR(); } }while(0)
  #define STEP(C0,C1,P0,P1,t,GK,GV,GL) do{ SBAR(); \
    const lds_cptr vp_=vp0+2*sl_prev; \
    bf16x8 qa_=QF(0); VRD(0); SBAR(); float sacc=(P0[0]+P0[1]); \
    GAPA(C0=__builtin_amdgcn_mfma_f32_32x32x16_bf16(kf[0],qa_,zero16,0,0,0), P0[2],P0[3],P0[4],P0[5],     pw0[0]=PKW(P0,0), pw0[1]=PKW(P0,2), pw0); \
    VRD(4); SBAR(); GAPA(C1=__builtin_amdgcn_mfma_f32_32x32x16_bf16(kf[1],qa_,zero16,0,0,0), P0[6],P0[7],P0[8],P0[9],     pw0[2]=PKW(P0,4), pw0[3]=PKW(P0,6), pw0); \
    qa_=QF(1); VRD(1); SBAR(); GAPA(C0=__builtin_amdgcn_mfma_f32_32x32x16_bf16(kf[2],qa_,C0,0,0,0),   P0[10],P0[11],P0[12],P0[13], pw1[0]=PKW(P0,8), pw1[1]=PKW(P0,10), pw1); \
    VRD(5); SBAR(); GAPA(C1=__builtin_amdgcn_mfma_f32_32x32x16_bf16(kf[3],qa_,C1,0,0,0),   P0[14],P0[15],P1[0],P1[1],   pw1[2]=PKW(P0,12),pw1[3]=PKW(P0,14), pw1); \
    qa_=QF(2); VRD(2); SBAR(); GAPA(C0=__builtin_amdgcn_mfma_f32_32x32x16_bf16(kf[4],qa_,C0,0,0,0),   P1[2],P1[3],P1[4],P1[5],     pw2[0]=PKW(P1,0), pw2[1]=PKW(P1,2), pw2); \
    VRD(6); SBAR(); GAPA(C1=__builtin_amdgcn_mfma_f32_32x32x16_bf16(kf[5],qa_,C1,0,0,0),   P1[6],P1[7],P1[8],P1[9],     pw2[2]=PKW(P1,4), pw2[3]=PKW(P1,6), pw2); \
    qa_=QF(3); VRD(3); SBAR(); GAPA(C0=__builtin_amdgcn_mfma_f32_32x32x16_bf16(kf[6],qa_,C0,0,0,0),   P1[10],P1[11],P1[12],P1[13], pw3[0]=PKW(P1,8), pw3[1]=PKW(P1,10), pw3); \
    VRD(7); SBAR(); GAPA(C1=__builtin_amdgcn_mfma_f32_32x32x16_bf16(kf[7],qa_,C1,0,0,0),   P1[14],P1[15],0.f,0.f,       pw3[2]=PKW(P1,12),pw3[3]=PKW(P1,14), pw3); \
    l_reg+=sacc; \
    if(GK){DMA_K((t)+3,sl_cur);} if(GV){DMA_V((t)+1,sl_next);} \
    asm volatile("s_nop 15\n\ts_nop 7":"+v"(C0),"+v"(C1));   \
    _Pragma("unroll") for(int r=0;r<16;++r){C0[r]=fsub_s(C0[r],mhat);C1[r]=fsub_s(C1[r],mhat);} \
    CMASK(C0,C1,t); \
    { float a=MX3(C0[0],C0[1],C1[0]),b=MX3(C0[2],C0[3],C1[1]); a=MX3(a,C1[2],C1[3]); \
      _Pragma("unroll") for(int r=4;r<16;r+=4){a=MX3(a,C0[r],C0[r+1]);b=MX3(b,C0[r+2],C0[r+3]);a=MX3(a,C1[r],C1[r+1]);b=MX3(b,C1[r+2],C1[r+3]);} \
      float rm=__builtin_fmaxf(a,b); { auto rr=__builtin_amdgcn_permlane32_swap(__float_as_uint(rm),__float_as_uint(rm),false,false); rm=__builtin_fmaxf(__uint_as_float(rr[0]),__uint_as_float(rr[1])); } \
      resc=false; \
      if(__builtin_expect(__any(rm>(float)THRL),0)){ const float dl=__builtin_fmaxf(rm,0.f); mhat+=dl; \
        _Pragma("unroll") for(int r=0;r<16;++r){C0[r]-=dl;C1[r]-=dl;} \
        const float f=__builtin_amdgcn_exp2f(-dl); l_reg*=f; if(hi==0)wsf[r32]=f; resc=true; } } \
    SBAR(); \
    GAPB2(o[0]=__builtin_amdgcn_mfma_f32_32x32x16_bf16(PAF(0),VFR(0),o[0],0,0,0), C0,0);  VRD2(0); SBAR(); \
    GAPB2(o[1]=__builtin_amdgcn_mfma_f32_32x32x16_bf16(PAF(0),VFR(4),o[1],0,0,0), C0,2);  VRD2(4); SBAR(); \
    KRD(GL,0); GAPB2(o[0]=__builtin_amdgcn_mfma_f32_32x32x16_bf16(PAF(1),VFR(1),o[0],0,0,0), C0,4);  VRD2(1); SBAR(); \
    KRD(GL,1); GAPB2(o[1]=__builtin_amdgcn_mfma_f32_32x32x16_bf16(PAF(1),VFR(5),o[1],0,0,0), C0,6);  VRD2(5); SBAR(); \
    KRD(GL,2); GAPB2(o[0]=__builtin_amdgcn_mfma_f32_32x32x16_bf16(PAF(2),VFR(2),o[0],0,0,0), C0,8);  VRD2(2); SBAR(); \
    KRD(GL,3); GAPB2(o[1]=__builtin_amdgcn_mfma_f32_32x32x16_bf16(PAF(2),VFR(6),o[1],0,0,0), C0,10); VRD2(6); SBAR(); \
    GAPB2(o[0]=__builtin_amdgcn_mfma_f32_32x32x16_bf16(PAF(3),VFR(3),o[0],0,0,0), C0,12); VRD2(3); SBAR(); \
    GAPB2(o[1]=__builtin_amdgcn_mfma_f32_32x32x16_bf16(PAF(3),VFR(7),o[1],0,0,0), C0,14); VRD2(7); SBAR(); \
    GAPB2(o[2]=__builtin_amdgcn_mfma_f32_32x32x16_bf16(PAF(0),VFR(0),o[2],0,0,0), C1,0); \
    GAPB2(o[3]=__builtin_amdgcn_mfma_f32_32x32x16_bf16(PAF(0),VFR(4),o[3],0,0,0), C1,2); \
    GAPB2(o[2]=__builtin_amdgcn_mfma_f32_32x32x16_bf16(PAF(1),VFR(1),o[2],0,0,0), C1,4); \
    GAPB2(o[3]=__builtin_amdgcn_mfma_f32_32x32x16_bf16(PAF(1),VFR(5),o[3],0,0,0), C1,6); \
    GAPB2(o[2]=__builtin_amdgcn_mfma_f32_32x32x16_bf16(PAF(2),VFR(2),o[2],0,0,0), C1,8); \
    GAPB2(o[3]=__builtin_amdgcn_mfma_f32_32x32x16_bf16(PAF(2),VFR(6),o[3],0,0,0), C1,10); \
    GAPB2(o[2]=__builtin_amdgcn_mfma_f32_32x32x16_bf16(PAF(3),VFR(3),o[2],0,0,0), C1,12); \
    GAPB2(o[3]=__builtin_amdgcn_mfma_f32_32x32x16_bf16(PAF(3),VFR(7),o[3],0,0,0), C1,14); \
    }while(0)
  int t=1;
  for(;t+5<NT;t+=2){
    STEP(pB0,pB1,pA0,pA1,t,true,true,true);     WAIT_BAR(3); RESC(); ROT();
    STEP(pA0,pA1,pB0,pB1,t+1,true,true,true);   WAIT_BAR(3); RESC(); ROT();
  }
  #define ENDW(tt) do{ if((tt)+3<NT){WAIT_BAR(3);} else if((tt)+2<NT){WAIT_BAR(2);} else {WAIT_BAR(0);} }while(0)
  for(;t+1<NT;t+=2){
    STEP(pB0,pB1,pA0,pA1,t,(t+3<NT),(t+1<NT),(t+1<NT));       ENDW(t);   RESC(); ROT();
    STEP(pA0,pA1,pB0,pB1,t+1,(t+4<NT),(t+2<NT),(t+2<NT));     ENDW(t+1); RESC(); ROT();
  }
  STEP(pB0,pB1,pA0,pA1,NT-1,false,false,false); RESC();
  { float sacc=pB0[0]+pB0[1]; _Pragma("unroll") for(int r=2;r<16;++r)sacc+=pB0[r]; _Pragma("unroll") for(int r=0;r<16;++r)sacc+=pB1[r]; l_reg+=sacc;
    pw0=(u32x4){PKW(pB0,0),PKW(pB0,2),PKW(pB0,4),PKW(pB0,6)};pw1=(u32x4){PKW(pB0,8),PKW(pB0,10),PKW(pB0,12),PKW(pB0,14)};pw2=(u32x4){PKW(pB1,0),PKW(pB1,2),PKW(pB1,4),PKW(pB1,6)};pw3=(u32x4){PKW(pB1,8),PKW(pB1,10),PKW(pB1,12),PKW(pB1,14)};
    SBAR(); pv(o,vb0+2*sl_cur,PAF(0),PAF(1),PAF(2),PAF(3)); pv(o+2,vb0+2*sl_cur+8192,PAF(0),PAF(1),PAF(2),PAF(3)); }
  #undef PKW
  #undef PAF
  #undef VFR
  #undef PIN
  #undef MX3
  #undef GAPA
  #undef GAPB
  #undef EX
  #undef VRD
  #undef VRD2
  #undef GAPB2
  #undef KRD
  #undef STEP
  #undef ENDW
  {auto rr=__builtin_amdgcn_permlane32_swap(__float_as_uint(l_reg),__float_as_uint(l_reg),false,false);l_reg=__uint_as_float(rr[0])+__uint_as_float(rr[1]);}
  if(hi==0)wsf[32+r32]=l_reg;asm volatile("s_waitcnt lgkmcnt(0)":::"memory");
  float rli[16];
  #pragma unroll
  for(int r=0;r<16;++r)rli[r]=__builtin_amdgcn_rcpf(wsf[32+crow(r,hi)]);
  bf16*Ow=Ow0+(long)(wid*QBLK)*op;
  { bf16*stg=(bf16*)(shm+V128_OST)+wid*2048;
    #pragma unroll
    for(int ps=0;ps<2;++ps){
      #pragma unroll
      for(int r=0;r<16;++r){const int orow=crow(r,hi);
        #pragma unroll
        for(int d0=0;d0<2;++d0)stg[orow*64+d0*32+r32]=__float2bfloat16(o[2*ps+d0][r]*rli[r]);}
      asm volatile("s_waitcnt lgkmcnt(0)":::"memory");
      #pragma unroll
      for(int i=0;i<4;++i){const int row=i*8+(lane>>3),ch=lane&7; const u32x4 v=*(const u32x4*)(stg+row*64+ch*8); ATTN_STORE16(Ow+(long)row*op+ps*64+ch*8,v);}
      asm volatile("s_waitcnt lgkmcnt(0)":::"memory"); } }
  asm volatile("s_waitcnt lgkmcnt(0)\n\ts_barrier":::"memory");
  #undef DMA_K
  #undef DMA_V
  #undef CMASK
  #undef START
  #undef RESC
  #undef ROT
  #undef QF
}
constexpr int ATTN_LDS_BYTES=LDS_BYTES;
#undef SBAR
#undef WAIT_BAR
}
#define GAS __attribute__((address_space(1)))
#define LAS __attribute__((address_space(3)))
typedef unsigned short bf16;
typedef unsigned v4u __attribute__((ext_vector_type(4)));
typedef float f32x4 __attribute__((ext_vector_type(4)));
typedef short bf16x8 __attribute__((ext_vector_type(8)));
typedef GAS unsigned gu32;
typedef GAS unsigned long long gu64;
#define RLX_AGENT __ATOMIC_RELAXED, __HIP_MEMORY_SCOPE_AGENT
#define LDS_WAIT() asm volatile("s_waitcnt lgkmcnt(0)" ::: "memory")
#define VM_WAIT() asm volatile("s_waitcnt vmcnt(0)" ::: "memory")
__device__ __forceinline__ unsigned long long rt() { return __builtin_amdgcn_s_memrealtime(); }
__device__ __forceinline__ unsigned f2bf(float f) { unsigned u = __builtin_bit_cast(unsigned, f); return (u + 0x7fffu + ((u >> 16) & 1u)) >> 16; }
__device__ __forceinline__ unsigned pk2(float lo, float hi) { return f2bf(lo) | (f2bf(hi) << 16); }

#define XB_TMO      128
#define XB_XCNT(j)  (256  + 64 * (j))
#define XB_XSUB(j)  (1280 + 64 * (j))
#define XB_XGEN(j)  (2304 + 64 * (j))
#define XB_TOP      3328
#define XB_TOPGEN   3392
#define XCD_BAR_WORDS 3456
#define XB_SPIN_CAP (1u << 18)

__device__ __forceinline__ unsigned xb_ld(unsigned* p)              { return __hip_atomic_load(p, __ATOMIC_RELAXED, __HIP_MEMORY_SCOPE_AGENT); }
__device__ __forceinline__ unsigned xb_add(unsigned* p, unsigned v) { return __hip_atomic_fetch_add(p, v, __ATOMIC_RELAXED, __HIP_MEMORY_SCOPE_AGENT); }
__device__ __forceinline__ unsigned xb_xcc_id() { return (unsigned)__builtin_amdgcn_s_getreg((3 << 11) | 20) & 0xFu; }
#define XB_SPIN(cond, bar) do { unsigned _sp = 0; while (cond) { __builtin_amdgcn_s_sleep(1); \
    if ((++_sp & 255u) == 0u) { if (xb_ld(&(bar)[XB_TMO])) break; if (_sp > XB_SPIN_CAP) { atomicAdd(&(bar)[XB_TMO], 1u); break; } } } } while (0)

struct XcdBarrier {
    unsigned* bar; unsigned x;
    volatile LAS unsigned* st;
};

__device__ __forceinline__ XcdBarrier xcd_barrier_post(unsigned* bar, volatile LAS unsigned* st, const int tid_) {
    XcdBarrier b; b.bar = bar; b.x = xb_xcc_id(); b.st = st;
    if (tid_ == 0) (void)xb_add(&bar[XB_XCNT(b.x)], 1u);
    return b;
}
__device__ __forceinline__ void xcd_barrier_complete(unsigned* bar, unsigned x, unsigned& nloc, unsigned& nx) {
    const unsigned G = gridDim.x * gridDim.y * gridDim.z;
    unsigned sum, cnt, mine, sp = 0u;
    for (;;) {
        sum = 0u; cnt = 0u; mine = 0u;
#pragma unroll
        for (unsigned j = 0; j < 16; ++j) { const unsigned c = xb_ld(&bar[XB_XCNT(j)]); sum += c; cnt += (c > 0u) ? 1u : 0u; mine = (j == x) ? c : mine; }
        if (sum == G) break;
        __builtin_amdgcn_s_sleep(1);
        if ((++sp & 255u) == 0u) { if (xb_ld(&bar[XB_TMO])) break; if (sp > XB_SPIN_CAP) { atomicAdd(&bar[XB_TMO], 1u); break; } }
    }
    nloc = mine > 0u ? mine : 1u; nx = cnt > 0u ? cnt : 1u;
}

__device__ __forceinline__ void xcd_barrier(const XcdBarrier& b, const int tid_) {
    asm volatile("s_waitcnt vmcnt(0)" ::: "memory");
    __syncthreads();
    if (tid_ == 0) {
        unsigned* bar = b.bar;
        __builtin_amdgcn_s_waitcnt(0);
        unsigned nloc = b.st[0], nx = b.st[1];
        if (nloc == 0u) { xcd_barrier_complete(bar, b.x, nloc, nx); b.st[0] = nloc; b.st[1] = nx; }
        const unsigned old = xb_add(&bar[XB_XSUB(b.x)], 1u);
        const unsigned gen = old / nloc;
        if (old + 1u == (gen + 1u) * nloc) {
            __builtin_amdgcn_fence(__ATOMIC_RELEASE, "agent");
            asm volatile("s_waitcnt vmcnt(0)" ::: "memory");
            const unsigned og = xb_add(&bar[XB_TOP], 1u);
            const unsigned tg = og / nx;
            if (og + 1u == (tg + 1u) * nx) xb_add(&bar[XB_TOPGEN], 1u);
            else XB_SPIN(xb_ld(&bar[XB_TOPGEN]) == tg, bar);
            __builtin_amdgcn_fence(__ATOMIC_ACQUIRE, "agent");
            xb_add(&bar[XB_XGEN(b.x)], 1u);
            asm volatile("s_waitcnt vmcnt(0)" ::: "memory");
        } else {
            XB_SPIN(xb_ld(&bar[XB_XGEN(b.x)]) == gen, bar);
            __builtin_amdgcn_fence(__ATOMIC_ACQUIRE, "agent");
            asm volatile("s_waitcnt vmcnt(0)" ::: "memory");
        }
    }
    __syncthreads();
}
constexpr size_t MiB = 1u << 20;
constexpr size_t WS_CTL = 0, CTL_ZERO_BYTES = 81920;
constexpr size_t WS_MOD = 1 * MiB;
constexpr size_t WS_ROPE = 3 * MiB;
constexpr size_t WS_ROUTE_E = 3 * MiB + 65536;
constexpr size_t WS_ROUTE_W = 3 * MiB + 262144;
constexpr size_t WS_SLOT_TOK = 4 * MiB;
constexpr size_t WS_SLOT_W = 4 * MiB + 524288;
constexpr size_t WS_TOKSLOT = 5 * MiB;
constexpr size_t WS_XC = 8 * MiB;
constexpr size_t WS_H = 24 * MiB;
constexpr size_t WS_WT = 96 * MiB;
constexpr size_t WT_IN = 0, WT_OUT = 6 * MiB, WT_GU = 8 * MiB, WT_DN = 120 * MiB;
constexpr size_t WS_HP = 286 * MiB;
constexpr size_t WS_R1 = 438 * MiB;
constexpr size_t R1_OPART = 216 * MiB;
constexpr size_t WS_END = 970 * MiB;

constexpr int CW_TMO = 0, CW_CODE = 1;
constexpr int CW_BAR = 4096;
constexpr int CW_MOE = 16384;

constexpr int RING_OFF = 0, RING_BYTES = 131072;
constexpr int LDSCTL_OFF = RING_BYTES, MISC_OFF = LDSCTL_OFF + 320;
constexpr int TAB_OFF = LDSCTL_OFF + 1024;
constexpr int SS_OFF = LDSCTL_OFF + 4096;
constexpr int LDS_BYTES = 147456;
constexpr int NWAVES = 8;

struct Args { const float* in[27]; float* out; unsigned char* ws; int ph_lo, ph_hi; };
struct Frame { LAS unsigned char* lds; gu32* ctl; int tid, lane, wave, vcu, G; };
constexpr int ARGS_OFF = LDSCTL_OFF + 512;
#define ARG_LO(k) ((unsigned)__builtin_amdgcn_readfirstlane((int)((const LAS unsigned*)(F.lds + ARGS_OFF))[2 * (k)]))
#define ARG_HI(k) ((unsigned)__builtin_amdgcn_readfirstlane((int)((const LAS unsigned*)(F.lds + ARGS_OFF))[2 * (k) + 1]))
#define ARG_U64(k) (((unsigned long long)ARG_HI(k) << 32) | (unsigned long long)ARG_LO(k))
#define ARG_IN(k) ((const float*)(const GAS float*)ARG_U64(k))
#define ARG_OUT ((float*)(GAS float*)ARG_U64(27))
#define ARG_WS ((unsigned char*)(GAS unsigned char*)ARG_U64(28))

__device__ __forceinline__ float wave_sum(float v) {
#define WS_DPP(ctrl) v += __int_as_float(__builtin_amdgcn_update_dpp(0, __float_as_int(v), (ctrl), 0xf, 0xf, true))
    WS_DPP(0xB1); WS_DPP(0x4E); WS_DPP(0x141); WS_DPP(0x140);
#undef WS_DPP
    { const auto r = __builtin_amdgcn_permlane16_swap(__float_as_uint(v), __float_as_uint(v), false, false); v = __uint_as_float(r[0]) + __uint_as_float(r[1]); }
    { const auto r = __builtin_amdgcn_permlane32_swap(__float_as_uint(v), __float_as_uint(v), false, false); v = __uint_as_float(r[0]) + __uint_as_float(r[1]); }
    return v;
}
__device__ __forceinline__ float* resid_row(float* out, float* xc, int r) { const int b = r / RB, t = r - b * RB; return t < SEQ ? out + (size_t)(b * SEQ + t) * D : xc + (size_t)(b * CTXL + t - SEQ) * D; }

__device__ __forceinline__ void p0_phase(const Frame& F) {
    const size_t gt = (size_t)F.vcu * 512 + F.tid, NT_ = (size_t)F.G * 512;
    { const f32x4* s = (const f32x4*)ARG_IN(2); f32x4* d = (f32x4*)(ARG_WS + WS_XC); for (size_t i = gt; i < (size_t)NB * CTXL * D / 4; i += NT_) d[i] = s[i]; }
    if (F.vcu == 0) { for (int i = F.tid; i < 1024; i += 512) { const int v = i >> 4, k = i & 15; const float inv = powf(10000.f, -(float)k / 16.f), ang = (float)v * inv;
        float* rt_ = (float*)(ARG_WS + WS_ROPE); rt_[i] = cosf(ang); rt_[1024 + i] = sinf(ang); } }
    LAS float* S = (LAS float*)(F.lds);
    LAS float* R = (LAS float*)(F.lds + 17 * 1024 * 4);
    { const float* c_ = ARG_IN(1); const float* cc_ = ARG_IN(3);
    for (int i = F.tid; i < 17 * 1024; i += 512) { const float v = (i < 16 * 1024) ? c_[i] : cc_[i - 16 * 1024]; S[i] = v / (1.f + __expf(-v)); } }
    __syncthreads();
    const float* adaw = ARG_IN(4); const float* adab = ARG_IN(5); float* MODw = (float*)(ARG_WS + WS_MOD);
    const int cl = F.tid & 31, kc = F.tid >> 5;
    for (int item = F.vcu; item < 4 * 192; item += F.G) {
        const int l = item / 192, n0 = (item % 192) * 32;
        const float* W = adaw + ((size_t)l * D + kc * 64) * 6144 + n0 + cl;
        float acc[17];
#pragma unroll
        for (int bb = 0; bb < 17; ++bb) acc[bb] = 0.f;
        float w[64];
#pragma unroll
        for (int j = 0; j < 64; ++j) w[j] = W[(size_t)j * 6144];
#pragma unroll
        for (int k = 0; k < 64; k += 16) {
#pragma unroll
            for (int bb = 0; bb < 17; ++bb) {
#pragma unroll
                for (int j = 0; j < 16; j += 4) { const f32x4 s4 = *(const LAS f32x4*)(S + bb * 1024 + kc * 64 + k + j); acc[bb] += (s4[0] * w[k + j] + s4[1] * w[k + j + 1]) + (s4[2] * w[k + j + 2] + s4[3] * w[k + j + 3]); } }
        }
#pragma unroll
        for (int bb = 0; bb < 17; ++bb) R[(kc * 17 + bb) * 32 + cl] = acc[bb];
        __syncthreads();
        for (int o = F.tid; o < 17 * 32; o += 512) { const int bb = o >> 5, c = o & 31; float sum = 0.f;
#pragma unroll
            for (int q = 0; q < 16; ++q) sum += R[(q * 17 + bb) * 32 + c];
            MODw[(size_t)(l * 17 + bb) * 6144 + n0 + c] = adab[l * 6144 + n0 + c] + sum; }
        __syncthreads();
    }
}

__device__ __forceinline__ void transpose_item(const float* W, int K, int N, bf16* WT, int k0, int n0, int drow, LAS float* scr, int lane) {
    float wv[32];
#pragma unroll
    for (int i = 0; i < 32; ++i) wv[i] = __builtin_nontemporal_load(&W[(size_t)(k0 + 2 * i + (lane >> 5)) * N + n0 + (lane & 31)]);
#pragma unroll
    for (int i = 0; i < 32; ++i) scr[(2 * i + (lane >> 5)) * 33 + (lane & 31)] = wv[i];
    LDS_WAIT(); asm volatile("" ::: "memory");
    const int c = lane & 7;
#pragma unroll
    for (int j = 0; j < 4; ++j) { const int n = (lane >> 3) + 8 * j; const LAS float* s = scr + (8 * c) * 33 + n;
        v4u o; o.x = pk2(s[0 * 33], s[1 * 33]); o.y = pk2(s[2 * 33], s[3 * 33]); o.z = pk2(s[4 * 33], s[5 * 33]); o.w = pk2(s[6 * 33], s[7 * 33]);
        *(GAS v4u*)(WT + (size_t)(drow + n) * K + k0 + 8 * c) = o; }
    LDS_WAIT(); asm volatile("" ::: "memory");
}
__device__ __forceinline__ void transpose_item8(const float* W, int K, int N, unsigned char* WT, int k0, int n0, int drow, LAS float* scr, int lane, float scl) {
    float wv[32];
#pragma unroll
    for (int i = 0; i < 32; ++i) wv[i] = __builtin_nontemporal_load(&W[(size_t)(k0 + 2 * i + (lane >> 5)) * N + n0 + (lane & 31)]);
#pragma unroll
    for (int i = 0; i < 32; ++i) scr[(2 * i + (lane >> 5)) * 33 + (lane & 31)] = wv[i];
    LDS_WAIT(); asm volatile("" ::: "memory");
    const int c = lane & 7; typedef unsigned u32x2 __attribute__((ext_vector_type(2)));
#pragma unroll
    for (int j = 0; j < 4; ++j) { const int n = (lane >> 3) + 8 * j; const LAS float* s = scr + (8 * c) * 33 + n;
        u32x2 o; o.x = pk4_fp8(s[0 * 33] * scl, s[1 * 33] * scl, s[2 * 33] * scl, s[3 * 33] * scl); o.y = pk4_fp8(s[4 * 33] * scl, s[5 * 33] * scl, s[6 * 33] * scl, s[7 * 33] * scl);
        *(GAS u32x2*)(WT + (size_t)(drow + n) * K + k0 + 8 * c) = o; }
    LDS_WAIT(); asm volatile("" ::: "memory");
}
__device__ __forceinline__ void transpose_item8w(const float* W, int K, int N, unsigned char* WT, int k0, int n0, int drow, LAS unsigned short* scr, int lane, float scl) {
    f32x4 wv[16];
#pragma unroll
    for (int i = 0; i < 16; ++i) wv[i] = __builtin_nontemporal_load((const f32x4*)(W + (size_t)(k0 + 4 * i + (lane >> 4)) * N + n0 + 4 * (lane & 15)));
#pragma unroll
    for (int i = 0; i < 16; ++i) { LAS unsigned* d = (LAS unsigned*)(scr + (4 * i + (lane >> 4)) * 66 + 4 * (lane & 15)); d[0] = pk2(wv[i][0] * scl, wv[i][1] * scl); d[1] = pk2(wv[i][2] * scl, wv[i][3] * scl); }
    LDS_WAIT(); asm volatile("" ::: "memory");
    const int c = lane & 7; typedef unsigned u32x2 __attribute__((ext_vector_type(2)));
#pragma unroll
    for (int j = 0; j < 8; ++j) { const int n = (lane >> 3) + 8 * j; const LAS unsigned short* s = scr + (8 * c) * 66 + n;
        float f[8];
#pragma unroll
        for (int q = 0; q < 8; ++q) f[q] = __uint_as_float((unsigned)s[q * 66] << 16);
        u32x2 o; o.x = pk4_fp8(f[0], f[1], f[2], f[3]); o.y = pk4_fp8(f[4], f[5], f[6], f[7]);
        *(GAS u32x2*)(WT + (size_t)(drow + n) * K + k0 + 8 * c) = o; }
    LDS_WAIT(); asm volatile("" ::: "memory");
}
__device__ __forceinline__ int wt_drow(int mode, int e, int N, int n0) {
    if (mode == 0) return e * N + n0;
    if (mode == 1) return n0 < 512 ? (n0 >> 7) * 256 + (n0 & 127) : (n0 < 1024 ? ((n0 - 512) >> 7) * 256 + 128 + (n0 & 127) : n0);
    return e * 2 * N + (n0 >> 7) * 256 + (n0 & 127) + (mode == 3 ? 128 : 0);
}
template <bool TO8 = false>
__device__ __forceinline__ int wconv_job(const Frame& F, int& it, int step, const float* W, int nexp, int K, int N, bf16* WT, int mode, float scl = 1.f) {
    constexpr int NW_ = TO8 ? 64 : 32;
    const int per = (K / 64) * (N / NW_), tot = nexp * per, nblk = N / NW_;
    LAS float* scr = (LAS float*)(F.lds + RING_OFF + F.wave * 16384);
    if (TO8) {
        LAS unsigned short* scr8 = (LAS unsigned short*)scr; unsigned char* WT8 = (unsigned char*)WT; const int lane = F.lane; f32x4 wv[16];
#define T8_LOAD(itx) do { const int e_ = (itx) / per, r_ = (itx) - e_ * per, kb_ = r_ / nblk, nb_ = r_ - kb_ * nblk; const float* Wp = W + (size_t)e_ * K * N + (size_t)(64 * kb_ + (lane >> 4)) * N + NW_ * nb_ + 4 * (lane & 15); \
        _Pragma("unroll") for (int i = 0; i < 16; ++i) wv[i] = __builtin_nontemporal_load((const f32x4*)(Wp + (size_t)(4 * i) * N)); } while (0)
        if (it < tot) T8_LOAD(it);
        for (; it < tot; it += step) { const int e = it / per, r = it - e * per, kb = r / nblk, nb = r - kb * nblk; const int k0 = 64 * kb, drow = wt_drow(mode, e, N, NW_ * nb);
#pragma unroll
            for (int i = 0; i < 16; ++i) { LAS unsigned* d = (LAS unsigned*)(scr8 + (4 * i + (lane >> 4)) * 66 + 4 * (lane & 15)); d[0] = pk2(wv[i][0] * scl, wv[i][1] * scl); d[1] = pk2(wv[i][2] * scl, wv[i][3] * scl); }
            if (it + step < tot) T8_LOAD(it + step);
            LDS_WAIT(); asm volatile("" ::: "memory");
            const int c = lane & 7; typedef unsigned u32x2 __attribute__((ext_vector_type(2)));
#pragma unroll
            for (int j = 0; j < 8; ++j) { const int n = (lane >> 3) + 8 * j; const LAS unsigned short* sp = scr8 + (8 * c) * 66 + n;
                float f[8];
#pragma unroll
                for (int q = 0; q < 8; ++q) f[q] = __uint_as_float((unsigned)sp[q * 66] << 16);
                u32x2 o; o.x = pk4_fp8(f[0], f[1], f[2], f[3]); o.y = pk4_fp8(f[4], f[5], f[6], f[7]);
                *(GAS u32x2*)(WT8 + (size_t)(drow + n) * K + k0 + 8 * c) = o; }
            LDS_WAIT(); asm volatile("" ::: "memory");
        }
#undef T8_LOAD
        it -= tot; return tot;
    }
    for (; it < tot; it += step) { const int e = it / per, r = it - e * per, kb = r / nblk, nb = r - kb * nblk;
        if (TO8) transpose_item8w(W + (size_t)e * K * N, K, N, (unsigned char*)WT, 64 * kb, NW_ * nb, wt_drow(mode, e, N, NW_ * nb), (LAS unsigned short*)scr, F.lane, scl);
        else transpose_item(W + (size_t)e * K * N, K, N, WT, 64 * kb, 32 * nb, wt_drow(mode, e, N, 32 * nb), scr, F.lane); }
    it -= tot; return tot;
}
template <bool F8, bool F8D, bool W8IN = false, bool W8OUT = false, bool W8EV = false>
__device__ __forceinline__ void wconv_phase(const Frame& F, int l) {
    const int i = l >> 1, step = F.G * NWAVES; int it = F.vcu * NWAVES + F.wave;
    bf16* WT = (bf16*)(ARG_WS + WS_WT);
    if ((l & 1) == 0) {
        wconv_job<W8EV>(F, it, step, ARG_IN(8) + (size_t)i * D * EV_IN, 1, D, EV_IN, WT + WT_IN / 2, 1, W8EV ? 32.f : 1.f);
        wconv_job(F, it, step, ARG_IN(14) + (size_t)i * D * D, 1, D, D, WT + WT_OUT / 2, 0);
        wconv_job<F8>(F, it, step, ARG_IN(15) + (size_t)i * D * FF, 1, D, FF, WT + WT_GU / 2, 2, 32.f);
        wconv_job<F8>(F, it, step, ARG_IN(16) + (size_t)i * D * FF, 1, D, FF, WT + WT_GU / 2, 3, 32.f);
        wconv_job<F8D>(F, it, step, ARG_IN(17) + (size_t)i * FF * D, 1, FF, D, WT + WT_DN / 2, 0, 64.f);
    } else {
        wconv_job<W8IN>(F, it, step, ARG_IN(18) + (size_t)i * D * OD_IN, 1, D, OD_IN, WT + WT_IN / 2, 0, W8IN ? 32.f : 1.f);
        wconv_job<W8OUT>(F, it, step, ARG_IN(21) + (size_t)i * D * D, 1, D, D, WT + WT_OUT / 2, 0, W8OUT ? 32.f : 1.f);
        wconv_job<F8>(F, it, step, ARG_IN(23) + (size_t)i * NE * D * FF, NE, D, FF, WT + WT_GU / 2, 2, 32.f);
        wconv_job<F8>(F, it, step, ARG_IN(24) + (size_t)i * NE * D * FF, NE, D, FF, WT + WT_GU / 2, 3, 32.f);
        wconv_job<F8D>(F, it, step, ARG_IN(25) + (size_t)i * NE * FF * D, NE, FF, D, WT + WT_DN / 2, 0, 64.f);
    }
}

template <bool ROUTER, bool OUT8 = false, bool MOEADD = false>
__device__ __forceinline__ void norm_phase(const Frame& F, int l, int which, bool lat_only) {
    const float* MOD = (const float*)(ARG_WS + WS_MOD) + (size_t)l * 17 * 6144;
    const float* G = (which ? ARG_IN(7) : ARG_IN(6)) + l * D;
    unsigned char* ws_ = ARG_WS; float* xc = (float*)(ws_ + WS_XC); bf16* H = (bf16*)(ws_ + WS_H); const float* outp = (l == 0 && which == 0) ? ARG_IN(0) : ARG_OUT;
    int* routeE = (int*)(ws_ + WS_ROUTE_E); float* routeW = (float*)(ws_ + WS_ROUTE_W);
    LAS float* RW = (LAS float*)(F.lds);
    LAS unsigned* LC = (LAS unsigned*)(F.lds + TAB_OFF);
    if (ROUTER) {
        const float* rw = ARG_IN(22) + (size_t)(l >> 1) * D * NE;
        for (int i = F.tid; i < D * NE; i += 512) { const int c = i >> 3, e = i & 7, ln = (c & 255) >> 2, j = c >> 8, q = c & 3; RW[(((j * 4 + q) * 2 + (e >> 2)) * 64 + ln) * 4 + (e & 3)] = rw[i]; }
        if (F.tid < 16) LC[F.tid] = 0u;
        int* st = (int*)(ws_ + WS_SLOT_TOK); for (int i = F.vcu * 512 + F.tid; i < MAX_SLOTS; i += F.G * 512) st[i] = -1;
        __syncthreads();
    }
    const int gw = F.vcu * NWAVES + F.wave, NGW = F.G * NWAVES, RPW = (M_ALL + NGW - 1) / NGW, r0_ = gw * RPW, r1_ = (r0_ + RPW < M_ALL) ? r0_ + RPW : M_ALL;
    int mkey = -1; f32x4 mg[4], msh[4], vn[4];
    const int* TS_ = (const int*)(ws_ + WS_TOKSLOT); const bf16* Y_ = (const bf16*)(ws_ + WS_HP);
    int sn0 = 0, sn1 = 0; float wn0 = 0.f, wn1 = 0.f, wc0 = 0.f, wc1 = 0.f; unsigned long long yn0[4], yn1[4]; f32x4 g5v[4];
#define NRM_ROUTE(rr) do { sn0 = TS_[2 * (rr)]; sn1 = TS_[2 * (rr) + 1]; wn0 = routeW[2 * (rr)]; wn1 = routeW[2 * (rr) + 1]; } while (0)
#define NRM_YROW() do { wc0 = wn0; wc1 = wn1; _Pragma("unroll") for (int j = 0; j < 4; ++j) { const int c = 4 * F.lane + 256 * j; yn0[j] = *(const unsigned long long*)(Y_ + (size_t)sn0 * D + c); yn1[j] = *(const unsigned long long*)(Y_ + (size_t)sn1 * D + c); } } while (0)
    if (r0_ < r1_) { const int b = r0_ / RB, t = r0_ - b * RB; const float* xr = (t < SEQ) ? outp + (size_t)(b * SEQ + t) * D : xc + (size_t)(b * CTXL + t - SEQ) * D;
        if (MOEADD) NRM_ROUTE(r0_);
#pragma unroll
        for (int j = 0; j < 4; ++j) vn[j] = *(const f32x4*)(xr + 4 * F.lane + 256 * j);
        if (MOEADD) { NRM_YROW(); if (r0_ + 1 < r1_) NRM_ROUTE(r0_ + 1); } }
    for (int r = r0_; r < r1_; ++r) {
        const int b = r / RB, t = r - b * RB;
        { const int key = (t < SEQ) ? b : NB;
          if (key != mkey) { mkey = key; const float* mp = MOD + (size_t)key * 6144 + (which ? 3 : 0) * D;
#pragma unroll
            for (int j = 0; j < 4; ++j) { const int c = 4 * F.lane + 256 * j; const f32x4 g = *(const f32x4*)(G + c), sh = *(const f32x4*)(mp + c), sc = *(const f32x4*)(mp + D + c); mg[j] = g * (sc + 1.f); msh[j] = sh;
                if (MOEADD) g5v[j] = *(const f32x4*)(MOD - 17 * 6144 + (size_t)key * 6144 + 5 * D + c); } } }
        f32x4 v[4]; float s = 0.f;
#pragma unroll
        for (int j = 0; j < 4; ++j) v[j] = vn[j];
        unsigned long long y0[4], y1[4]; const float w0 = wc0, w1 = wc1;
        if (MOEADD) {
#pragma unroll
            for (int j = 0; j < 4; ++j) { y0[j] = yn0[j]; y1[j] = yn1[j]; } }
        if (r + 1 < r1_) { const int b2 = (r + 1) / RB, t2 = (r + 1) - b2 * RB; const float* xr = (t2 < SEQ) ? outp + (size_t)(b2 * SEQ + t2) * D : xc + (size_t)(b2 * CTXL + t2 - SEQ) * D;
#pragma unroll
            for (int j = 0; j < 4; ++j) vn[j] = *(const f32x4*)(xr + 4 * F.lane + 256 * j);
            if (MOEADD) { NRM_YROW(); if (r + 2 < r1_) NRM_ROUTE(r + 2); } }
        if (lat_only && t >= SEQ) continue;
        if (MOEADD) { float* xw = (t < SEQ) ? ARG_OUT + (size_t)(b * SEQ + t) * D : xc + (size_t)(b * CTXL + t - SEQ) * D;
#pragma unroll
            for (int j = 0; j < 4; ++j) { const int c = 4 * F.lane + 256 * j;
                f32x4 a0, a1; a0.x = __uint_as_float((unsigned)y0[j] << 16); a0.y = __uint_as_float((unsigned)y0[j] & 0xffff0000u); a0.z = __uint_as_float((unsigned)(y0[j] >> 32) << 16); a0.w = __uint_as_float((unsigned)(y0[j] >> 32) & 0xffff0000u);
                a1.x = __uint_as_float((unsigned)y1[j] << 16); a1.y = __uint_as_float((unsigned)y1[j] & 0xffff0000u); a1.z = __uint_as_float((unsigned)(y1[j] >> 32) << 16); a1.w = __uint_as_float((unsigned)(y1[j] >> 32) & 0xffff0000u);
                v[j] = v[j] + g5v[j] * (a0 * w0 + a1 * w1); *(f32x4*)(xw + c) = v[j]; } }
#pragma unroll
        for (int j = 0; j < 4; ++j) s += (v[j].x * v[j].x + v[j].y * v[j].y) + (v[j].z * v[j].z + v[j].w * v[j].w);
        const float rs = 1.f / sqrtf(wave_sum(s) * (1.f / D) + 1e-6f);
#pragma unroll
        for (int j = 0; j < 4; ++j) { const int c = 4 * F.lane + 256 * j;
            v[j] = (v[j] * rs) * mg[j] + msh[j];
            if (OUT8) *(unsigned*)((unsigned char*)H + (size_t)r * D + c) = pk4_fp8(v[j].x, v[j].y, v[j].z, v[j].w);
            else *(unsigned long long*)(H + (size_t)r * D + c) = (unsigned long long)pk2(v[j].x, v[j].y) | ((unsigned long long)pk2(v[j].z, v[j].w) << 32); }
        if (ROUTER) {
            float lg[8];
#pragma unroll
            for (int e = 0; e < 8; ++e) lg[e] = 0.f;
#pragma unroll
            for (int j = 0; j < 4; ++j)
#pragma unroll
                for (int q = 0; q < 4; ++q) { const f32x4 w0 = *(const LAS f32x4*)(RW + (((j * 4 + q) * 2 + 0) * 64 + F.lane) * 4), w1 = *(const LAS f32x4*)(RW + (((j * 4 + q) * 2 + 1) * 64 + F.lane) * 4); const float hv = v[j][q];
                    lg[0] += hv * w0[0]; lg[1] += hv * w0[1]; lg[2] += hv * w0[2]; lg[3] += hv * w0[3]; lg[4] += hv * w1[0]; lg[5] += hv * w1[1]; lg[6] += hv * w1[2]; lg[7] += hv * w1[3]; }
#pragma unroll
            for (int e = 0; e < 8; ++e) lg[e] = wave_sum(lg[e]);
            int e0 = 0; float v0 = lg[0];
#pragma unroll
            for (int e = 1; e < 8; ++e) if (lg[e] > v0) { v0 = lg[e]; e0 = e; }
            int e1 = -1; float v1 = -INFINITY;
#pragma unroll
            for (int e = 0; e < 8; ++e) if (e != e0 && lg[e] > v1) { v1 = lg[e]; e1 = e; }
            if (F.lane == 0) { const float w0 = 1.f / (1.f + __expf(v1 - v0));
                routeE[r] = e0 | (e1 << 8); routeW[2 * r] = w0; routeW[2 * r + 1] = 1.f - w0;
                __hip_atomic_fetch_add(&LC[e0], 1u, __ATOMIC_RELAXED, __HIP_MEMORY_SCOPE_WORKGROUP); __hip_atomic_fetch_add(&LC[e1], 1u, __ATOMIC_RELAXED, __HIP_MEMORY_SCOPE_WORKGROUP); }
        }
    }
    if (ROUTER) { __syncthreads(); if (F.tid < 8) { const unsigned c = LC[F.tid]; if (c) __hip_atomic_fetch_add(F.ctl + CW_MOE + 1024 * (l >> 1) + F.tid, c, RLX_AGENT); } __syncthreads(); }
#undef NRM_ROUTE
#undef NRM_YROW
}

template <bool EVEN>
__device__ __forceinline__ void qkpost_phase(const Frame& F, int l) {
    constexpr int NH = EVEN ? 10 : 32, NQ = EVEN ? 8 : 16, P = EVEN ? EV_P : OD_IN;
    bf16* base = (bf16*)(ARG_WS + WS_R1);
    const float* cosT = (const float*)(ARG_WS + WS_ROPE); const float* sinT = cosT + 1024;
    const float* qg = ARG_IN(12) + (l >> 1) * 64; const float* kg = ARG_IN(13) + (l >> 1) * 64;
    const int k = F.lane & 7, sub = F.lane >> 3;
    const long total = (long)M_ALL * NH, step = (long)F.G * NWAVES * 8;
    for (long it = ((long)(F.vcu * NWAVES + F.wave)) * 8 + sub; it < total; it += step) {
        const int r = (int)(it / NH), h = (int)(it - (long)r * NH); const int b = r / RB, t = r - b * RB; const bool isq = h < NQ;
        if (!EVEN && t >= SEQ && !isq) continue;
        bf16* p = base + (size_t)r * P + (EVEN ? (isq ? 512 + 64 * h : 1024 + 64 * (h - 8)) : (isq ? 64 * h : 1024 + 64 * (h - 16))) + 8 * k;
        const v4u raw = *(const v4u*)p; float x[8];
#pragma unroll
        for (int e = 0; e < 4; ++e) { x[2 * e] = __uint_as_float(raw[e] << 16); x[2 * e + 1] = __uint_as_float(raw[e] & 0xffff0000u); }
        if (EVEN) { float ss = 0.f;
#pragma unroll
            for (int e = 0; e < 8; ++e) ss += x[e] * x[e];
            ss += __shfl_xor(ss, 1); ss += __shfl_xor(ss, 2); ss += __shfl_xor(ss, 4);
            const float rs = 1.f / sqrtf(ss * (1.f / 64.f) + 1e-6f); const float* g = (isq ? qg : kg) + 8 * k;
#pragma unroll
            for (int e = 0; e < 8; ++e) x[e] = x[e] * rs * g[e]; }
        float y[8];
#pragma unroll
        for (int e = 0; e < 8; ++e) y[e] = __shfl_xor(x[e], 2);
        if (t < SEQ) { const int pv_ = (k >> 2) ? (t & 63) : (t >> 6); const float* cp = cosT + pv_ * 16 + (k & 1) * 8; const float* sp = sinT + pv_ * 16 + (k & 1) * 8; const float sg = (k & 2) ? 1.f : -1.f;
#pragma unroll
            for (int e = 0; e < 8; ++e) x[e] = x[e] * cp[e] + sg * y[e] * sp[e]; }
        if (isq) {
#pragma unroll
            for (int e = 0; e < 8; ++e) x[e] *= QSCALE; }
        v4u o; o.x = pk2(x[0], x[1]); o.y = pk2(x[2], x[3]); o.z = pk2(x[4], x[5]); o.w = pk2(x[6], x[7]);
        *(v4u*)p = o;
    }
}

__device__ __forceinline__ void conv_phase(const Frame& F, int l) {
    const int i = l >> 1;
    LAS unsigned char* TILE = F.lds;
    LAS float* CW = (LAS float*)(F.lds + 63488);
    const bf16* EV = (const bf16*)(ARG_WS + WS_R1); bf16* MIX = (bf16*)(ARG_WS + WS_H);
    { const float* cw = ARG_IN(9) + (size_t)i * 31 * 512; for (int k = F.tid; k < 31 * 512; k += 512) { const int j = k >> 9, ch = k & 511; CW[(j * 2 + ((ch >> 2) & 1)) * 256 + (ch >> 3) * 4 + (ch & 3)] = cw[k]; } }
    float lg[8], lb[8]; const float* lng_ = ARG_IN(10); const float* lnb_ = ARG_IN(11);
#pragma unroll
    for (int c = 0; c < 8; ++c) { lg[c] = lng_[i * 512 + 8 * F.lane + c]; lb[c] = lnb_[i * 512 + 8 * F.lane + c]; }
    const int NU = NB * 72;
    for (int u = F.vcu; u < NU; u += F.G) {
        const int b = u / 72, v = u - b * 72; const bool lat = v < 64; const int t0 = lat ? 32 * v : 32 * (v - 64), L = lat ? SEQ : CTXL, rbase = b * RB + (lat ? 0 : SEQ);
        __syncthreads();
        for (int rr = F.wave; rr < 62; rr += NWAVES) { const int t = t0 - 15 + rr; v4u val = (v4u){0u, 0u, 0u, 0u};
            if (t >= 0 && t < L) val = *(const v4u*)(EV + (size_t)(rbase + t) * EV_P + 8 * F.lane);
            *(LAS v4u*)(TILE + rr * 1024 + 16 * F.lane) = val; }
        __syncthreads();
        float acc[4][8];
#pragma unroll
        for (int q = 0; q < 4; ++q)
#pragma unroll
            for (int c = 0; c < 8; ++c) acc[q][c] = 0.f;
#pragma unroll 2
        for (int j = 0; j < 31; ++j) {
            const f32x4 w0 = *(const LAS f32x4*)(CW + (j * 2) * 256 + 4 * F.lane), w1 = *(const LAS f32x4*)(CW + (j * 2 + 1) * 256 + 4 * F.lane);
#pragma unroll
            for (int q = 0; q < 4; ++q) { const v4u raw = *(const LAS v4u*)(TILE + (4 * F.wave + q + j) * 1024 + 16 * F.lane);
                acc[q][0] += __uint_as_float(raw[0] << 16) * w0[0]; acc[q][1] += __uint_as_float(raw[0] & 0xffff0000u) * w0[1];
                acc[q][2] += __uint_as_float(raw[1] << 16) * w0[2]; acc[q][3] += __uint_as_float(raw[1] & 0xffff0000u) * w0[3];
                acc[q][4] += __uint_as_float(raw[2] << 16) * w1[0]; acc[q][5] += __uint_as_float(raw[2] & 0xffff0000u) * w1[1];
                acc[q][6] += __uint_as_float(raw[3] << 16) * w1[2]; acc[q][7] += __uint_as_float(raw[3] & 0xffff0000u) * w1[3]; }
        }
#pragma unroll
        for (int q = 0; q < 4; ++q) {
            float s = 0.f;
#pragma unroll
            for (int c = 0; c < 8; ++c) s += acc[q][c];
            const float mean = wave_sum(s) * (1.f / 512.f); float s2 = 0.f;
#pragma unroll
            for (int c = 0; c < 8; ++c) { acc[q][c] -= mean; s2 += acc[q][c] * acc[q][c]; }
            const float rstd = 1.f / sqrtf(wave_sum(s2) * (1.f / 512.f) + 1e-5f);
            float o[8];
#pragma unroll
            for (int c = 0; c < 8; ++c) o[c] = fast_silu(acc[q][c] * rstd * lg[c] + lb[c]);
            v4u w; w.x = pk2(o[0], o[1]); w.y = pk2(o[2], o[3]); w.z = pk2(o[4], o[5]); w.w = pk2(o[6], o[7]);
            *(v4u*)(MIX + (size_t)(rbase + t0 + 4 * F.wave + q) * D + 8 * F.lane) = w;
        }
    }
    __syncthreads();
}

__device__ __forceinline__ void attn_even_phase(const Frame& F, unsigned char* lds_generic) {
    using abf = attn_body::bf16;
    const abf* EV = (const abf*)(ARG_WS + WS_R1); abf* MIX = (abf*)(ARG_WS + WS_H);
    const int NLAT = NB * 8 * 8, per = (NLAT + F.G - 1) / F.G;
    for (int id = F.vcu * per; id < (F.vcu + 1) * per && id < NLAT; ++id) {
        const int qb = id & 7, h = ((id >> 5) & 1) * 4 + ((id >> 3) & 3), b = id >> 6;
        const size_t r0 = (size_t)b * RB;
        attn_body::attn_unit<8, EV_P, EV_P, EV_P, D>(EV + (r0 + qb * 256) * EV_P + 512 + 64 * h, EV + r0 * EV_P + 1024 + 64 * (h >> 2), EV + r0 * EV_P + 1152 + 64 * (h >> 2),
                                MIX + (r0 + qb * 256) * D + 512 + 64 * h, 36, (char*)lds_generic, F.tid);
    }
    const int NCTX = NB * 8, perc = (NCTX + F.G - 1) / F.G;
    const int cv_ = (F.G >= 2 * NCTX) ? F.vcu - (F.G - NCTX) : F.vcu;
    for (int id = cv_ * perc; cv_ >= 0 && id < (cv_ + 1) * perc && id < NCTX; ++id) {
        const int h = id & 7, b = id >> 3; const size_t r0 = (size_t)b * RB + SEQ;
        attn_body::attn_unit<8, EV_P, EV_P, EV_P, D>(EV + r0 * EV_P + 512 + 64 * h, EV + r0 * EV_P + 1024 + 64 * (h >> 2), EV + r0 * EV_P + 1152 + 64 * (h >> 2),
                                MIX + r0 * D + 512 + 64 * h, 4, (char*)lds_generic, F.tid);
    }
}
__device__ __forceinline__ void diffcomb_rows(const Frame& F, int l, int rbase, int nrows, int h) {
    const bf16* OP = (const bf16*)(ARG_WS + WS_R1 + R1_OPART); bf16* MIX = (bf16*)(ARG_WS + WS_H);
    const float* lp = ARG_IN(19) + (l >> 1) * 256; const float lam_init = 0.8f - 0.6f * expf(-0.3f * (float)l);
    const float lam = expf(wave_sum(lp[F.lane] * lp[64 + F.lane])) - expf(wave_sum(lp[128 + F.lane] * lp[192 + F.lane])) + lam_init;
    const int k = F.lane & 15, sub = F.lane >> 4; const float* sg = ARG_IN(20) + (l >> 1) * 128 + 8 * k; const float osc = 1.f - lam_init;
    const bool out8 = ((W8OUT_MASK >> (l >> 1)) & 1) != 0;
    float g[8];
#pragma unroll
    for (int e = 0; e < 8; ++e) g[e] = sg[e] * osc;
    for (int it0 = F.wave * 4 + sub; it0 < nrows; it0 += NWAVES * 16) {
        v4u a[4], c[4];
#pragma unroll
        for (int q = 0; q < 4; ++q) { const bf16* p = OP + (size_t)(rbase + it0 + q * NWAVES * 4) * OP_P + h * 256 + 8 * k; a[q] = *(const v4u*)p; c[q] = *(const v4u*)(p + 128); }
#pragma unroll
        for (int q = 0; q < 4; ++q) { const int r = rbase + it0 + q * NWAVES * 4; float x[8]; float ss = 0.f;
#pragma unroll
            for (int e = 0; e < 4; ++e) { x[2 * e] = __uint_as_float(a[q][e] << 16) - lam * __uint_as_float(c[q][e] << 16); x[2 * e + 1] = __uint_as_float(a[q][e] & 0xffff0000u) - lam * __uint_as_float(c[q][e] & 0xffff0000u); }
#pragma unroll
            for (int e = 0; e < 8; ++e) ss += x[e] * x[e];
#define DC_DPP(ctrl) ss += __int_as_float(__builtin_amdgcn_update_dpp(0, __float_as_int(ss), (ctrl), 0xf, 0xf, true))
            DC_DPP(0xB1); DC_DPP(0x4E); DC_DPP(0x141); DC_DPP(0x140);
#undef DC_DPP
            const float rs = 1.f / sqrtf(ss * (1.f / 128.f) + 1e-6f);
            v4u o; o.x = pk2(x[0] * rs * g[0], x[1] * rs * g[1]); o.y = pk2(x[2] * rs * g[2], x[3] * rs * g[3]); o.z = pk2(x[4] * rs * g[4], x[5] * rs * g[5]); o.w = pk2(x[6] * rs * g[6], x[7] * rs * g[7]);
            if (out8) { typedef unsigned u32x2_ __attribute__((ext_vector_type(2))); u32x2_ o8; o8.x = pk4_fp8(x[0] * rs * g[0], x[1] * rs * g[1], x[2] * rs * g[2], x[3] * rs * g[3]); o8.y = pk4_fp8(x[4] * rs * g[4], x[5] * rs * g[5], x[6] * rs * g[6], x[7] * rs * g[7]);
                *(u32x2_*)((unsigned char*)MIX + (size_t)r * D + h * 128 + 8 * k) = o8; }
            else *(v4u*)(MIX + (size_t)r * D + h * 128 + 8 * k) = o; }
    }
}
__device__ __forceinline__ void attn_odd_phase(const Frame& F, unsigned char* lds_generic, bool need_ctx, int l) {
    using abf = attn_body::bf16;
    const abf* QKV = (const abf*)(ARG_WS + WS_R1); abf* OP = (abf*)(ARG_WS + WS_R1 + R1_OPART);
    const int NLAT = NB * 32 * 8;
    if (F.G * 16 == NLAT) {
        const int b = F.vcu >> 4, h = (F.vcu >> 1) & 7, qh = F.vcu & 1; const size_t r0 = (size_t)b * RB;
#if DIFF_V128
        for (int j = 0; j < 8; ++j) { const int qb = qh * 4 + (j & 3), c = j >> 2;
            attn_body::attn_unit_v128<8, OD_IN, OD_IN, OD_IN, OP_P>(QKV + (r0 + qb * 256) * OD_IN + (h * 2 + c) * 64, QKV + r0 * OD_IN + 1024 + (h * 2 + c) * 64, QKV + r0 * OD_IN + 2048 + h * 128,
                                OP + (r0 + qb * 256) * OP_P + h * 256 + c * 128, 36, (char*)lds_generic, F.tid); }
#else
        for (int j = 0; j < 16; ++j) { const int qb = qh * 4 + (j & 3), cv = j >> 2, c = cv >> 1, vh = cv & 1;
            attn_body::attn_unit<8, OD_IN, OD_IN, OD_IN, OP_P>(QKV + (r0 + qb * 256) * OD_IN + (h * 2 + c) * 64, QKV + r0 * OD_IN + 1024 + (h * 2 + c) * 64, QKV + r0 * OD_IN + 2048 + h * 128 + vh * 64,
                                OP + (r0 + qb * 256) * OP_P + h * 256 + c * 128 + vh * 64, 36, (char*)lds_generic, F.tid); }
#endif
        VM_WAIT(); __syncthreads();
        diffcomb_rows(F, l, b * RB + qh * 1024, 1024, h);
        if (need_ctx && F.vcu < NB * 8) { const int bc = F.vcu >> 3, hc = F.vcu & 7; const size_t rc = (size_t)bc * RB + SEQ;
#if DIFF_V128
            for (int c = 0; c < 2; ++c)
                attn_body::attn_unit_v128<8, OD_IN, OD_IN, OD_IN, OP_P>(QKV + rc * OD_IN + (hc * 2 + c) * 64, QKV + rc * OD_IN + 1024 + (hc * 2 + c) * 64, QKV + rc * OD_IN + 2048 + hc * 128,
                                    OP + rc * OP_P + hc * 256 + c * 128, 4, (char*)lds_generic, F.tid);
#else
            for (int cv = 0; cv < 4; ++cv) { const int c = cv >> 1, vh = cv & 1;
                attn_body::attn_unit<8, OD_IN, OD_IN, OD_IN, OP_P>(QKV + rc * OD_IN + (hc * 2 + c) * 64, QKV + rc * OD_IN + 1024 + (hc * 2 + c) * 64, QKV + rc * OD_IN + 2048 + hc * 128 + vh * 64,
                                    OP + rc * OP_P + hc * 256 + c * 128 + vh * 64, 4, (char*)lds_generic, F.tid); }
#endif
            VM_WAIT(); __syncthreads();
            diffcomb_rows(F, l, bc * RB + SEQ, CTXL, hc); }
        return;
    }
    const int per = (NLAT + F.G - 1) / F.G;
    for (int id = F.vcu * per; id < (F.vcu + 1) * per && id < NLAT; ++id) {
        const int qb = id & 7, cv = (id >> 3) & 3, h = (id >> 5) & 7, b = id >> 8; const int c = cv >> 1, vh = cv & 1;
        const size_t r0 = (size_t)b * RB;
        attn_body::attn_unit<8, OD_IN, OD_IN, OD_IN, OP_P>(QKV + (r0 + qb * 256) * OD_IN + (h * 2 + c) * 64, QKV + r0 * OD_IN + 1024 + (h * 2 + c) * 64, QKV + r0 * OD_IN + 2048 + h * 128 + vh * 64,
                                OP + (r0 + qb * 256) * OP_P + h * 256 + c * 128 + vh * 64, 36, (char*)lds_generic, F.tid);
    }
    if (need_ctx) {
        const int NCTX = NB * 32, perc = (NCTX + F.G - 1) / F.G;
        for (int id = F.vcu * perc; id < (F.vcu + 1) * perc && id < NCTX; ++id) {
            const int cv = id & 3, h = (id >> 2) & 7, b = id >> 5; const int c = cv >> 1, vh = cv & 1; const size_t r0 = (size_t)b * RB + SEQ;
            attn_body::attn_unit<8, OD_IN, OD_IN, OD_IN, OP_P>(QKV + r0 * OD_IN + (h * 2 + c) * 64, QKV + r0 * OD_IN + 1024 + (h * 2 + c) * 64, QKV + r0 * OD_IN + 2048 + h * 128 + vh * 64,
                                    OP + r0 * OP_P + h * 256 + c * 128 + vh * 64, 4, (char*)lds_generic, F.tid);
        }
    }
}
__device__ __forceinline__ void diffcomb_phase(const Frame& F, int l, bool need_ctx) {
    if (F.G * 16 == NB * 32 * 8) return;
    for (int u = F.vcu; u < NB * 8; u += F.G) { const int b = u >> 3, h = u & 7; diffcomb_rows(F, l, b * RB, need_ctx ? RB : SEQ, h); }
}

__device__ __forceinline__ void moe_tables(const Frame& F, int i) {
    LAS int* TAB = (LAS int*)(F.lds + TAB_OFF);
    __syncthreads();
    if (F.tid == 0) { int ts = 0;
        for (int g = 0; g < 8; ++g) { const unsigned c = __hip_atomic_load(F.ctl + CW_MOE + 1024 * i + g, RLX_AGENT); const int nt = (int)((c + 255u) >> 8); TAB[320 + g] = ts;
            for (int q = 0; q < nt && ts + q < MAX_SLOT_TILES; ++q) TAB[ts + q] = g; ts += nt; }
        TAB[336] = ts < MAX_SLOT_TILES ? ts : MAX_SLOT_TILES; }
    __syncthreads();
}
template <bool F8>
__device__ __forceinline__ void moe_assign_phase(const Frame& F, int l, bool lat_only) {
    const int i = l >> 1; moe_tables(F, i);
    LAS int* TAB = (LAS int*)(F.lds + TAB_OFF);
    LAS unsigned* LCNT = (LAS unsigned*)(F.lds);
    LAS int* SL = (LAS int*)(F.lds + 256);
    const int* RE = (const int*)(ARG_WS + WS_ROUTE_E); const float* RWt = (const float*)(ARG_WS + WS_ROUTE_W);
    int* ST = (int*)(ARG_WS + WS_SLOT_TOK); float* SW = (float*)(ARG_WS + WS_SLOT_W);
    const int chunk = (M_ALL + F.G - 1) / F.G, r0 = F.vcu * chunk, nr = (r0 + chunk <= M_ALL) ? chunk : (M_ALL > r0 ? M_ALL - r0 : 0);
    for (int base = 0; base < nr; base += 512) {
        if (F.tid < 32) LCNT[F.tid] = 0u;
        __syncthreads();
        const int r = r0 + base + F.tid; const bool valid = (base + F.tid < nr) && !(lat_only && (r % RB) >= SEQ);
        int e0 = 0, e1 = 0; unsigned lr0 = 0, lr1 = 0;
        if (valid) { const int ee = RE[r]; e0 = ee & 255; e1 = ee >> 8; lr0 = __hip_atomic_fetch_add(&LCNT[e0], 1u, __ATOMIC_RELAXED, __HIP_MEMORY_SCOPE_WORKGROUP); lr1 = __hip_atomic_fetch_add(&LCNT[e1], 1u, __ATOMIC_RELAXED, __HIP_MEMORY_SCOPE_WORKGROUP); }
        __syncthreads();
        if (F.tid < 8) { const unsigned c = LCNT[F.tid]; LCNT[16 + F.tid] = c ? __hip_atomic_fetch_add(F.ctl + CW_MOE + 1024 * i + 64 + F.tid, c, RLX_AGENT) : 0u; }
        __syncthreads();
        int s0 = -1, s1 = -1;
        if (valid) { s0 = TAB[320 + e0] * 256 + (int)(LCNT[16 + e0] + lr0); s1 = TAB[320 + e1] * 256 + (int)(LCNT[16 + e1] + lr1);
            if (s0 < MAX_SLOTS) { ST[s0] = r; SW[s0] = RWt[2 * r]; } else s0 = -1;
            if (s1 < MAX_SLOTS) { ST[s1] = r; SW[s1] = RWt[2 * r + 1]; } else s1 = -1; }
        if (base + F.tid < nr) { SL[2 * F.tid] = s0; SL[2 * F.tid + 1] = s1; if (valid) { int* TS = (int*)(ARG_WS + WS_TOKSLOT); TS[2 * r] = s0; TS[2 * r + 1] = s1; } }
        __syncthreads();
        const int ncp = 2 * ((nr - base) < 512 ? (nr - base) : 512);
        const bf16* H = (const bf16*)(ARG_WS + WS_H); bf16* HP = (bf16*)(ARG_WS + WS_HP);
        for (int cp0 = F.wave; cp0 < ncp; cp0 += 4 * NWAVES) {
            v4u x0[4], x1[4]; int sl[4];
#pragma unroll
            for (int q = 0; q < 4; ++q) { const int cp = cp0 + q * NWAVES; sl[q] = (cp < ncp) ? SL[cp] : -1; const int rr = r0 + base + (cp >> 1);
                if (sl[q] >= 0) { if (F8) x0[q] = ((const v4u*)((const unsigned char*)H + (size_t)rr * D))[F.lane]; else { const v4u* src = (const v4u*)(H + (size_t)rr * D) + F.lane; x0[q] = src[0]; x1[q] = src[64]; } } }
#pragma unroll
            for (int q = 0; q < 4; ++q) if (sl[q] >= 0) { if (F8) ((v4u*)((unsigned char*)HP + (size_t)sl[q] * D))[F.lane] = x0[q]; else { v4u* dst = (v4u*)(HP + (size_t)sl[q] * D) + F.lane; dst[0] = x0[q]; dst[64] = x1[q]; } }
        }
        __syncthreads();
    }
}

__device__ __forceinline__ void final_phase(const Frame& F) {
    const float* G = ARG_IN(26); float* outp = ARG_OUT; unsigned char* ws_ = ARG_WS; const int gw = F.vcu * NWAVES + F.wave, NGW = F.G * NWAVES;
    const int* TS = (const int*)(ws_ + WS_TOKSLOT); const float* RWt = (const float*)(ws_ + WS_ROUTE_W); const bf16* Y = (const bf16*)(ws_ + WS_HP);
    const float* MOD3 = (const float*)(ws_ + WS_MOD) + (size_t)3 * 17 * 6144 + 5 * D;
    const int RPW = (NB * SEQ + NGW - 1) / NGW, r0_ = gw * RPW, r1_ = (r0_ + RPW < NB * SEQ) ? r0_ + RPW : NB * SEQ;
    if (r0_ >= r1_) return;
    f32x4 gf[4];
#pragma unroll
    for (int j = 0; j < 4; ++j) gf[j] = *(const f32x4*)(G + 4 * F.lane + 256 * j);
    int sn0, sn1; float wn0, wn1;
    f32x4 xn[4]; unsigned long long yn0[4], yn1[4]; float wc0, wc1;
#define FIN_ROUTE(rl) do { const int b_ = (rl) / SEQ, r_ = b_ * RB + ((rl) - b_ * SEQ); sn0 = TS[2 * r_]; sn1 = TS[2 * r_ + 1]; wn0 = RWt[2 * r_]; wn1 = RWt[2 * r_ + 1]; } while (0)
#define FIN_ROW(rl) do { const float* xr_ = outp + (size_t)(rl) * D; wc0 = wn0; wc1 = wn1; \
        _Pragma("unroll") for (int j = 0; j < 4; ++j) { const int c = 4 * F.lane + 256 * j; xn[j] = *(const f32x4*)(xr_ + c); yn0[j] = *(const unsigned long long*)(Y + (size_t)sn0 * D + c); yn1[j] = *(const unsigned long long*)(Y + (size_t)sn1 * D + c); } } while (0)
    FIN_ROUTE(r0_); FIN_ROW(r0_); if (r0_ + 1 < r1_) FIN_ROUTE(r0_ + 1);
    int gkey = -1; f32x4 g5v[4];
    for (int rl = r0_; rl < r1_; ++rl) { float* xr = outp + (size_t)rl * D; const int b = rl / SEQ; f32x4 v[4]; float s = 0.f;
        if (b != gkey) { gkey = b; const float* g5 = MOD3 + (size_t)b * 6144;
#pragma unroll
            for (int j = 0; j < 4; ++j) g5v[j] = *(const f32x4*)(g5 + 4 * F.lane + 256 * j); }
        unsigned long long y0[4], y1[4]; const float w0 = wc0, w1 = wc1;
#pragma unroll
        for (int j = 0; j < 4; ++j) { v[j] = xn[j]; y0[j] = yn0[j]; y1[j] = yn1[j]; }
        if (rl + 1 < r1_) FIN_ROW(rl + 1);
        if (rl + 2 < r1_) FIN_ROUTE(rl + 2);
#pragma unroll
        for (int j = 0; j < 4; ++j) {
            f32x4 a0, a1; a0.x = __uint_as_float((unsigned)y0[j] << 16); a0.y = __uint_as_float((unsigned)y0[j] & 0xffff0000u); a0.z = __uint_as_float((unsigned)(y0[j] >> 32) << 16); a0.w = __uint_as_float((unsigned)(y0[j] >> 32) & 0xffff0000u);
            a1.x = __uint_as_float((unsigned)y1[j] << 16); a1.y = __uint_as_float((unsigned)y1[j] & 0xffff0000u); a1.z = __uint_as_float((unsigned)(y1[j] >> 32) << 16); a1.w = __uint_as_float((unsigned)(y1[j] >> 32) & 0xffff0000u);
            v[j] = v[j] + g5v[j] * (a0 * w0 + a1 * w1);
            s += (v[j].x * v[j].x + v[j].y * v[j].y) + (v[j].z * v[j].z + v[j].w * v[j].w); }
        const float rs = 1.f / sqrtf(wave_sum(s) * (1.f / D) + 1e-6f);
#pragma unroll
        for (int j = 0; j < 4; ++j) { const int c = 4 * F.lane + 256 * j; *(f32x4*)(xr + c) = (v[j] * rs) * gf[j]; } }
#undef FIN_ROUTE
#undef FIN_ROW
}

constexpr int PH_PAIR = 21, NPH = 2 + 2 * PH_PAIR;
#ifndef MK_ONE_LAUNCH
#define MK_ONE_LAUNCH 0
#endif
#ifndef PROBE_DUP
#define PROBE_DUP 0
#endif
#define IN(k) (lo <= (k) && (k) < hi)
#if PROBE_UDUP >= 0
#define PROBE_U(k) do { if (PROBE_UDUP == (k)) S.so.tot = S.so.nwg * 2; } while (0)
#else
#define PROBE_U(k) do { } while (0)
#endif
#define REPS(k) (((PROBE_DUP >> (k)) & 1) ? 2 : 1)
#define FRESH(tag) do { int z_; asm volatile("s_mov_b32 %0, 0 ; MARK " tag : "=s"(z_) :: "memory"); F.lane = (int)__builtin_amdgcn_mbcnt_hi(~0u, __builtin_amdgcn_mbcnt_lo(~0u, (unsigned)z_)); F.tid = F.wave * 64 + F.lane; } while (0)
#define SEAM(k) do { if (IN(k) && IN((k) + 1)) xcd_barrier(bar, F.tid); } while (0)
#define WSP(off) (ARG_WS + (off))
#define H_ ((bf16_t*)WSP(WS_H))
#define WT_ ((bf16_t*)WSP(WS_WT))
#define R1_ ((bf16_t*)WSP(WS_R1))
#define XC_ ((float*)WSP(WS_XC))
#define MODL(l) ((const float*)WSP(WS_MOD) + (size_t)(l) * 17 * 6144)
template <int I>
__device__ __forceinline__ void layer_pair(Frame& F, const XcdBarrier& bar, const int lo, const int hi, unsigned char* lds, int bx) {
    using namespace pg8;
    const PG8_LAS int* TAB = (const PG8_LAS int*)(F.lds + TAB_OFF);
    constexpr int il = I; constexpr int pb = 1 + PH_PAIR * il;
    constexpr bool W8W = (W8OUT_MASK >> I) & 1;
    constexpr bool W8E = (W8EV_MASK >> I) & 1;
    constexpr bool W8O = (W8IN_MASK >> I) & 1;
    constexpr bool F8E = (F8_MASK >> (2 * I)) & 1, F8O = (F8_MASK >> (2 * I + 1)) & 1, F8DE = (F8D_MASK >> (2 * I)) & 1, F8DO = (F8D_MASK >> (2 * I + 1)) & 1;
        { const int l = 2 * il;
        FRESH("0"); if (IN(pb + 0)) for (int rep_ = 0; rep_ < REPS(0); ++rep_) { if (rep_) xcd_barrier(bar, F.tid); if (I != 0) { } }

        FRESH("1"); if (IN(pb + 1)) for (int rep_ = 0; rep_ < REPS(1); ++rep_) { if (rep_) xcd_barrier(bar, F.tid); if (I != 0) wconv_phase<F8E, F8DE, false, false, W8E>(F, l); norm_phase<false, W8E, (I != 0)>(F, l, 0, false); }
        SEAM(pb + 1);
        FRESH("2"); if (IN(pb + 2)) for (int rep_ = 0; rep_ < REPS(2); ++rep_) { if (rep_) xcd_barrier(bar, F.tid); Gemm g{H_, WT_ + WT_IN / 2, M_ALL, EV_IN, W8E ? D / 2 : D}; MapOrder S; S.init(M_ALL / 256, EV_IN / 256, F.G, bx, 0, (W8E ? D / 2 : D) / 64); PROBE_U(2); EpiEvenIn2 E{R1_, (const float*)WSP(WS_ROPE), ARG_IN(12) + il * 64, ARG_IN(13) + il * 64, (PG8_LAS float*)(F.lds + SS_OFF), W8E ? 1.f / 32.f : 1.f};
            gemm_phase<EpiEvenIn2, MapOrder, true, true, W8E>(F.lds + RING_OFF, g, S, E, F.tid); }
        SEAM(pb + 2);
        FRESH("3"); if (IN(pb + 3)) for (int rep_ = 0; rep_ < REPS(3); ++rep_) { if (rep_) xcd_barrier(bar, F.tid); }
        FRESH("4"); if (IN(pb + 4)) for (int rep_ = 0; rep_ < REPS(4); ++rep_) { if (rep_) xcd_barrier(bar, F.tid); conv_phase(F, l); attn_even_phase(F, lds); }
        SEAM(pb + 4);
        FRESH("5"); if (IN(pb + 5)) for (int rep_ = 0; rep_ < REPS(5); ++rep_) { if (rep_) xcd_barrier(bar, F.tid); Gemm g{H_, WT_ + WT_OUT / 2, M_ALL, D, D}; MapOrder S; S.init(M_ALL / 256, D / 256, F.G, bx, 0, D / 64, 1); PROBE_U(5); EpiResid E{ARG_OUT, XC_, MODL(l) + 2 * D, 1.f, (l == 0) ? ARG_IN(0) : (const float*)ARG_OUT};
            gemm_phase<EpiResid, MapOrder, true, true>(F.lds + RING_OFF, g, S, E, F.tid); }
        SEAM(pb + 5);
        FRESH("6"); if (IN(pb + 6)) for (int rep_ = 0; rep_ < REPS(6); ++rep_) { if (rep_) xcd_barrier(bar, F.tid); norm_phase<false, F8E>(F, l, 1, false); }
        SEAM(pb + 6);
        FRESH("7"); if (IN(pb + 7)) for (int rep_ = 0; rep_ < REPS(7); ++rep_) { if (rep_) xcd_barrier(bar, F.tid); Gemm g{H_, WT_ + WT_GU / 2, M_ALL, 2 * FF, F8E ? D / 2 : D}; MapOrder S; S.init(M_ALL / 256, 2 * FF / 256, F.G, bx, 0, (F8E ? D / 2 : D) / 64); PROBE_U(7); typedef typename std::conditional<F8DE, EpiSwiGLU8, EpiSwiGLU>::type EpiUp; EpiUp E{(decltype(EpiUp::ACT))R1_, 2 * FF / 256, F8E ? 1.f / 32.f : 1.f};
            gemm_phase<EpiUp, MapOrder, true, true, F8E>(F.lds + RING_OFF, g, S, E, F.tid); }
        SEAM(pb + 7);
        FRESH("8"); if (IN(pb + 8)) for (int rep_ = 0; rep_ < REPS(8); ++rep_) { if (rep_) xcd_barrier(bar, F.tid); Gemm g{R1_, WT_ + WT_DN / 2, M_ALL, D, F8DE ? FF / 2 : FF}; MapOrder S; S.init(M_ALL / 256, D / 256, F.G, bx, 0, (F8DE ? FF / 2 : FF) / 64, 1); PROBE_U(8); EpiResid E{ARG_OUT, XC_, MODL(l) + 5 * D, F8DE ? 1.f / 64.f : 1.f, (const float*)ARG_OUT};
            gemm_phase<EpiResid, MapOrder, true, true, F8DE>(F.lds + RING_OFF, g, S, E, F.tid); }
        SEAM(pb + 8);
        }
        { const int l = 2 * il + 1; const bool need_ctx = (l < 3);
        FRESH("9"); if (IN(pb + 9)) for (int rep_ = 0; rep_ < REPS(9); ++rep_) { if (rep_) xcd_barrier(bar, F.tid); }

        FRESH("10"); if (IN(pb + 10)) for (int rep_ = 0; rep_ < REPS(10); ++rep_) { if (rep_) xcd_barrier(bar, F.tid); wconv_phase<F8O, F8DO, W8O, W8W>(F, l); norm_phase<false, W8O>(F, l, 0, false); }
        SEAM(pb + 10);
        FRESH("11"); if (IN(pb + 11)) for (int rep_ = 0; rep_ < REPS(11); ++rep_) { if (rep_) xcd_barrier(bar, F.tid); Gemm g{H_, WT_ + WT_IN / 2, M_ALL, OD_IN, W8O ? D / 2 : D}; MapOrder S; S.init(M_ALL / 256, OD_IN / 256, F.G, bx, 0, (W8O ? D / 2 : D) / 64); PROBE_U(11); EpiOddIn E{R1_, (const float*)WSP(WS_ROPE), W8O ? 1.f / 32.f : 1.f};
            gemm_phase<EpiOddIn, MapOrder, true, true, W8O>(F.lds + RING_OFF, g, S, E, F.tid); }
        SEAM(pb + 11);
        FRESH("12"); if (IN(pb + 12)) for (int rep_ = 0; rep_ < REPS(12); ++rep_) { if (rep_) xcd_barrier(bar, F.tid); }
        FRESH("13"); if (IN(pb + 13)) for (int rep_ = 0; rep_ < REPS(13); ++rep_) { if (rep_) xcd_barrier(bar, F.tid); attn_odd_phase(F, lds, need_ctx, l); }
        if (F.G * 16 != NB * 32 * 8) SEAM(pb + 13);
        FRESH("14"); if (IN(pb + 14)) for (int rep_ = 0; rep_ < REPS(14); ++rep_) { if (rep_) xcd_barrier(bar, F.tid); diffcomb_phase(F, l, need_ctx); }
        SEAM(pb + 14);
        FRESH("15"); if (IN(pb + 15)) for (int rep_ = 0; rep_ < REPS(15); ++rep_) { if (rep_) xcd_barrier(bar, F.tid); Gemm g{H_, WT_ + WT_OUT / 2, M_ALL, D, W8W ? D / 2 : D}; MapOrder S; S.init(need_ctx ? M_ALL / 256 : NB * 8, D / 256, F.G, bx, need_ctx ? 0 : 1, (W8W ? D / 2 : D) / 64, 1); PROBE_U(15); EpiResid E{ARG_OUT, XC_, MODL(l) + 2 * D, W8W ? 1.f / 32.f : 1.f, (l == 0) ? ARG_IN(0) : (const float*)ARG_OUT};
            gemm_phase<EpiResid, MapOrder, true, true, W8W>(F.lds + RING_OFF, g, S, E, F.tid); }
        SEAM(pb + 15);
        FRESH("16"); if (IN(pb + 16)) for (int rep_ = 0; rep_ < REPS(16); ++rep_) { if (rep_) xcd_barrier(bar, F.tid); norm_phase<true, F8O>(F, l, 1, !need_ctx); }
        SEAM(pb + 16);
        FRESH("17"); if (IN(pb + 17)) for (int rep_ = 0; rep_ < REPS(17); ++rep_) { if (rep_) xcd_barrier(bar, F.tid); moe_assign_phase<F8O>(F, l, !need_ctx); }
        SEAM(pb + 17);
        FRESH("18"); if (IN(pb + 18)) for (int rep_ = 0; rep_ < REPS(18); ++rep_) { if (rep_) xcd_barrier(bar, F.tid); moe_tables(F, il); Gemm g{(const bf16_t*)WSP(WS_HP), WT_ + WT_GU / 2, MAX_SLOTS, NE * 2 * FF, F8O ? D / 2 : D}; MapOrder S; S.init(__builtin_amdgcn_readfirstlane(TAB[336]), 2 * FF / 256, F.G, bx, 2, (F8O ? D / 2 : D) / 64, 1, 0, 2 * FF / 256, TAB); PROBE_U(18); typedef typename std::conditional<F8DO, EpiSwiGLU8, EpiSwiGLU>::type EpiUp; EpiUp E{(decltype(EpiUp::ACT))R1_, 2 * FF / 256, F8O ? 1.f / 32.f : 1.f};
            gemm_phase<EpiUp, MapOrder, true, true, F8O>(F.lds + RING_OFF, g, S, E, F.tid); }
        SEAM(pb + 18);
        FRESH("19"); if (IN(pb + 19)) for (int rep_ = 0; rep_ < REPS(19); ++rep_) { if (rep_) xcd_barrier(bar, F.tid); moe_tables(F, il); Gemm g{R1_, WT_ + WT_DN / 2, MAX_SLOTS, NE * D, F8DO ? FF / 2 : FF}; MapOrder S; S.init(__builtin_amdgcn_readfirstlane(TAB[336]), D / 256, F.G, bx, 2, 0, 1, 0, D / 256, TAB); PROBE_U(19);
            EpiMoeY E{(bf16_t*)WSP(WS_HP), F8DO ? 1.f / 64.f : 1.f};
            gemm_phase<EpiMoeY, MapOrder, true, true, F8DO>(F.lds + RING_OFF, g, S, E, F.tid); }
        SEAM(pb + 19);
        }
}
__global__ void __launch_bounds__(NWAVES * 64, 2) fwd(Args args) {
    extern __shared__ __attribute__((aligned(16))) unsigned char lds[];
    Frame F;
    F.lds = (LAS unsigned char*)lds;
    F.tid = threadIdx.x; F.lane = F.tid & 63; F.wave = __builtin_amdgcn_readfirstlane(F.tid >> 6); asm volatile("" : "+s"(F.wave));
    F.G = gridDim.x; { const int bx = blockIdx.x; F.vcu = (F.G % 8 == 0) ? (bx % 8) * (F.G / 8) + bx / 8 : bx; }
    F.ctl = (gu32*)(args.ws + WS_CTL);
    for (int u = F.tid; u < (LDS_BYTES - LDSCTL_OFF) / 4; u += NWAVES * 64) ((LAS unsigned*)(F.lds + LDSCTL_OFF))[u] = 0u;
    __syncthreads();
    if (F.tid < 58) { const unsigned* ka = (const unsigned*)__builtin_amdgcn_kernarg_segment_ptr(); ((LAS unsigned*)(F.lds + ARGS_OFF))[F.tid] = ka[F.tid]; }
    __syncthreads();
    const int lo = args.ph_lo, hi = args.ph_hi; int bx = (int)blockIdx.x;
    XcdBarrier bar; bar.bar = (unsigned*)(F.ctl + CW_BAR); bar.x = 0; bar.st = nullptr;
    if (hi - lo > 1) bar = xcd_barrier_post((unsigned*)(F.ctl + CW_BAR), (volatile LAS unsigned*)(F.lds + MISC_OFF) + 8, F.tid);

    FRESH("P0"); if (IN(0)) { p0_phase(F); wconv_phase<(F8_MASK & 1) != 0, (F8D_MASK & 1) != 0, false, false, (W8EV_MASK & 1) != 0>(F, 0); }
    SEAM(0);
    layer_pair<0>(F, bar, lo, hi, lds, bx);
    layer_pair<1>(F, bar, lo, hi, lds, bx);
    FRESH("FINAL"); if (IN(NPH - 1)) final_phase(F);
#undef IN
#undef SEAM
}

extern "C" void kernel_launch(void* const* d_in, const int* in_sizes, int n_in, void* d_out, int out_size, void* d_ws, size_t ws_size, hipStream_t stream) {
    static int grid = 0;
    if (grid == 0) {
        if (n_in != 27 || out_size != NB * SEQ * D || ws_size < WS_END) { fprintf(stderr, "kernel_launch: unexpected shapes: n_in %d out %d ws %zu (need %zu)\n", n_in, out_size, ws_size, (size_t)WS_END); grid = -1; return; }
        int dev = 0, cus = 0, per_cu = 0;
        if (hipGetDevice(&dev) != hipSuccess || hipDeviceGetAttribute(&cus, hipDeviceAttributeMultiprocessorCount, dev) != hipSuccess) { grid = -1; return; }
        if (hipFuncSetAttribute((const void*)fwd, hipFuncAttributeMaxDynamicSharedMemorySize, LDS_BYTES) != hipSuccess) { fprintf(stderr, "kernel_launch: hipFuncSetAttribute failed\n"); grid = -1; return; }
        if (hipOccupancyMaxActiveBlocksPerMultiprocessor(&per_cu, (const void*)fwd, NWAVES * 64, LDS_BYTES) != hipSuccess || per_cu < 1) fprintf(stderr, "kernel_launch: occupancy query reports %d blocks per CU\n", per_cu);
        (void)hipGetLastError();
        grid = cus;
    }
    if (grid < 0) return;
    (void)hipMemsetAsync((char*)d_ws + WS_CTL, 0, CTL_ZERO_BYTES, stream);
    Args a{};
    for (int i = 0; i < 27; ++i) a.in[i] = (const float*)d_in[i];
    a.out = (float*)d_out; a.ws = (unsigned char*)d_ws;
#if MK_ONE_LAUNCH
    a.ph_lo = 0; a.ph_hi = NPH;
    hipLaunchKernelGGL(fwd, dim3(grid), dim3(NWAVES * 64), LDS_BYTES, stream, a);
#else
    for (int p = 0; p < NPH; ++p) { a.ph_lo = p; a.ph_hi = p + 1; hipLaunchKernelGGL(fwd, dim3(grid), dim3(NWAVES * 64), LDS_BYTES, stream, a); }
#endif
    const hipError_t le = hipPeekAtLastError();
    if (le != hipSuccess) fprintf(stderr, "kernel_launch: launch failed: %s\n", hipGetErrorName(le));
}
```
